# Optimizing an MI355X kernel written in HIP

```python
import jax, jax.numpy as jnp
from jax import lax
import numpy as np

D_MODEL = 1024
BATCH = 4
SEQ = 4096
DEPTH = 1

RMS_EPS = 1e-6
N_MOD = 6
POOL_WINDOWS = (2, 4, 8, 16)
POOL_WIDTH = D_MODEL // 2
POOL_GROUP = POOL_WIDTH // len(POOL_WINDOWS)
MLA_HEADS = 8
QK_NOPE = D_MODEL // 16
QK_ROPE = D_MODEL // 32
V_HEAD = D_MODEL // 16
Q_LORA = D_MODEL // 4
KV_LORA = D_MODEL // 8
ROPE_THETA = 10000.0
Q_BLOCK = 128
MLA_WIDTH = MLA_HEADS * V_HEAD
IN_WIDTH = POOL_WIDTH + Q_LORA + KV_LORA + QK_ROPE + 2 * D_MODEL
PEER_HEADS = 8
PEER_KEYS = 128
PEER_EXPERTS = PEER_KEYS * PEER_KEYS
PEER_QUERY = 256
PEER_TOPK = 16
PEER_CHUNK = 128

kernel_name = "hybrid_pool_mla_peer_block"


def rmsnorm(x, gain):
    xf = x.astype(jnp.float32)
    y = xf * lax.rsqrt(jnp.mean(xf * xf, axis=-1, keepdims=True) + RMS_EPS)
    return (y * gain.astype(jnp.float32)).astype(x.dtype)


def rope_tables(seq, dtype):
    pos = jnp.arange(seq, dtype=jnp.float32)
    inv = 1.0 / (ROPE_THETA ** (jnp.arange(0, QK_ROPE, 2, dtype=jnp.float32) / QK_ROPE))
    ang = pos[:, None] * inv[None, :]
    ang = jnp.concatenate([ang, ang], axis=-1)
    return jnp.cos(ang).astype(dtype), jnp.sin(ang).astype(dtype)


def apply_rope(x, cos, sin):
    half = x.shape[-1] // 2
    rot = jnp.concatenate([-x[..., half:], x[..., :half]], axis=-1)
    return x * cos + rot * sin


def multiscale_pool(xp, w_group, scale):
    b, s, _ = xp.shape
    ng = len(POOL_WINDOWS)
    xg = xp.reshape(b, s, ng, POOL_GROUP).astype(jnp.float32)
    csp = jnp.concatenate([jnp.zeros((b, 1, ng, POOL_GROUP), jnp.float32),
                           jnp.cumsum(xg, axis=1)], axis=1)
    t = jnp.arange(s)
    pooled = []
    for g, w in enumerate(POOL_WINDOWS):
        upper = csp[:, 1:, g]
        lower = jnp.concatenate([jnp.zeros((b, w - 1, POOL_GROUP), jnp.float32),
                                 csp[:, :s - w + 1, g]], axis=1)
        count = jnp.minimum(t + 1, w).astype(jnp.float32)[None, :, None]
        pooled.append((upper - lower) / count)
    mixed = (jnp.stack(pooled, axis=2) - xg).astype(xp.dtype)
    mixed = jnp.einsum('bsgc,gcd->bsgd', mixed, w_group)
    return mixed.reshape(b, s, POOL_WIDTH) * scale


def causal_block_attention(q_nope, q_rope, k_nope, k_rope, v):
    s = q_nope.shape[1]
    sm_scale = (QK_NOPE + QK_ROPE) ** -0.5
    outs = []
    for i in range(s // Q_BLOCK):
        q0, q1 = i * Q_BLOCK, (i + 1) * Q_BLOCK
        sc = (jnp.einsum('bqhd,bkhd->bhqk', q_nope[:, q0:q1], k_nope[:, :q1])
              + jnp.einsum('bqhd,bkd->bhqk', q_rope[:, q0:q1], k_rope[:, :q1]))
        sc = sc.astype(jnp.float32) * sm_scale
        qpos = q0 + jnp.arange(Q_BLOCK)[:, None]
        kpos = jnp.arange(q1)[None, :]
        sc = jnp.where(kpos <= qpos, sc, -jnp.inf)
        p = jax.nn.softmax(sc, axis=-1).astype(v.dtype)
        outs.append(jnp.einsum('bhqk,bkhd->bqhd', p, v[:, :q1]))
    return jnp.concatenate(outs, axis=1)


def latent_attention(q_lat, kv_lat, k_rope, g_q_lat, w_q_up, g_kv_lat, w_kv_up):
    b, s, _ = q_lat.shape
    cos, sin = rope_tables(s, q_lat.dtype)
    q = (rmsnorm(q_lat, g_q_lat) @ w_q_up).reshape(b, s, MLA_HEADS, QK_NOPE + QK_ROPE)
    kv = (rmsnorm(kv_lat, g_kv_lat) @ w_kv_up).reshape(b, s, MLA_HEADS, QK_NOPE + V_HEAD)
    q_nope = q[..., :QK_NOPE]
    q_rope = apply_rope(q[..., QK_NOPE:], cos[:, None, :], sin[:, None, :])
    k_nope, v = kv[..., :QK_NOPE], kv[..., QK_NOPE:]
    k_rope = apply_rope(k_rope, cos, sin)
    o = causal_block_attention(q_nope, q_rope, k_nope, k_rope, v)
    return o.reshape(b, s, MLA_WIDTH)


def peer(xn, w_query, sub_keys1, sub_keys2, expert_u, expert_v):
    b, s, d = xn.shape
    half = PEER_QUERY // 2
    q = (xn @ w_query).reshape(b, s, PEER_HEADS, PEER_QUERY)
    s1 = jnp.einsum('bshd,hkd->bshk', q[..., :half], sub_keys1)
    s2 = jnp.einsum('bshd,hkd->bshk', q[..., half:], sub_keys2)
    v1, i1 = lax.top_k(s1, PEER_TOPK)
    v2, i2 = lax.top_k(s2, PEER_TOPK)
    cand = (v1[..., :, None] + v2[..., None, :]).reshape(b, s, PEER_HEADS, PEER_TOPK * PEER_TOPK)
    sc, ci = lax.top_k(cand, PEER_TOPK)
    eidx = (jnp.take_along_axis(i1, ci // PEER_TOPK, axis=-1) * PEER_KEYS
            + jnp.take_along_axis(i2, ci % PEER_TOPK, axis=-1))
    gate = jax.nn.softmax(sc.astype(jnp.float32), axis=-1).astype(xn.dtype)
    n_chunks = (b * s) // PEER_CHUNK
    xs = xn.reshape(n_chunks, PEER_CHUNK, d)
    es = eidx.reshape(n_chunks, PEER_CHUNK, PEER_HEADS, PEER_TOPK)
    gs = gate.reshape(n_chunks, PEER_CHUNK, PEER_HEADS, PEER_TOPK)

    def chunk(args):
        xc, ec, gc = args
        act = jnp.einsum('cd,chkd->chk', xc, expert_u[ec])
        w = gc * jax.nn.gelu(act)
        return jnp.einsum('chk,chkd->cd', w, expert_v[ec])

    y = lax.map(chunk, (xs, es, gs))
    return y.reshape(b, s, d)


def setup_inputs(seed: int = 0) -> dict:
    key = jax.random.key(seed)
    ks = jax.random.split(key, 24)
    L, D = DEPTH, D_MODEL

    def nrm(k, shape, scale):
        return jax.random.normal(k, shape, jnp.float32) * scale

    def gain(k, shape):
        return 1.0 + nrm(k, shape, 0.01)

    return {
        "x": nrm(ks[0], (BATCH, SEQ, D), 1.0),
        "c": nrm(ks[1], (BATCH, D), 1.0),
        "w_ada": nrm(ks[2], (L, D, N_MOD * D), 0.5 * D ** -0.5),
        "b_ada": nrm(ks[3], (L, N_MOD * D), 0.01),
        "g_pre1": gain(ks[4], (L, D)),
        "g_post1": gain(ks[5], (L, D)),
        "w_in": nrm(ks[6], (L, D, IN_WIDTH), D ** -0.5),
        "w_pool_group": nrm(ks[7], (L, len(POOL_WINDOWS), POOL_GROUP, POOL_GROUP), POOL_GROUP ** -0.5),
        "pool_scale": 1.0 + nrm(ks[8], (L, POOL_WIDTH), 0.1),
        "w_pool_o": nrm(ks[9], (L, POOL_WIDTH, D), POOL_WIDTH ** -0.5),
        "g_q_lat": gain(ks[10], (L, Q_LORA)),
        "w_q_up": nrm(ks[11], (L, Q_LORA, MLA_HEADS * (QK_NOPE + QK_ROPE)), Q_LORA ** -0.5),
        "g_kv_lat": gain(ks[12], (L, KV_LORA)),
        "w_kv_up": nrm(ks[13], (L, KV_LORA, MLA_HEADS * (QK_NOPE + V_HEAD)), KV_LORA ** -0.5),
        "w_mla_o": nrm(ks[14], (L, MLA_WIDTH, D), MLA_WIDTH ** -0.5),
        "w_out": nrm(ks[15], (L, D, D), D ** -0.5),
        "g_pre2": gain(ks[16], (L, D)),
        "g_post2": gain(ks[17], (L, D)),
        "w_query": nrm(ks[18], (L, D, PEER_HEADS * PEER_QUERY), D ** -0.5),
        "sub_keys1": nrm(ks[19], (L, PEER_HEADS, PEER_KEYS, PEER_QUERY // 2), (PEER_QUERY // 2) ** -0.5),
        "sub_keys2": nrm(ks[20], (L, PEER_HEADS, PEER_KEYS, PEER_QUERY // 2), (PEER_QUERY // 2) ** -0.5),
        "expert_u": nrm(ks[21], (L, PEER_EXPERTS, D), D ** -0.5),
        "expert_v": nrm(ks[22], (L, PEER_EXPERTS, D), 0.1),
    }


def reference(x, c, w_ada, b_ada, g_pre1, g_post1, w_in, w_pool_group, pool_scale, w_pool_o,
              g_q_lat, w_q_up, g_kv_lat, w_kv_up, w_mla_o, w_out, g_pre2, g_post2,
              w_query, sub_keys1, sub_keys2, expert_u, expert_v):
    h = x
    split_at = np.cumsum([POOL_WIDTH, Q_LORA, KV_LORA, QK_ROPE, D_MODEL]).tolist()
    for l in range(DEPTH):
        mod = jax.nn.silu(c) @ w_ada[l] + b_ada[l]
        shift1, scale1, gate1, shift2, scale2, gate2 = jnp.split(mod[:, None, :], N_MOD, axis=-1)

        xn = rmsnorm(h, g_pre1[l]) * (1.0 + scale1) + shift1
        proj = xn @ w_in[l]
        x_pool, q_lat, kv_lat, k_rope, gate_a, gate_b = jnp.split(proj, split_at, axis=-1)
        y_pool = multiscale_pool(x_pool, w_pool_group[l], pool_scale[l]) @ w_pool_o[l]
        y_mla = latent_attention(q_lat, kv_lat, k_rope, g_q_lat[l], w_q_up[l],
                                 g_kv_lat[l], w_kv_up[l]) @ w_mla_o[l]
        merged = jax.nn.sigmoid(gate_a) * y_pool + jax.nn.sigmoid(gate_b) * y_mla
        h = h + gate1 * rmsnorm(merged @ w_out[l], g_post1[l])

        xn2 = rmsnorm(h, g_pre2[l]) * (1.0 + scale2) + shift2
        y2 = peer(xn2, w_query[l], sub_keys1[l], sub_keys2[l], expert_u[l], expert_v[l])
        h = h + gate2 * rmsnorm(y2, g_post2[l])
    return h
```

```cpp
#include <hip/hip_runtime.h>
#include <cstdio>
#include <cstdint>

#ifndef DIAG
#define DIAG 0
#endif
#define LAS __attribute__((address_space(3)))
#define GAS __attribute__((address_space(1)))
typedef unsigned short bf16;
typedef short bf16x8 __attribute__((ext_vector_type(8)));
typedef float f32x4 __attribute__((ext_vector_type(4)));
typedef float f32x2 __attribute__((ext_vector_type(2)));
typedef float f32x16 __attribute__((ext_vector_type(16)));
typedef unsigned u32x4 __attribute__((ext_vector_type(4)));
typedef unsigned u32x2 __attribute__((ext_vector_type(2)));
typedef __bf16 bf16x2_t __attribute__((ext_vector_type(2)));

constexpr int NBATCH = 4, SEQ = 4096, T = NBATCH * SEQ, D = 1024;
constexpr int PROJ_N = 3072;
constexpr int NHEAD = 8, QKD = 96, VD = 64;
constexpr float RMS_EPS = 1e-6f;
constexpr float ATT_C2 = 0.10206207261596577f * 1.4426950408889634f;
constexpr int PEER_H = 8, PEER_K = 16;

constexpr size_t MiB = 1u << 20;
constexpr size_t WS_CTL = 0, CTL_ZERO_BYTES = 1 * MiB;
constexpr size_t WS_WIN = 1 * MiB;
constexpr size_t WS_WQ = 7 * MiB;
constexpr size_t WS_WK = WS_WQ + 512 * 1024;
constexpr size_t WS_WV = WS_WK + 256 * 1024;
constexpr size_t WS_WG = 8 * MiB;
constexpr size_t WS_WPO = WS_WG + 512 * 1024;
constexpr size_t WS_WMO = WS_WPO + 1 * MiB;
constexpr size_t WS_WOUT = WS_WMO + 1 * MiB;
constexpr size_t WS_WQY = 13 * MiB;
constexpr size_t WS_SK = 17 * MiB;
constexpr size_t WS_ROPE = WS_SK + 512 * 1024;
constexpr size_t WS_R1 = 18 * MiB;
constexpr size_t WS_R2 = 50 * MiB;
constexpr size_t WS_EIDX = WS_R2 + 64 * MiB;
constexpr size_t WS_GATE = WS_EIDX + 8 * MiB;
constexpr size_t WS_KB = 146 * MiB;
constexpr size_t WS_VT = 170 * MiB;
constexpr size_t WS_MRG = 146 * MiB;
constexpr size_t WS_PIN = 186 * MiB;
constexpr size_t WS_PF = 202 * MiB;
constexpr size_t WS_AO = 218 * MiB;
constexpr size_t WS_EU = 146 * MiB;
constexpr size_t WS_EV = 178 * MiB;
constexpr size_t WS_END = 234 * MiB;
constexpr int CW_BAR = 4096;
constexpr int CW_MOD = 16384;
constexpr int CW_RSQ = CW_MOD + 2 * 4 * 6144;
constexpr int CW_RSK = CW_RSQ + 2 * T;
constexpr int CW_MODF = CW_RSK + 2 * T;
static_assert((CW_MODF + 4 * 6144) * 4 <= (int)CTL_ZERO_BYTES, "ctl");
constexpr double MOD_FX = 1099511627776.0, RS_FX = 16777216.0;
__device__ __forceinline__ void fx_add(long long* p, float v, double scale) { atomicAdd((unsigned long long*)p, (unsigned long long)__double2ll_rn((double)v * scale)); }
__device__ __forceinline__ float fx_get(const long long* p, double inv_scale) { return (float)((double)(*p) * inv_scale); }

__device__ __forceinline__ unsigned cvtpk(float lo, float hi) { f32x2 v = {lo, hi}; bf16x2_t b = __builtin_convertvector(v, bf16x2_t); return __builtin_bit_cast(unsigned, b); }
__device__ __forceinline__ float bflo(unsigned w) { return __uint_as_float(w << 16); }
__device__ __forceinline__ float bfhi(unsigned w) { return __uint_as_float(w & 0xffff0000u); }
__device__ __forceinline__ u32x4 pack8(f32x4 a, f32x4 b) { u32x4 w; w.x = cvtpk(a[0], a[1]); w.y = cvtpk(a[2], a[3]); w.z = cvtpk(b[0], b[1]); w.w = cvtpk(b[2], b[3]); return w; }
__device__ __forceinline__ void unpack8(u32x4 w, f32x4& a, f32x4& b) { a = (f32x4){bflo(w.x), bfhi(w.x), bflo(w.y), bfhi(w.y)}; b = (f32x4){bflo(w.z), bfhi(w.z), bflo(w.w), bfhi(w.w)}; }
__device__ __forceinline__ float sigmoidf_(float x) { return __builtin_amdgcn_rcpf(1.0f + __builtin_amdgcn_exp2f(-1.4426950408889634f * x)); }
__device__ __forceinline__ float wave_sum(float v) {
#pragma unroll
    for (int o = 1; o < 64; o <<= 1) v += __shfl_xor(v, o);
    return v;
}
#define LDS_WAIT() asm volatile("s_waitcnt lgkmcnt(0)" ::: "memory")

namespace pg8 {
typedef unsigned short bf16_t;
constexpr int BM = 256, BK = 64, HALF = 128, HTB = HALF * BK * 2, STAGE_BYTES = 8 * HTB, NXCD = 8, WGM = 8;
__host__ __device__ __forceinline__ int lds_byte(int r, int c) { const int st = (r >> 4) * 2 + (c >> 5), rr = r & 15, cc = c & 31, ob = rr * 64 + cc * 2; return st * 1024 + (ob ^ (((ob >> 9) & 1) << 5)); }
__host__ __device__ __forceinline__ void stage_rc(int b, int& R, int& C) { const int st = b / 1024, sb = b % 1024, swz = sb ^ (((sb >> 9) & 1) << 5); R = (st >> 1) * 16 + swz / 64; C = (st & 1) * 32 + (swz % 64) / 2; }
__host__ __device__ __forceinline__ int perm32(int rho) { const int n = rho >> 4, i = rho & 15; return 8 * (i >> 2) + 4 * n + (i & 3); }
struct Unit { int pm, pn; };
struct Gemm { const bf16_t* A; const bf16_t* Bt; int M, N, K, lda, ldb; };
struct StaticOrder {
    int nM, nN, nwg, G, c;
    __host__ __device__ void init(int M, int N, int G_, int c_) { nM = M / BM; nN = N / BM; nwg = nM * nN; G = G_; c = c_; }
    __host__ __device__ bool next(int i, Unit& u) const {
        const long L = (long)i * G + c; if (L >= nwg) return false;
        int wgid = (int)L; { const int q = nwg / NXCD, r = nwg % NXCD, xcd = wgid % NXCD, off = wgid / NXCD; wgid = (xcd < r ? xcd * (q + 1) : r * (q + 1) + (xcd - r) * q) + off; }
        const int nig = WGM * nN, gid = wgid / nig, fm = gid * WGM, gsz = (nM - fm) < WGM ? (nM - fm) : WGM;
        u.pm = fm + ((wgid % nig) % gsz); u.pn = (wgid % nig) / gsz; return true;
    }
};
template <class Epi, bool ALIGN_EPI>
__device__ __forceinline__ void gemm_phase(LAS unsigned char* lds, const Gemm g, const StaticOrder& S, const Epi& E) {
    int tid_ = threadIdx.x; asm volatile("" : "+v"(tid_));
    const int tid = tid_, wid = __builtin_amdgcn_readfirstlane(tid >> 6), lane = tid & 63, wr = wid >> 2, wc = wid & 3, fr = lane & 15, fq = lane >> 4;
    int K_ = g.K; asm volatile("" : "+s"(K_));
    const int K = K_, nt = K / BK;
    unsigned voffA[2], voffB[2];
#pragma unroll
    for (int i = 0; i < 2; ++i) { int R, C; stage_rc(tid * 16 + i * 8192, R, C); const int Rb = (R & ~31) + perm32(R & 31);
        voffA[i] = (unsigned)(R * g.lda + C) * 2u; voffB[i] = (unsigned)(Rb * g.ldb + C) * 2u; }
    const size_t kstep = (size_t)(BK * 2);
    const size_t hstepA = (size_t)HALF * g.lda * 2, hstepB = (size_t)HALF * g.ldb * 2;
    const size_t tstepA = 2 * hstepA, tstepB = 2 * hstepB;
    const unsigned ldsw = (unsigned)wid * 1024u;
    const int aoff = lds_byte(wr * 64 + fr, fq * 8), boff = lds_byte(wc * 32 + fr, fq * 8);
#define PG8_SA(b, h) (((b) * 2 + (h)) * HTB)
#define PG8_SB(b, h) ((4 + (b) * 2 + (h)) * HTB)
#define PG8_STAGE(bufoff, gbase, voff) do { _Pragma("unroll") for (int _i = 0; _i < 2; ++_i) \
        __builtin_amdgcn_global_load_lds((const unsigned*)((const char*)(gbase) + (voff)[_i]), (LAS unsigned*)(lds + (bufoff) + ldsw + _i * 8192), 16, 0, 0); } while (0)
#define PG8_LDA(dst, b, h) do { _Pragma("unroll") for (int m = 0; m < 4; ++m) _Pragma("unroll") for (int k = 0; k < 2; ++k) dst[m][k] = *(const LAS bf16x8*)(lds + PG8_SA(b, h) + aoff + m * 2048 + k * 1024); } while (0)
#define PG8_LDB(dst, b, h) do { _Pragma("unroll") for (int n = 0; n < 2; ++n) _Pragma("unroll") for (int k = 0; k < 2; ++k) dst[n][k] = *(const LAS bf16x8*)(lds + PG8_SB(b, h) + boff + n * 2048 + k * 1024); } while (0)
#define PG8_MMA(ai, bj, At, Bt) do { __builtin_amdgcn_s_setprio(1); _Pragma("unroll") for (int m = 0; m < 4; ++m) _Pragma("unroll") for (int n = 0; n < 2; ++n) _Pragma("unroll") for (int k = 0; k < 2; ++k) \
        acc[ai][bj][m][n] = __builtin_amdgcn_mfma_f32_16x16x32_bf16(Bt[n][k], At[m][k], acc[ai][bj][m][n], 0, 0, 0); __builtin_amdgcn_s_setprio(0); } while (0)
#define PG8_WAIT_V(n) asm volatile("s_waitcnt vmcnt(" #n ")" ::: "memory")
#define PG8_WAIT_L(n) asm volatile("s_waitcnt lgkmcnt(" #n ")" ::: "memory")
#define PG8_BAR __builtin_amdgcn_s_barrier()
#define PG8_SCHED __builtin_amdgcn_sched_barrier(0)
    Unit cur, nxt; int ui = 0;
    if (!S.next(0, cur)) return;
    f32x4 acc[2][2][4][2];
#pragma unroll
    for (int a = 0; a < 2; ++a)
#pragma unroll
        for (int b = 0; b < 2; ++b)
#pragma unroll
            for (int m = 0; m < 4; ++m)
#pragma unroll
                for (int n = 0; n < 2; ++n) acc[a][b][m][n] = (f32x4){0.f, 0.f, 0.f, 0.f};
    bf16x8 At[4][2], B0[2][2], B1[2][2];
    const char* cA = (const char*)g.A + (size_t)cur.pm * tstepA; const char* cB = (const char*)g.Bt + (size_t)cur.pn * tstepB;
    PG8_STAGE(PG8_SB(0, 0), cB, voffB); PG8_STAGE(PG8_SB(0, 1), cB + hstepB, voffB); PG8_STAGE(PG8_SA(0, 0), cA, voffA); PG8_STAGE(PG8_SA(0, 1), cA + hstepA, voffA);
    if (wr == 1) PG8_BAR;
    PG8_WAIT_V(2); PG8_BAR;
    PG8_STAGE(PG8_SB(1, 0), cB + kstep, voffB); PG8_STAGE(PG8_SA(1, 0), cA + kstep, voffA); PG8_STAGE(PG8_SB(1, 1), cB + hstepB + kstep, voffB);
    PG8_WAIT_V(6); PG8_BAR;
    for (;;) {
        const bool has_next = S.next(ui + 1, nxt);
        const char* nA = has_next ? (const char*)g.A + (size_t)nxt.pm * tstepA : cA; const char* nB = has_next ? (const char*)g.Bt + (size_t)nxt.pn * tstepB : cB;
        for (int t = 0; t < nt; t += 2) {
            const bool last = (t == nt - 2);
            const char* a1 = cA + (size_t)(t + 1) * kstep;
            const char* a2 = last ? nA : cA + (size_t)(t + 2) * kstep; const char* b2 = last ? nB : cB + (size_t)(t + 2) * kstep;
            const char* a3 = a2 + kstep; const char* b3 = b2 + kstep;
            PG8_LDB(B0, 0, 0); PG8_LDB(B1, 0, 1); PG8_SCHED; PG8_LDA(At, 0, 0); PG8_STAGE(PG8_SA(1, 1), a1 + hstepA, voffA);
            PG8_WAIT_V(8); PG8_WAIT_L(0); PG8_BAR; PG8_MMA(0, 0, At, B0); PG8_MMA(0, 1, At, B1); PG8_BAR; PG8_SCHED;
            PG8_LDA(At, 0, 1); PG8_STAGE(PG8_SB(0, 0), b2, voffB); PG8_STAGE(PG8_SB(0, 1), b2 + hstepB, voffB); PG8_STAGE(PG8_SA(0, 0), a2, voffA);
            PG8_WAIT_V(8); PG8_WAIT_L(0); PG8_BAR; PG8_MMA(1, 0, At, B0); PG8_MMA(1, 1, At, B1); PG8_BAR; PG8_SCHED;
            PG8_LDB(B0, 1, 0); PG8_LDB(B1, 1, 1); PG8_SCHED; PG8_LDA(At, 1, 0); PG8_STAGE(PG8_SA(0, 1), a2 + hstepA, voffA);
            PG8_WAIT_V(8); PG8_WAIT_L(0); PG8_BAR; PG8_MMA(0, 0, At, B0); PG8_MMA(0, 1, At, B1); PG8_BAR; PG8_SCHED;
            PG8_LDA(At, 1, 1); PG8_STAGE(PG8_SB(1, 0), b3, voffB); PG8_STAGE(PG8_SB(1, 1), b3 + hstepB, voffB); PG8_STAGE(PG8_SA(1, 0), a3, voffA);
            PG8_WAIT_V(8); PG8_WAIT_L(0); PG8_BAR; PG8_MMA(1, 0, At, B0); PG8_MMA(1, 1, At, B1); PG8_BAR; PG8_SCHED;
        }
        if constexpr (ALIGN_EPI) { if (wr == 0) PG8_BAR; }
        E(acc, cur, wr, wc, fr, fq);
        if (!has_next) break;
#pragma unroll
        for (int a = 0; a < 2; ++a)
#pragma unroll
            for (int b = 0; b < 2; ++b)
#pragma unroll
                for (int m = 0; m < 4; ++m)
#pragma unroll
                    for (int n = 0; n < 2; ++n) acc[a][b][m][n] = (f32x4){0.f, 0.f, 0.f, 0.f};
        cur = nxt; cA = nA; cB = nB; ++ui;
        if constexpr (ALIGN_EPI) { if (wr == 1) PG8_BAR; }
    }
    PG8_WAIT_V(0);
    if constexpr (!ALIGN_EPI) { if (wr == 0) PG8_BAR; }
    PG8_BAR;
#undef PG8_SA
#undef PG8_SB
#undef PG8_STAGE
#undef PG8_LDA
#undef PG8_LDB
#undef PG8_MMA
#undef PG8_WAIT_V
#undef PG8_WAIT_L
#undef PG8_BAR
#undef PG8_SCHED
}

#define EPI_ARGS const f32x4 (&acc)[2][2][4][2], const Unit& u, int wr, int wc, int fr, int fq
__device__ __forceinline__ void rope8(f32x4& v0, f32x4& v1, const float* tab, int e0) {
    const f32x4 c = *(const f32x4*)(tab + e0), s = *(const f32x4*)(tab + 16 + e0);
    const float a0 = v0[0] * c[0] - v0[1] * s[0], b0 = v0[1] * c[0] + v0[0] * s[0];
    const float a1 = v0[2] * c[1] - v0[3] * s[1], b1 = v0[3] * c[1] + v0[2] * s[1];
    const float a2 = v1[0] * c[2] - v1[1] * s[2], b2 = v1[1] * c[2] + v1[0] * s[2];
    const float a3 = v1[2] * c[3] - v1[3] * s[3], b3 = v1[3] * c[3] + v1[2] * s[3];
    v0 = (f32x4){a0, b0, a1, b1}; v1 = (f32x4){a2, b2, a3, b3};
}
struct EpiPlain { bf16* O; int ldc;
    __device__ __forceinline__ void operator()(EPI_ARGS) const {
#pragma unroll
        for (int ai = 0; ai < 2; ++ai)
#pragma unroll
            for (int m = 0; m < 4; ++m) { const int row = u.pm * BM + ai * HALF + wr * 64 + m * 16 + fr;
#pragma unroll
                for (int bj = 0; bj < 2; ++bj) { const int col0 = u.pn * BM + bj * HALF + wc * 32 + 8 * fq;
                    *(u32x4*)(O + (size_t)row * ldc + col0) = pack8(acc[ai][bj][m][0], acc[ai][bj][m][1]); } }
    }
};
struct EpiProj { bf16* P; bf16* Kb; long long* rsq; long long* rsk; const float* rope;
    __device__ __forceinline__ void operator()(EPI_ARGS) const {
        const int pn = u.pn;
#pragma unroll
        for (int ai = 0; ai < 2; ++ai)
#pragma unroll
            for (int m = 0; m < 4; ++m) { const int row = u.pm * BM + ai * HALF + wr * 64 + m * 16 + fr; float ss = 0.f;
#pragma unroll
                for (int bj = 0; bj < 2; ++bj) { const int col0 = pn * BM + bj * HALF + wc * 32 + 8 * fq;
                    f32x4 v0 = acc[ai][bj][m][0], v1 = acc[ai][bj][m][1];
                    if (pn >= 4) {
#pragma unroll
                        for (int i = 0; i < 4; ++i) { v0[i] = sigmoidf_(v0[i]); v1[i] = sigmoidf_(v1[i]); }
                    }
                    *(u32x4*)(P + (size_t)row * PROJ_N + col0) = pack8(v0, v1);
                    if (pn == 2 || (pn == 3 && bj == 0)) ss += (v0[0] * v0[0] + v0[1] * v0[1]) + (v0[2] * v0[2] + v0[3] * v0[3]) + (v1[0] * v1[0] + v1[1] * v1[1]) + (v1[2] * v1[2] + v1[3] * v1[3]);
                    if (pn == 3 && bj == 1 && wc == 0) {
                        rope8(v0, v1, rope + (size_t)(row & (SEQ - 1)) * 32, 4 * fq);
                        const u32x4 w = pack8(v0, v1);
#pragma unroll
                        for (int h = 0; h < NHEAD; ++h) *(u32x4*)(Kb + (size_t)row * (NHEAD * QKD) + h * QKD + 64 + 8 * fq) = w;
                    }
                }
                if (pn == 2 || pn == 3) { ss += __shfl_xor(ss, 16); ss += __shfl_xor(ss, 32);
                    if (fq == 0) fx_add((pn == 2 ? rsq : rsk) + row, ss, RS_FX); }
            }
    }
};
struct EpiQ { bf16* Q; const long long* rsq; const float* rope;
    __device__ __forceinline__ void operator()(EPI_ARGS) const {
#pragma unroll
        for (int ai = 0; ai < 2; ++ai)
#pragma unroll
            for (int m = 0; m < 4; ++m) { const int row = u.pm * BM + ai * HALF + wr * 64 + m * 16 + fr;
                const float sc = rsqrtf(fx_get(rsq + row, 1.0 / RS_FX) * (1.0f / 256.0f) + RMS_EPS) * ATT_C2;
#pragma unroll
                for (int bj = 0; bj < 2; ++bj) { const int col0 = u.pn * BM + bj * HALF + wc * 32 + 8 * fq;
                    f32x4 v0 = acc[ai][bj][m][0] * sc, v1 = acc[ai][bj][m][1] * sc;
                    if (((u.pn * 8 + bj * 4 + wc) % 3) == 2) rope8(v0, v1, rope + (size_t)(row & (SEQ - 1)) * 32, 4 * fq);
                    *(u32x4*)(Q + (size_t)row * (NHEAD * QKD) + col0) = pack8(v0, v1); }
                asm volatile("" ::: "memory"); }
    }
};
struct EpiKn { bf16* Kb; const long long* rsk;
    __device__ __forceinline__ void operator()(EPI_ARGS) const {
#pragma unroll
        for (int ai = 0; ai < 2; ++ai)
#pragma unroll
            for (int m = 0; m < 4; ++m) { const int row = u.pm * BM + ai * HALF + wr * 64 + m * 16 + fr;
                const float sc = rsqrtf(fx_get(rsk + row, 1.0 / RS_FX) * (1.0f / 128.0f) + RMS_EPS);
#pragma unroll
                for (int bj = 0; bj < 2; ++bj) { const int col0 = u.pn * BM + bj * HALF + wc * 32 + 8 * fq; const int h = col0 >> 6, j = col0 & 63;
                    *(u32x4*)(Kb + (size_t)row * (NHEAD * QKD) + h * QKD + j) = pack8(acc[ai][bj][m][0] * sc, acc[ai][bj][m][1] * sc); }
                if (m & 1) asm volatile("" ::: "memory"); }
    }
};
struct EpiVt { bf16* Vt; const long long* rsk;
    __device__ __forceinline__ void operator()(EPI_ARGS) const {
#pragma unroll
        for (int bj = 0; bj < 2; ++bj) { const int col0 = u.pn * BM + bj * HALF + wc * 32 + 8 * fq;
            f32x4 s0, s1;
#pragma unroll
            for (int i = 0; i < 4; ++i) { s0[i] = rsqrtf(fx_get(rsk + col0 + i, 1.0 / RS_FX) * (1.0f / 128.0f) + RMS_EPS); s1[i] = rsqrtf(fx_get(rsk + col0 + 4 + i, 1.0 / RS_FX) * (1.0f / 128.0f) + RMS_EPS); }
#pragma unroll
            for (int ai = 0; ai < 2; ++ai)
#pragma unroll
                for (int m = 0; m < 4; ++m) { const int row = u.pm * BM + ai * HALF + wr * 64 + m * 16 + fr;
                    *(u32x4*)(Vt + (size_t)row * T + col0) = pack8(acc[ai][bj][m][0] * s0, acc[ai][bj][m][1] * s1); }
            asm volatile("" ::: "memory"); }
    }
};
template <int MODE> struct EpiGate { bf16* Y; const bf16* P; int goff;
    __device__ __forceinline__ void operator()(EPI_ARGS) const {
#pragma unroll
        for (int ai = 0; ai < 2; ++ai)
#pragma unroll
            for (int m = 0; m < 4; ++m) { const int row = u.pm * BM + ai * HALF + wr * 64 + m * 16 + fr;
#pragma unroll
                for (int bj = 0; bj < 2; ++bj) { const int col0 = u.pn * BM + bj * HALF + wc * 32 + 8 * fq;
                    f32x4 g0, g1; unpack8(*(const u32x4*)(P + (size_t)row * PROJ_N + goff + col0), g0, g1);
                    f32x4 v0 = acc[ai][bj][m][0] * g0, v1 = acc[ai][bj][m][1] * g1;
                    bf16* yp = Y + (size_t)row * D + col0;
                    if (MODE == 1) { f32x4 y0, y1; unpack8(*(const u32x4*)yp, y0, y1); v0 += y0; v1 += y1; }
                    *(u32x4*)yp = pack8(v0, v1); } }
    }
};
}

#define XB_TMO      128
#define XB_XCNT(j)  (256  + 64 * (j))
#define XB_XSUB(j)  (1280 + 64 * (j))
#define XB_XGEN(j)  (2304 + 64 * (j))
#define XB_TOP      3328
#define XB_TOPGEN   3392
#define XCD_BAR_WORDS 3456
#define XB_SPIN_CAP (1u << 18)
__device__ __forceinline__ unsigned xb_ld(unsigned* p)              { return __hip_atomic_load(p, __ATOMIC_RELAXED, __HIP_MEMORY_SCOPE_AGENT); }
__device__ __forceinline__ unsigned xb_add(unsigned* p, unsigned v) { return __hip_atomic_fetch_add(p, v, __ATOMIC_RELAXED, __HIP_MEMORY_SCOPE_AGENT); }
__device__ __forceinline__ unsigned xb_xcc_id() { return (unsigned)__builtin_amdgcn_s_getreg((3 << 11) | 20) & 0xFu; }
#define XB_SPIN(cond, bar) do { unsigned _sp = 0; while (cond) { __builtin_amdgcn_s_sleep(1); \
    if ((++_sp & 255u) == 0u) { if (xb_ld(&(bar)[XB_TMO])) break; if (_sp > XB_SPIN_CAP) { atomicAdd(&(bar)[XB_TMO], 1u); break; } } } } while (0)
struct XcdBarrier { unsigned* bar; unsigned x; volatile LAS unsigned* st; };
__device__ __forceinline__ XcdBarrier xcd_barrier_post(unsigned* bar, volatile LAS unsigned* st) {
    XcdBarrier b; b.bar = bar; b.x = xb_xcc_id(); b.st = st;
    if (threadIdx.x == 0) (void)xb_add(&bar[XB_XCNT(b.x)], 1u);
    return b;
}
__device__ __forceinline__ void xcd_barrier_complete(unsigned* bar, unsigned x, unsigned& nloc, unsigned& nx) {
    const unsigned G = gridDim.x * gridDim.y * gridDim.z;
    unsigned sum, cnt, mine, sp = 0u;
    for (;;) {
        sum = 0u; cnt = 0u; mine = 0u;
#pragma unroll
        for (unsigned j = 0; j < 16; ++j) { const unsigned c = xb_ld(&bar[XB_XCNT(j)]); sum += c; cnt += (c > 0u) ? 1u : 0u; mine = (j == x) ? c : mine; }
        if (sum == G) break;
        __builtin_amdgcn_s_sleep(1);
        if ((++sp & 255u) == 0u) { if (xb_ld(&bar[XB_TMO])) break; if (sp > XB_SPIN_CAP) { atomicAdd(&bar[XB_TMO], 1u); break; } }
    }
    nloc = mine > 0u ? mine : 1u; nx = cnt > 0u ? cnt : 1u;
}
__device__ __forceinline__ void xcd_barrier(const XcdBarrier& b) {
    asm volatile("s_waitcnt vmcnt(0)" ::: "memory");
    __syncthreads();
    if (threadIdx.x == 0) {
        unsigned* bar = b.bar;
        __builtin_amdgcn_s_waitcnt(0);
        unsigned nloc = b.st[0], nx = b.st[1];
        if (nloc == 0u) { xcd_barrier_complete(bar, b.x, nloc, nx); b.st[0] = nloc; b.st[1] = nx; }
        const unsigned old = xb_add(&bar[XB_XSUB(b.x)], 1u);
        const unsigned gen = old / nloc;
        if (old + 1u == (gen + 1u) * nloc) {
            __builtin_amdgcn_fence(__ATOMIC_RELEASE, "agent");
            asm volatile("s_waitcnt vmcnt(0)" ::: "memory");
            const unsigned og = xb_add(&bar[XB_TOP], 1u);
            const unsigned tg = og / nx;
            if (og + 1u == (tg + 1u) * nx) xb_add(&bar[XB_TOPGEN], 1u);
            else XB_SPIN(xb_ld(&bar[XB_TOPGEN]) == tg, bar);
            __builtin_amdgcn_fence(__ATOMIC_ACQUIRE, "agent");
            xb_add(&bar[XB_XGEN(b.x)], 1u);
            asm volatile("s_waitcnt vmcnt(0)" ::: "memory");
        } else {
            XB_SPIN(xb_ld(&bar[XB_XGEN(b.x)]) == gen, bar);
            __builtin_amdgcn_fence(__ATOMIC_ACQUIRE, "agent");
            asm volatile("s_waitcnt vmcnt(0)" ::: "memory");
        }
    }
    __syncthreads();
}

constexpr int NWAVES = 8;
constexpr int RING_BYTES = 131072, LDSCTL_OFF = RING_BYTES, LDS_BYTES = 147456;
struct Args { const float* in[23]; float* out; unsigned char* ws; };
struct Frame {
    LAS unsigned char* lds; int tid, lane, wave, vcu, G;
    const float* const* in; float* out; unsigned char* ws;
};
enum { I_X = 0, I_C, I_WADA, I_BADA, I_GPRE1, I_GPOST1, I_WIN, I_WPG, I_PSCALE, I_WPO, I_GQ, I_WQUP, I_GKV, I_WKVUP, I_WMO, I_WOUT, I_GPRE2, I_GPOST2, I_WQY, I_SK1, I_SK2, I_EU, I_EV };

__device__ __forceinline__ void tr_block(const float* src, int spitch, int ks, int ns, int perm, const float* gk, const float* gn, bf16* dst, int dpitch, int nd, int kd, LAS float* scr, int lane) {
    if (src) {
        const float gnv = gn ? gn[lane & 31] : 1.0f;
#pragma unroll 8
        for (int i = 0; i < 32; ++i) { const int kk = 2 * i + (lane >> 5); float v = src[(size_t)(ks + kk) * spitch + ns + (lane & 31)] * gnv; if (gk) v *= gk[ks + kk]; scr[kk * 33 + (lane & 31)] = v; }
    } else {
#pragma unroll 8
        for (int i = 0; i < 32; ++i) { const int kk = 2 * i + (lane >> 5); scr[kk * 33 + (lane & 31)] = 0.f; }
    }
    LDS_WAIT(); asm volatile("" ::: "memory");
    const int c = lane & 7;
#pragma unroll
    for (int j = 0; j < 4; ++j) { const int n = (lane >> 3) + 8 * j; const int pc = perm ? ((n >> 1) + 16 * (n & 1)) : n; const LAS float* s = scr + (8 * c) * 33 + pc;
        u32x4 o; o.x = cvtpk(s[0 * 33], s[1 * 33]); o.y = cvtpk(s[2 * 33], s[3 * 33]); o.z = cvtpk(s[4 * 33], s[5 * 33]); o.w = cvtpk(s[6 * 33], s[7 * 33]);
        *(u32x4*)(dst + (size_t)(nd + n) * dpitch + kd + 8 * c) = o; }
    LDS_WAIT(); asm volatile("" ::: "memory");
}

__device__ __forceinline__ void p0_prologue(Frame& F) {
    LAS float* scr = (LAS float*)(F.lds + F.wave * 16384);
    int lane_ = F.lane; asm volatile("" : "+v"(lane_));
    const int gw = F.vcu * NWAVES + F.wave, NGW = F.G * NWAVES, lane = lane_;
    unsigned char* ws = F.ws;
    {
        long long* mod = (long long*)((unsigned*)(ws + WS_CTL) + CW_MOD);
        const float* cc = F.in[I_C]; const float* wa = F.in[I_WADA]; const float* ba = F.in[I_BADA];
        for (int it = gw; it < 24 * 64; it += NGW) {
            const int cg = it % 24, kc = it / 24; const int col = cg * 256 + 4 * lane;
            f32x4 a0 = {0, 0, 0, 0}, a1 = a0, a2 = a0, a3 = a0;
            if (kc == 0) { a0 = *(const f32x4*)(ba + col); a1 = a0; a2 = a0; a3 = a0; }
#pragma unroll 4
            for (int k = kc * 16; k < kc * 16 + 16; ++k) {
                const f32x4 w = *(const f32x4*)(wa + (size_t)k * 6144 + col);
                const float c0 = cc[k], c1 = cc[1024 + k], c2 = cc[2048 + k], c3 = cc[3072 + k];
                a0 += w * (c0 * sigmoidf_(c0)); a1 += w * (c1 * sigmoidf_(c1)); a2 += w * (c2 * sigmoidf_(c2)); a3 += w * (c3 * sigmoidf_(c3));
            }
#pragma unroll
            for (int i = 0; i < 4; ++i) { fx_add(mod + col + i, a0[i], MOD_FX); fx_add(mod + 6144 + col + i, a1[i], MOD_FX); fx_add(mod + 2 * 6144 + col + i, a2[i], MOD_FX); fx_add(mod + 3 * 6144 + col + i, a3[i], MOD_FX); }
        }
    }
    {
        bf16* Win = (bf16*)(ws + WS_WIN); bf16* Wq = (bf16*)(ws + WS_WQ); bf16* Wk = (bf16*)(ws + WS_WK); bf16* Wv = (bf16*)(ws + WS_WV); bf16* Wg = (bf16*)(ws + WS_WG);
        bf16* Wpo = (bf16*)(ws + WS_WPO); bf16* Wmo = (bf16*)(ws + WS_WMO); bf16* Wout = (bf16*)(ws + WS_WOUT); bf16* Wqy = (bf16*)(ws + WS_WQY);
        constexpr int N1 = 96 * 16, N2 = 24 * 4, N3 = 16 * 4, N4 = 16 * 4, N5 = 16 * 8, N6 = 32 * 8, N7 = 32 * 8, N8 = 32 * 16, N9 = 64 * 16;
        constexpr int NITEMS = N1 + N2 + N3 + N4 + N5 + N6 + N7 + N8 + N9;
        for (int it = gw; it < NITEMS; it += NGW) {
            int r = it;
            if (r < N1) { const int nb = r % 96, kb = r / 96; const float* s = F.in[I_WIN]; int ns = 32 * nb, pm = 0;
                if (nb == 28) pm = 1; else if (nb >= 29 && nb < 32) s = nullptr; else if (nb >= 32) ns = 928 + 32 * (nb - 32);
                tr_block(s, 2976, 64 * kb, ns, pm, nullptr, nullptr, Win, 1024, 32 * nb, 64 * kb, scr, lane); continue; } r -= N1;
            if (r < N2) { const int nb = r % 24, kb = r / 24; const int h = nb / 3, q = nb % 3;
                tr_block(F.in[I_WQUP], 768, 64 * kb, 96 * h + 32 * q, q == 2, F.in[I_GQ], nullptr, Wq, 256, 32 * nb, 64 * kb, scr, lane); continue; } r -= N2;
            if (r < N3) { const int nb = r % 16, kb = r / 16; const int h = nb / 2, q = nb % 2;
                tr_block(kb < 2 ? F.in[I_WKVUP] : nullptr, 1024, 64 * kb, 128 * h + 32 * q, 0, F.in[I_GKV], nullptr, Wk, 256, 32 * nb, 64 * kb, scr, lane); continue; } r -= N3;
            if (r < N4) { const int nb = r % 16, kb = r / 16; const int h = nb / 2, q = nb % 2;
                tr_block(kb < 2 ? F.in[I_WKVUP] : nullptr, 1024, 64 * kb, 128 * h + 64 + 32 * q, 0, F.in[I_GKV], nullptr, Wv, 256, 32 * nb, 64 * kb, scr, lane); continue; } r -= N4;
            if (r < N5) { const int nb = r % 16, kb = r / 16; const int g = nb / 4; const bool dg = (kb / 2) == g;
                tr_block(dg ? F.in[I_WPG] + (size_t)g * 128 * 128 : nullptr, 128, 64 * (kb % 2), 32 * (nb % 4), 0, nullptr, F.in[I_PSCALE] + g * 128 + 32 * (nb % 4), Wg, 512, 32 * nb, 64 * kb, scr, lane); continue; } r -= N5;
            if (r < N6) { const int nb = r % 32, kb = r / 32; tr_block(F.in[I_WPO], 1024, 64 * kb, 32 * nb, 0, nullptr, nullptr, Wpo, 512, 32 * nb, 64 * kb, scr, lane); continue; } r -= N6;
            if (r < N7) { const int nb = r % 32, kb = r / 32; tr_block(F.in[I_WMO], 1024, 64 * kb, 32 * nb, 0, nullptr, nullptr, Wmo, 512, 32 * nb, 64 * kb, scr, lane); continue; } r -= N7;
            if (r < N8) { const int nb = r % 32, kb = r / 32; tr_block(F.in[I_WOUT], 1024, 64 * kb, 32 * nb, 0, nullptr, nullptr, Wout, 1024, 32 * nb, 64 * kb, scr, lane); continue; } r -= N8;
            { const int nb = r % 64, kb = r / 64; tr_block(F.in[I_WQY], 2048, 64 * kb, 32 * nb, 0, nullptr, nullptr, Wqy, 1024, 32 * nb, 64 * kb, scr, lane); }
        }
    }
    {
        bf16* sk = (bf16*)(ws + WS_SK);
        const int gt = (F.vcu * NWAVES * 64) + F.wave * 64 + lane, NGT = F.G * NWAVES * 64;
        for (int i = gt; i < 2 * 131072 / 8; i += NGT) { const int side = i / 16384, o = (i % 16384) * 8; const float* s = F.in[side ? I_SK2 : I_SK1] + o;
            *(u32x4*)(sk + (size_t)side * 131072 + o) = pack8(*(const f32x4*)s, *(const f32x4*)(s + 4)); }
        float* rope = (float*)(ws + WS_ROPE);
        for (int i = gt; i < SEQ * 16; i += NGT) { const int pos = i >> 4, e = i & 15;
            const float frac[4] = {1.0f, 0.5623413251903491f, 0.31622776601683794f, 0.17782794100389228f};
            const float dec[4] = {1.0f, 0.1f, 0.01f, 0.001f};
            const float inv = (float)((double)dec[e >> 2] * (double)frac[e & 3]);
            const float ang = (float)pos * inv;
            const double rev = (double)ang * 0.15915494309189535;
            const float fr = (float)(rev - floor(rev));
            rope[pos * 32 + e] = __builtin_amdgcn_cosf(fr); rope[pos * 32 + 16 + e] = __builtin_amdgcn_sinf(fr); }
    }
}

__device__ __forceinline__ void p1_xn(Frame& F) {
    int lane_ = F.lane; asm volatile("" : "+v"(lane_));
    const int gw = F.vcu * NWAVES + F.wave, NGW = F.G * NWAVES, lane = lane_;
    const long long* mod = (const long long*)((const unsigned*)(F.ws + WS_CTL) + CW_MOD); const float* g = F.in[I_GPRE1]; bf16* xn = (bf16*)(F.ws + WS_R1);
    { float* modf = (float*)(F.ws + WS_CTL) + CW_MODF; for (int i = gw * 64 + lane; i < 4 * 6144; i += NGW * 64) modf[i] = fx_get(mod + i, 1.0 / MOD_FX); }
    for (int row = gw; row < T; row += NGW) {
        const f32x4* xr = (const f32x4*)(F.in[I_X] + (size_t)row * D) + lane; const long long* mb = mod + (row / SEQ) * 6144;
        f32x4 v[4]; float s = 0.f;
#pragma unroll
        for (int j = 0; j < 4; ++j) { v[j] = xr[64 * j]; s += (v[j].x * v[j].x + v[j].y * v[j].y) + (v[j].z * v[j].z + v[j].w * v[j].w); }
        const float rstd = rsqrtf(wave_sum(s) * (1.f / D) + RMS_EPS);
#pragma unroll
        for (int j = 0; j < 4; ++j) { const int col = 4 * lane + 256 * j;
            const f32x4 gg = *(const f32x4*)(g + col); f32x4 sh, sc;
#pragma unroll
            for (int i = 0; i < 4; ++i) { sh[i] = fx_get(mb + col + i, 1.0 / MOD_FX); sc[i] = fx_get(mb + 1024 + col + i, 1.0 / MOD_FX); }
            const f32x4 o = v[j] * rstd * gg * (sc + 1.0f) + sh;
            u32x2 w; w.x = cvtpk(o.x, o.y); w.y = cvtpk(o.z, o.w); *(u32x2*)(xn + (size_t)row * D + col) = w; }
    }
}
__device__ __forceinline__ void p3_pool(Frame& F) {
    const bf16* P = (const bf16*)(F.ws + WS_R2); bf16* PI = (bf16*)(F.ws + WS_PIN);
    int tid_ = F.tid; asm volatile("" : "+v"(tid_));
    const int gt = (F.vcu * NWAVES * 64) + tid_, NGT = F.G * NWAVES * 64;
    for (int i = gt; i < T * 64; i += NGT) {
        const int t = i >> 6, ch = (i & 63) * 8; const int s = t & (SEQ - 1); const int w = 2 << (ch >> 7); const int cnt = (s + 1 < w) ? s + 1 : w;
        f32x4 a0 = {0, 0, 0, 0}, a1 = a0, x0, x1;
        unpack8(*(const u32x4*)(P + (size_t)t * PROJ_N + ch), x0, x1);
        for (int j = 0; j < cnt; ++j) { f32x4 y0, y1; unpack8(*(const u32x4*)(P + (size_t)(t - j) * PROJ_N + ch), y0, y1); a0 += y0; a1 += y1; }
        const float ic = 1.0f / (float)cnt;
        *(u32x4*)(PI + (size_t)t * 512 + ch) = pack8(a0 * ic - x0, a1 * ic - x1);
    }
}
__device__ __forceinline__ void p7_rows(Frame& F) {
    int lane_ = F.lane; asm volatile("" : "+v"(lane_));
    const int gw = F.vcu * NWAVES + F.wave, NGW = F.G * NWAVES, lane = lane_;
    const float* mod = (const float*)(F.ws + WS_CTL) + CW_MODF; const bf16* Z = (const bf16*)(F.ws + WS_R2); bf16* xn = (bf16*)(F.ws + WS_R1);
    const float* gp1 = F.in[I_GPOST1]; const float* gp2 = F.in[I_GPRE2];
    for (int row = gw; row < T; row += NGW) {
        const float* mb = mod + (row / SEQ) * 6144;
        f32x4 z[4], h[4]; float s = 0.f;
#pragma unroll
        for (int j = 0; j < 4; ++j) { const u32x2 w = *(const u32x2*)(Z + (size_t)row * D + 4 * lane + 256 * j); z[j] = (f32x4){bflo(w.x), bfhi(w.x), bflo(w.y), bfhi(w.y)};
            s += (z[j].x * z[j].x + z[j].y * z[j].y) + (z[j].z * z[j].z + z[j].w * z[j].w); }
        const float rz = rsqrtf(wave_sum(s) * (1.f / D) + RMS_EPS); float s2 = 0.f;
#pragma unroll
        for (int j = 0; j < 4; ++j) { const int col = 4 * lane + 256 * j;
            const f32x4 x = *(const f32x4*)(F.in[I_X] + (size_t)row * D + col), g1 = *(const f32x4*)(mb + 2048 + col), gg = *(const f32x4*)(gp1 + col);
            h[j] = x + g1 * (z[j] * rz * gg); *(f32x4*)(F.out + (size_t)row * D + col) = (DIAG == 1) ? x : (DIAG == 4) ? (h[j] + (h[j] - x)) : h[j];
            s2 += (h[j].x * h[j].x + h[j].y * h[j].y) + (h[j].z * h[j].z + h[j].w * h[j].w); }
        const float rh = rsqrtf(wave_sum(s2) * (1.f / D) + RMS_EPS);
#pragma unroll
        for (int j = 0; j < 4; ++j) { const int col = 4 * lane + 256 * j;
            const f32x4 gg = *(const f32x4*)(gp2 + col), sh = *(const f32x4*)(mb + 3072 + col), sc = *(const f32x4*)(mb + 4096 + col);
            const f32x4 o = h[j] * rh * gg * (sc + 1.0f) + sh;
            u32x2 w; w.x = cvtpk(o.x, o.y); w.y = cvtpk(o.z, o.w); *(u32x2*)(xn + (size_t)row * D + col) = w; }
    }
}

constexpr int ATT_KP = 208, ATT_VP = 144, ATT_KB = 64 * ATT_KP, ATT_VB = 64 * ATT_VP;
__device__ __forceinline__ void attn_unit(int b, int h, int qb, const bf16* Qb, const bf16* Kb, const bf16* Vt, bf16* O, LAS unsigned char* lds) {
    int tid_ = threadIdx.x; asm volatile("" : "+v"(tid_));
    const int tid = tid_, lane = tid & 63, r32 = lane & 31, hi = lane >> 5; const int wid = __builtin_amdgcn_readfirstlane(tid >> 6);
    const int q0 = qb * 256, tok0 = b * SEQ, NT = (q0 + 256) / 64;
    const int kr0 = tid / 12, kc0 = tid % 12, kr1 = (tid + 512) / 12, kc1 = (tid + 512) % 12;
    const bf16* kg0 = Kb + (size_t)(tok0 + kr0) * 768 + h * QKD + kc0 * 8;
    const bf16* kg1 = Kb + (size_t)(tok0 + kr1) * 768 + h * QKD + kc1 * 8;
    const int kl0 = kr0 * ATT_KP + kc0 * 16, kl1 = kr1 * ATT_KP + kc1 * 16;
    const int vd = tid >> 3, vc = tid & 7;
    const bf16* vg = Vt + (size_t)(h * VD + vd) * T + tok0 + vc * 8;
    const int vl = 2 * ATT_KB + vd * ATT_VP + vc * 16;
    const bool k2 = tid < 256;
    const int qrow = tok0 + q0 + wid * 32 + r32; const int qpos = q0 + wid * 32 + r32;
    bf16x8 qf[6];
#pragma unroll
    for (int s = 0; s < 6; ++s) qf[s] = *(const bf16x8*)(Qb + (size_t)qrow * 768 + h * QKD + 16 * s + 8 * hi);
    const int krow = (r32 & ~12) | ((r32 & 4) << 1) | ((r32 & 8) >> 1);
    const int ka = krow * ATT_KP + hi * 16, va = 2 * ATT_KB + r32 * ATT_VP + hi * 16;
    f32x16 o0 = {}, o1 = {}; float mrun = -INFINITY, lrun = 0.f;
    u32x4 kx0, kx1, vx;
    kx0 = *(const u32x4*)kg0; kx1 = k2 ? *(const u32x4*)kg1 : (u32x4){0, 0, 0, 0}; vx = *(const u32x4*)vg;
    *(LAS u32x4*)(lds + kl0) = kx0; if (k2) *(LAS u32x4*)(lds + kl1) = kx1; *(LAS u32x4*)(lds + vl) = vx;
    __syncthreads();
    for (int t = 0; t < NT; ++t) {
        const int cb = t & 1, nb = cb ^ 1;
        const bool more = t + 1 < NT;
        if (more) { kx0 = *(const u32x4*)(kg0 + (size_t)(t + 1) * 64 * 768); if (k2) kx1 = *(const u32x4*)(kg1 + (size_t)(t + 1) * 64 * 768); vx = *(const u32x4*)(vg + (t + 1) * 64); }
        const int kv0 = t * 64;
        if (kv0 <= q0 + wid * 32 + 31) {
            f32x16 p0 = {}, p1 = {};
            const LAS unsigned char* kb = lds + cb * ATT_KB + ka;
#pragma unroll
            for (int s = 0; s < 6; ++s) {
                const bf16x8 a0 = *(const LAS bf16x8*)(kb + s * 32), a1 = *(const LAS bf16x8*)(kb + 32 * ATT_KP + s * 32);
                p0 = __builtin_amdgcn_mfma_f32_32x32x16_bf16(a0, qf[s], p0, 0, 0, 0);
                p1 = __builtin_amdgcn_mfma_f32_32x32x16_bf16(a1, qf[s], p1, 0, 0, 0);
            }
            if (kv0 + 63 > q0 + wid * 32) {
#pragma unroll
                for (int r = 0; r < 16; ++r) { const int kv = kv0 + (r & 7) + 8 * hi + 16 * (r >> 3); if (kv > qpos) p0[r] = -INFINITY; if (kv + 32 > qpos) p1[r] = -INFINITY; }
            }
            float mx = fmaxf(p0[0], p1[0]);
#pragma unroll
            for (int r = 1; r < 16; ++r) mx = fmaxf(mx, fmaxf(p0[r], p1[r]));
            mx = fmaxf(mx, __shfl_xor(mx, 32));
            const float mnew = fmaxf(mrun, mx); const float alpha = __builtin_amdgcn_exp2f(mrun - mnew); mrun = mnew;
            float ls = 0.f;
#pragma unroll
            for (int r = 0; r < 16; ++r) { p0[r] = __builtin_amdgcn_exp2f(p0[r] - mnew); p1[r] = __builtin_amdgcn_exp2f(p1[r] - mnew); ls += p0[r] + p1[r]; }
            lrun = lrun * alpha + ls;
#pragma unroll
            for (int r = 0; r < 16; ++r) { o0[r] *= alpha; o1[r] *= alpha; }
            u32x4 pb[4];
            pb[0] = (u32x4){cvtpk(p0[0], p0[1]), cvtpk(p0[2], p0[3]), cvtpk(p0[4], p0[5]), cvtpk(p0[6], p0[7])};
            pb[1] = (u32x4){cvtpk(p0[8], p0[9]), cvtpk(p0[10], p0[11]), cvtpk(p0[12], p0[13]), cvtpk(p0[14], p0[15])};
            pb[2] = (u32x4){cvtpk(p1[0], p1[1]), cvtpk(p1[2], p1[3]), cvtpk(p1[4], p1[5]), cvtpk(p1[6], p1[7])};
            pb[3] = (u32x4){cvtpk(p1[8], p1[9]), cvtpk(p1[10], p1[11]), cvtpk(p1[12], p1[13]), cvtpk(p1[14], p1[15])};
            const LAS unsigned char* vb = lds + cb * ATT_VB + va;
#pragma unroll
            for (int ks = 0; ks < 4; ++ks) {
                const bf16x8 a0 = *(const LAS bf16x8*)(vb + ks * 32), a1 = *(const LAS bf16x8*)(vb + 32 * ATT_VP + ks * 32);
                const bf16x8 pbv = __builtin_bit_cast(bf16x8, pb[ks]);
                o0 = __builtin_amdgcn_mfma_f32_32x32x16_bf16(a0, pbv, o0, 0, 0, 0);
                o1 = __builtin_amdgcn_mfma_f32_32x32x16_bf16(a1, pbv, o1, 0, 0, 0);
            }
        }
        if (more) { *(LAS u32x4*)(lds + nb * ATT_KB + kl0) = kx0; if (k2) *(LAS u32x4*)(lds + nb * ATT_KB + kl1) = kx1; *(LAS u32x4*)(lds + nb * ATT_VB + vl) = vx; }
        __syncthreads();
    }
    const float lt = lrun + __shfl_xor(lrun, 32); const float il = 1.0f / lt;
    bf16* op = O + (size_t)qrow * 512 + h * VD;
#pragma unroll
    for (int rg = 0; rg < 4; ++rg) {
        u32x2 w0, w1; w0.x = cvtpk(o0[4 * rg] * il, o0[4 * rg + 1] * il); w0.y = cvtpk(o0[4 * rg + 2] * il, o0[4 * rg + 3] * il);
        w1.x = cvtpk(o1[4 * rg] * il, o1[4 * rg + 1] * il); w1.y = cvtpk(o1[4 * rg + 2] * il, o1[4 * rg + 3] * il);
        *(u32x2*)(op + 8 * rg + 4 * hi) = w0; *(u32x2*)(op + 32 + 8 * rg + 4 * hi) = w1;
    }
}
__device__ __forceinline__ void p4_attention(Frame& F) {
    const bf16* Qb = (const bf16*)(F.ws + WS_R1); const bf16* Kb = (const bf16*)(F.ws + WS_KB); const bf16* Vt = (const bf16*)(F.ws + WS_VT); bf16* O = (bf16*)(F.ws + WS_AO);
    for (int p = F.vcu; p < 256; p += F.G) {
        const int bh = p >> 3, s = p & 7;
        attn_unit(bh >> 3, bh & 7, 15 - s, Qb, Kb, Vt, O, F.lds);
        attn_unit(bh >> 3, bh & 7, s, Qb, Kb, Vt, O, F.lds);
    }
}

__device__ __forceinline__ int mono(float x) { const int b = __float_as_int(x); return b ^ ((b >> 31) & 0x7fffffff); }
__device__ __forceinline__ float unmono(int k) { return __int_as_float(k ^ ((k >> 31) & 0x7fffffff)); }
#define TK_INS(L, xx) do { int _x = (xx); _Pragma("unroll") for (int _i = 0; _i < 16; ++_i) { const int _t = max(L[_i], _x); _x = min(L[_i], _x); L[_i] = _t; } } while (0)
__device__ __forceinline__ void peer_side(const bf16* qp, const bf16* sk, int r32, int hi, int (&L)[16]) {
    bf16x8 qf[8];
#pragma unroll
    for (int s = 0; s < 8; ++s) qf[s] = *(const bf16x8*)(qp + 16 * s + 8 * hi);
#pragma unroll
    for (int i = 0; i < 16; ++i) L[i] = (int)0x80000000;
#pragma unroll
    for (int kt = 0; kt < 4; ++kt) {
        f32x16 acc = {};
#pragma unroll
        for (int s = 0; s < 8; ++s) { const bf16x8 a = *(const bf16x8*)(sk + (size_t)(32 * kt + r32) * 128 + 16 * s + 8 * hi); acc = __builtin_amdgcn_mfma_f32_32x32x16_bf16(a, qf[s], acc, 0, 0, 0); }
#pragma unroll
        for (int r = 0; r < 16; ++r) { const int key = 32 * kt + (r & 3) + 8 * (r >> 2); TK_INS(L, (mono(acc[r]) & ~127) | (127 - key)); }
        asm volatile("" ::: "memory");
    }
    int Oth[16];
#pragma unroll
    for (int i = 0; i < 16; ++i) { L[i] ^= (hi << 2); Oth[i] = __shfl_xor(L[i], 32); }
#pragma unroll
    for (int i = 0; i < 16; ++i) TK_INS(L, Oth[i]);
}
__device__ __forceinline__ void p9_peer_topk(Frame& F) {
    const bf16* QP = (const bf16*)(F.ws + WS_R2); const bf16* SK = (const bf16*)(F.ws + WS_SK);
    int* eidx = (int*)(F.ws + WS_EIDX); float* gate = (float*)(F.ws + WS_GATE);
    int lane_ = F.lane; asm volatile("" : "+v"(lane_));
    const int gw = F.vcu * NWAVES + F.wave, NGW = F.G * NWAVES, lane = lane_, r32 = lane & 31, hi = lane >> 5;
    LAS int* tab = (LAS int*)(F.lds + F.wave * 8192);
    for (int it = gw; it < (T / 32) * PEER_H; it += NGW) {
        const int h = it & 7, tb = it >> 3; const int tok = tb * 32 + r32;
        int L1[16], L2[16], L3[16];
        peer_side(QP + (size_t)tok * 2048 + h * 256, SK + (size_t)h * 16384, r32, hi, L1);
        peer_side(QP + (size_t)tok * 2048 + h * 256 + 128, SK + 131072 + (size_t)h * 16384, r32, hi, L2);
        float v1[16], v2[16];
#pragma unroll
        for (int i = 0; i < 16; ++i) { v1[i] = unmono(L1[i] & ~127); v2[i] = unmono(L2[i] & ~127); tab[i * 64 + lane] = 127 - (L1[i] & 127); tab[(16 + i) * 64 + lane] = 127 - (L2[i] & 127); L3[i] = (int)0x80000000; }
#pragma unroll
        for (int a = 0; a < 16; ++a)
#pragma unroll
            for (int b = 0; b < 16; ++b) if ((a + 1) * (b + 1) <= 16) TK_INS(L3, (mono(v1[a] + v2[b]) & ~255) | (255 - (a * 16 + b)));
        float sc[16], ssum = 0.f; int ei[16];
#pragma unroll
        for (int k = 0; k < 16; ++k) { const int ci = 255 - (L3[k] & 255); sc[k] = unmono(L3[k] & ~255);
            ei[k] = tab[(ci >> 4) * 64 + lane] * 128 + tab[(16 + (ci & 15)) * 64 + lane]; }
        const float smax = sc[0];
#pragma unroll
        for (int k = 0; k < 16; ++k) { sc[k] = __builtin_amdgcn_exp2f((sc[k] - smax) * 1.4426950408889634f); ssum += sc[k]; }
        const float inv = 1.0f / ssum;
        const size_t ob = ((size_t)tok * PEER_H + h) * PEER_K;
        if (hi == 0) {
#pragma unroll
            for (int k = 0; k < 16; k += 4) *(u32x4*)(eidx + ob + k) = (u32x4){(unsigned)ei[k], (unsigned)ei[k + 1], (unsigned)ei[k + 2], (unsigned)ei[k + 3]};
        } else {
#pragma unroll
            for (int k = 0; k < 16; k += 4) *(f32x4*)(gate + ob + k) = (f32x4){sc[k] * inv, sc[k + 1] * inv, sc[k + 2] * inv, sc[k + 3] * inv};
        }
        LDS_WAIT();
    }
}
constexpr float EU_SCALE = 32.0f, EV_SCALE = 8.0f;
__device__ __forceinline__ unsigned pk4_fp8(f32x4 v, float sc) { int r = __builtin_amdgcn_cvt_pk_fp8_f32(v[0] * sc, v[1] * sc, 0, false); r = __builtin_amdgcn_cvt_pk_fp8_f32(v[2] * sc, v[3] * sc, r, true); return (unsigned)r; }
__device__ __forceinline__ void cvt_experts(Frame& F) {
    int tid_ = F.tid; asm volatile("" : "+v"(tid_));
    const int gt = (F.vcu * NWAVES * 64) + tid_, NGT = F.G * NWAVES * 64;
    const float* su = F.in[I_EU]; const float* sv = F.in[I_EV]; unsigned char* du = F.ws + WS_EU; unsigned char* dv = F.ws + WS_EV;
    for (int i = gt; i < 16384 * 1024 / 16; i += NGT) { const size_t o = (size_t)i * 16;
        u32x4 a, b;
        a.x = pk4_fp8(*(const f32x4*)(su + o), EU_SCALE); a.y = pk4_fp8(*(const f32x4*)(su + o + 4), EU_SCALE); a.z = pk4_fp8(*(const f32x4*)(su + o + 8), EU_SCALE); a.w = pk4_fp8(*(const f32x4*)(su + o + 12), EU_SCALE);
        b.x = pk4_fp8(*(const f32x4*)(sv + o), EV_SCALE); b.y = pk4_fp8(*(const f32x4*)(sv + o + 4), EV_SCALE); b.z = pk4_fp8(*(const f32x4*)(sv + o + 8), EV_SCALE); b.w = pk4_fp8(*(const f32x4*)(sv + o + 12), EV_SCALE);
        *(u32x4*)(du + o) = a; *(u32x4*)(dv + o) = b; }
}

#define FMAC_V(acc, a, b) asm("v_fmac_f32_e32 %0, %1, %2" : "+v"(acc) : "v"(a), "v"(b))
#define FMAC_S(acc, ws, b) asm("v_fmac_f32_e32 %0, %1, %2" : "+v"(acc) : "s"(ws), "v"(b))
__device__ __forceinline__ float dot16_fp8(u32x4 r, const float (&x)[16]) {
    float a = 0.f, b = 0.f; f32x2 t;
    t = __builtin_amdgcn_cvt_pk_f32_fp8((int)r.x, false); FMAC_V(a, t.x, x[0]);  FMAC_V(b, t.y, x[1]);
    t = __builtin_amdgcn_cvt_pk_f32_fp8((int)r.x, true);  FMAC_V(a, t.x, x[2]);  FMAC_V(b, t.y, x[3]);
    t = __builtin_amdgcn_cvt_pk_f32_fp8((int)r.y, false); FMAC_V(a, t.x, x[4]);  FMAC_V(b, t.y, x[5]);
    t = __builtin_amdgcn_cvt_pk_f32_fp8((int)r.y, true);  FMAC_V(a, t.x, x[6]);  FMAC_V(b, t.y, x[7]);
    t = __builtin_amdgcn_cvt_pk_f32_fp8((int)r.z, false); FMAC_V(a, t.x, x[8]);  FMAC_V(b, t.y, x[9]);
    t = __builtin_amdgcn_cvt_pk_f32_fp8((int)r.z, true);  FMAC_V(a, t.x, x[10]); FMAC_V(b, t.y, x[11]);
    t = __builtin_amdgcn_cvt_pk_f32_fp8((int)r.w, false); FMAC_V(a, t.x, x[12]); FMAC_V(b, t.y, x[13]);
    t = __builtin_amdgcn_cvt_pk_f32_fp8((int)r.w, true);  FMAC_V(a, t.x, x[14]); FMAC_V(b, t.y, x[15]);
    return a + b;
}
__device__ __forceinline__ void axpy16_fp8(float (&y)[16], float w, u32x4 r) {
    f32x2 t;
    t = __builtin_amdgcn_cvt_pk_f32_fp8((int)r.x, false); FMAC_S(y[0], w, t.x);  FMAC_S(y[1], w, t.y);
    t = __builtin_amdgcn_cvt_pk_f32_fp8((int)r.x, true);  FMAC_S(y[2], w, t.x);  FMAC_S(y[3], w, t.y);
    t = __builtin_amdgcn_cvt_pk_f32_fp8((int)r.y, false); FMAC_S(y[4], w, t.x);  FMAC_S(y[5], w, t.y);
    t = __builtin_amdgcn_cvt_pk_f32_fp8((int)r.y, true);  FMAC_S(y[6], w, t.x);  FMAC_S(y[7], w, t.y);
    t = __builtin_amdgcn_cvt_pk_f32_fp8((int)r.z, false); FMAC_S(y[8], w, t.x);  FMAC_S(y[9], w, t.y);
    t = __builtin_amdgcn_cvt_pk_f32_fp8((int)r.z, true);  FMAC_S(y[10], w, t.x); FMAC_S(y[11], w, t.y);
    t = __builtin_amdgcn_cvt_pk_f32_fp8((int)r.w, false); FMAC_S(y[12], w, t.x); FMAC_S(y[13], w, t.y);
    t = __builtin_amdgcn_cvt_pk_f32_fp8((int)r.w, true);  FMAC_S(y[14], w, t.x); FMAC_S(y[15], w, t.y);
}
__device__ __forceinline__ void sort128(int& k0, int& k1, int lane) {
#pragma unroll
    for (int k = 2; k <= 128; k <<= 1) {
#pragma unroll
        for (int j = k >> 1; j > 0; j >>= 1) {
            if (j == 64) { const int lo = min(k0, k1), hi = max(k0, k1); k0 = lo; k1 = hi; }
            else {
                const bool lower = (lane & j) == 0;
                const int p0 = __shfl_xor(k0, j), p1 = __shfl_xor(k1, j);
                const bool up0 = (k == 128) ? true : (k == 64) ? true : ((lane & k) == 0);
                const bool up1 = (k == 128) ? true : (k == 64) ? false : ((lane & k) == 0);
                k0 = (lower == up0) ? min(k0, p0) : max(k0, p0);
                k1 = (lower == up1) ? min(k1, p1) : max(k1, p1);
            }
        }
    }
}
typedef int i32x4 __attribute__((ext_vector_type(4)));
__device__ __forceinline__ u32x4 row_load(__amdgpu_buffer_rsrc_t rsrc, int lane16, int e) { return __builtin_bit_cast(u32x4, __builtin_amdgcn_raw_buffer_load_b128(rsrc, lane16, e << 10, 0)); }
template <bool DRY> __device__ __forceinline__ void p10_peer_experts(Frame& F) {
    int lane_ = F.lane; asm volatile("" : "+v"(lane_));
    const int gw = F.vcu * NWAVES + F.wave, NGW = F.G * NWAVES, lane = lane_, lane16 = lane * 16;
    const bf16* XN = (const bf16*)(F.ws + WS_R1);
    const __amdgpu_buffer_rsrc_t ru = __builtin_amdgcn_make_buffer_rsrc((void*)(F.ws + WS_EU), 0, 16384 * 1024, 0x00020000), rv = __builtin_amdgcn_make_buffer_rsrc((void*)(F.ws + WS_EV), 0, 16384 * 1024, 0x00020000);
    const int* eidx = (const int*)(F.ws + WS_EIDX); const float* gate = (const float*)(F.ws + WS_GATE);
    const float* mod = (const float*)(F.ws + WS_CTL) + CW_MODF; const float* gp = F.in[I_GPOST2];
    const int b5 = (lane >> 5) & 1, b4 = (lane >> 4) & 1, b3 = (lane >> 3) & 1, b2 = (lane >> 2) & 1;
    const int eloc = b5 * 8 + b4 * 4 + b3 * 2 + b2;
    for (int tok = gw; tok < T; tok += NGW) {
        float x[16];
        { const u32x4 xa = *(const u32x4*)(XN + (size_t)tok * D + 16 * lane), xb = *(const u32x4*)(XN + (size_t)tok * D + 16 * lane + 8);
          x[0] = bflo(xa.x); x[1] = bfhi(xa.x); x[2] = bflo(xa.y); x[3] = bfhi(xa.y); x[4] = bflo(xa.z); x[5] = bfhi(xa.z); x[6] = bflo(xa.w); x[7] = bfhi(xa.w);
          x[8] = bflo(xb.x); x[9] = bfhi(xb.x); x[10] = bflo(xb.y); x[11] = bfhi(xb.y); x[12] = bflo(xb.z); x[13] = bfhi(xb.z); x[14] = bflo(xb.w); x[15] = bfhi(xb.w); }
        int k0 = (eidx[(size_t)tok * 128 + lane] << 7) | lane, k1 = (eidx[(size_t)tok * 128 + 64 + lane] << 7) | (64 + lane);
        sort128(k0, k1, lane);
        float y[16];
#pragma unroll
        for (int i = 0; i < 16; ++i) y[i] = 0.f;
        u32x4 U[16], V[16];
#pragma unroll
        for (int j = 0; j < 16; ++j) U[j] = row_load(ru, lane16, __builtin_amdgcn_readlane(k0, j) >> 7);
        for (int kb = 0; kb < 8; ++kb) {
            const int kv = kb < 4 ? k0 : k1; const int lb = (kb & 3) * 16;
#pragma unroll
            for (int j = 0; j < 16; ++j) V[j] = row_load(rv, lane16, __builtin_amdgcn_readlane(kv, lb + j) >> 7);
            __builtin_amdgcn_sched_barrier(0);
            float p[16];
#pragma unroll
            for (int j = 0; j < 16; ++j) p[j] = dot16_fp8(U[j], x);
            float q[8], r4[4], s2[2], tt;
#pragma unroll
            for (int j = 0; j < 8; ++j) { const float keep = b5 ? p[j + 8] : p[j], send = b5 ? p[j] : p[j + 8]; q[j] = keep + __shfl_xor(send, 32); }
#pragma unroll
            for (int j = 0; j < 4; ++j) { const float keep = b4 ? q[j + 4] : q[j], send = b4 ? q[j] : q[j + 4]; r4[j] = keep + __shfl_xor(send, 16); }
#pragma unroll
            for (int j = 0; j < 2; ++j) { const float keep = b3 ? r4[j + 2] : r4[j], send = b3 ? r4[j] : r4[j + 2]; s2[j] = keep + __shfl_xor(send, 8); }
            { const float keep = b2 ? s2[1] : s2[0], send = b2 ? s2[0] : s2[1]; tt = keep + __shfl_xor(send, 4); }
            tt += __shfl_xor(tt, 2); tt += __shfl_xor(tt, 1);
            tt *= (1.0f / EU_SCALE);
            const int pidx = __shfl(kv, lb + eloc) & 127;
            const float g = gate[(size_t)tok * 128 + pidx];
            const float u3 = 0.7978845608028654f * (tt + 0.044715f * tt * tt * tt);
            const float w = g * tt * sigmoidf_(2.0f * u3) * (1.0f / EV_SCALE);
            if (kb < 7) { const int kn = (kb + 1) < 4 ? k0 : k1; const int ln = ((kb + 1) & 3) * 16;
#pragma unroll
                for (int j = 0; j < 16; ++j) U[j] = row_load(ru, lane16, __builtin_amdgcn_readlane(kn, ln + j) >> 7); }
            __builtin_amdgcn_sched_barrier(0);
#pragma unroll
            for (int j = 0; j < 16; ++j) {
                const int sl = ((j >> 3) & 1) * 32 + ((j >> 2) & 1) * 16 + ((j >> 1) & 1) * 8 + (j & 1) * 4;
                const float wj = __int_as_float(__builtin_amdgcn_readlane(__float_as_int(w), sl));
                axpy16_fp8(y, wj, V[j]); }
        }
        float ss = 0.f;
#pragma unroll
        for (int i = 0; i < 16; ++i) ss += y[i] * y[i];
        const float rstd = rsqrtf(wave_sum(ss) * (1.f / D) + RMS_EPS);
        const float* mb = mod + (tok / SEQ) * 6144 + 5 * 1024; float* orow = DRY ? (float*)(F.ws + WS_AO) + (size_t)(tok & 1023) * D : F.out + (size_t)tok * D;
#pragma unroll
        for (int c = 0; c < 4; ++c) { const int col = 16 * lane + 4 * c;
            const f32x4 yy = {y[4 * c], y[4 * c + 1], y[4 * c + 2], y[4 * c + 3]};
            const f32x4 h0 = *(const f32x4*)(orow + col), g0 = *(const f32x4*)(mb + col), p0 = *(const f32x4*)(gp + col);
            *(f32x4*)(orow + col) = h0 + g0 * (yy * rstd * p0); }
    }
}

__device__ __forceinline__ void p9_bruteforce(Frame& F) {
    const bf16* QP = (const bf16*)(F.ws + WS_R2);
    int* eidx = (int*)(F.ws + WS_EIDX); float* gate = (float*)(F.ws + WS_GATE);
    LAS float* sc = (LAS float*)(F.lds);
    (void)sc;
    float* scr = (float*)(F.ws + WS_PIN);
    (void)scr;
    const int gt = (F.vcu * NWAVES * 64) + F.tid, NGT = F.G * NWAVES * 64;
    for (int it = gt; it < T * 8; it += NGT) {
        const int tok = it >> 3, h = it & 7;
        float v[2][16]; int ix[2][16];
        for (int side = 0; side < 2; ++side) {
            const float* K = F.in[side ? I_SK2 : I_SK1] + (size_t)h * 16384;
            const bf16* q = QP + (size_t)tok * 2048 + h * 256 + side * 128;
            float prev = INFINITY; int previ = -1;
            for (int k = 0; k < 16; ++k) {
                float best = -INFINITY; int bi = -1;
                for (int key = 0; key < 128; ++key) {
                    float s = 0.f;
                    for (int d = 0; d < 128; ++d) s += __uint_as_float((unsigned)q[d] << 16) * K[key * 128 + d];
                    const bool after = (s < prev) || (s == prev && key > previ);
                    if (after && (s > best)) { best = s; bi = key; }
                }
                v[side][k] = best; ix[side][k] = bi; prev = best; previ = bi;
            }
        }
        float prev = INFINITY; int previ = -1; float scs[16]; int es[16];
        for (int k = 0; k < 16; ++k) {
            float best = -INFINITY; int bi = -1;
            for (int c = 0; c < 256; ++c) { const float s = v[0][c >> 4] + v[1][c & 15]; const bool after = (s < prev) || (s == prev && c > previ); if (after && s > best) { best = s; bi = c; } }
            scs[k] = best; es[k] = ix[0][bi >> 4] * 128 + ix[1][bi & 15]; prev = best; previ = bi;
        }
        float ssum = 0.f; for (int k = 0; k < 16; ++k) { scs[k] = __expf(scs[k] - scs[0]); ssum += scs[k]; }
        scs[0] = 1.0f;
        for (int k = 0; k < 16; ++k) { eidx[(size_t)it * 16 + k] = es[k]; gate[(size_t)it * 16 + k] = scs[k] / ssum; }
    }
}
__device__ __forceinline__ void p10_bruteforce(Frame& F) {
    const int gw = F.vcu * NWAVES + F.wave, NGW = F.G * NWAVES, lane = F.lane;
    const bf16* XN = (const bf16*)(F.ws + WS_R1); const float* EU = F.in[I_EU]; const float* EV = F.in[I_EV];
    const int* eidx = (const int*)(F.ws + WS_EIDX); const float* gate = (const float*)(F.ws + WS_GATE);
    const float* mod = (const float*)(F.ws + WS_CTL) + CW_MODF; const float* gp = F.in[I_GPOST2];
    for (int tok = gw; tok < T; tok += NGW) {
        float x[16], y[16];
        for (int i = 0; i < 16; ++i) { x[i] = __uint_as_float((unsigned)XN[(size_t)tok * D + lane + 64 * i] << 16); y[i] = 0.f; }
        for (int k = 0; k < 128; ++k) {
            const int e = eidx[(size_t)tok * 128 + k]; const float g = gate[(size_t)tok * 128 + k];
            float p = 0.f;
            for (int i = 0; i < 16; ++i) p += x[i] * EU[(size_t)e * D + lane + 64 * i];
            p = wave_sum(p);
            const float u3 = 0.7978845608028654f * (p + 0.044715f * p * p * p);
            const float w = g * 0.5f * p * (1.0f + tanhf(u3));
            for (int i = 0; i < 16; ++i) y[i] += w * EV[(size_t)e * D + lane + 64 * i];
        }
        float ss = 0.f; for (int i = 0; i < 16; ++i) ss += y[i] * y[i];
        const float rstd = rsqrtf(wave_sum(ss) * (1.f / D) + RMS_EPS);
        const float* mb = mod + (tok / SEQ) * 6144 + 5 * 1024; float* orow = F.out + (size_t)tok * D;
        for (int i = 0; i < 16; ++i) { const int col = lane + 64 * i; orow[col] = orow[col] + mb[col] * (y[i] * rstd * gp[col]); }
    }
}
#ifndef PH_MASK
#define PH_MASK 0xFFFFFFFFu
#endif
#define PH(k) ((PH_MASK >> (k)) & 1u)
__global__ void __launch_bounds__(NWAVES * 64, 2) fwd_megakernel(Args args) {
    extern __shared__ __attribute__((aligned(16))) unsigned char lds_raw[];
    Frame F;
    F.lds = (LAS unsigned char*)lds_raw;
    F.tid = threadIdx.x; F.lane = F.tid & 63; F.wave = __builtin_amdgcn_readfirstlane(F.tid >> 6);
    F.G = gridDim.x; { const int bx = blockIdx.x; F.vcu = (F.G % 8 == 0) ? (bx % 8) * (F.G / 8) + bx / 8 : bx; }
    F.in = args.in; F.out = args.out; F.ws = args.ws;
    unsigned char* ws = args.ws;
    volatile LAS unsigned* MISC = (volatile LAS unsigned*)(F.lds + LDSCTL_OFF);
    for (int u = F.tid; u < 64; u += NWAVES * 64) MISC[u] = 0u;
    __syncthreads();
    XcdBarrier bar = xcd_barrier_post((unsigned*)(ws + WS_CTL) + CW_BAR, MISC + 8);
#define GRID_BAR() xcd_barrier(bar)
    using namespace pg8;
    long long* rsq = (long long*)((unsigned*)(ws + WS_CTL) + CW_RSQ); long long* rsk = (long long*)((unsigned*)(ws + WS_CTL) + CW_RSK); const float* rope = (const float*)(ws + WS_ROPE);
    bf16* PROJ = (bf16*)(ws + WS_R2);
    if (PH(0)) p0_prologue(F); GRID_BAR();
    if (PH(1)) p1_xn(F); GRID_BAR();
    if (PH(2)) { Gemm g{(const bf16*)(ws + WS_R1), (const bf16*)(ws + WS_WIN), T, PROJ_N, 1024, 1024, 1024}; StaticOrder S; S.init(T, PROJ_N, F.G, (int)blockIdx.x);
      EpiProj E{PROJ, (bf16*)(ws + WS_KB), rsq, rsk, rope}; gemm_phase<EpiProj, true>(F.lds, g, S, E); }
    GRID_BAR();
    if (PH(3)) p3_pool(F);
    if (PH(4)) { Gemm g{PROJ + 512, (const bf16*)(ws + WS_WQ), T, 768, 256, PROJ_N, 256}; StaticOrder S; S.init(T, 768, F.G, (int)blockIdx.x);
      EpiQ E{(bf16*)(ws + WS_R1), rsq, rope}; gemm_phase<EpiQ, true>(F.lds, g, S, E); }
    if (PH(5)) { Gemm g{PROJ + 768, (const bf16*)(ws + WS_WK), T, 512, 256, PROJ_N, 256}; StaticOrder S; S.init(T, 512, F.G, (int)blockIdx.x);
      EpiKn E{(bf16*)(ws + WS_KB), rsk}; gemm_phase<EpiKn, true>(F.lds, g, S, E); }
    if (PH(6)) { Gemm g{(const bf16*)(ws + WS_WV), PROJ + 768, 512, T, 256, 256, PROJ_N}; StaticOrder S; S.init(512, T, F.G, (int)blockIdx.x);
      EpiVt E{(bf16*)(ws + WS_VT), rsk}; gemm_phase<EpiVt, true>(F.lds, g, S, E); }
    GRID_BAR();
    if (PH(7)) { Gemm g{(const bf16*)(ws + WS_PIN), (const bf16*)(ws + WS_WG), T, 512, 512, 512, 512}; StaticOrder S; S.init(T, 512, F.G, (int)blockIdx.x);
      EpiPlain E{(bf16*)(ws + WS_PF), 512}; gemm_phase<EpiPlain, true>(F.lds, g, S, E); }
    if (PH(8)) p4_attention(F);
#if defined(DUP_ATT)
    p4_attention(F);
#endif
    GRID_BAR();
    if (PH(9)) { Gemm g{(const bf16*)(ws + WS_PF), (const bf16*)(ws + WS_WPO), T, 1024, 512, 512, 512}; StaticOrder S; S.init(T, 1024, F.G, (int)blockIdx.x);
      EpiGate<0> E{(bf16*)(ws + WS_MRG), PROJ, 1024}; gemm_phase<EpiGate<0>, true>(F.lds, g, S, E); }
    asm volatile("s_waitcnt vmcnt(0)" ::: "memory"); __syncthreads();
    if (PH(10)) { Gemm g{(const bf16*)(ws + WS_AO), (const bf16*)(ws + WS_WMO), T, 1024, 512, 512, 512}; StaticOrder S; S.init(T, 1024, F.G, (int)blockIdx.x);
      EpiGate<1> E{(bf16*)(ws + WS_MRG), PROJ, 2048}; gemm_phase<EpiGate<1>, true>(F.lds, g, S, E); }
    GRID_BAR();
    if (PH(11)) { Gemm g{(const bf16*)(ws + WS_MRG), (const bf16*)(ws + WS_WOUT), T, 1024, 1024, 1024, 1024}; StaticOrder S; S.init(T, 1024, F.G, (int)blockIdx.x);
      EpiPlain E{(bf16*)(ws + WS_R2), 1024}; gemm_phase<EpiPlain, true>(F.lds, g, S, E); }
    GRID_BAR();
    if (PH(12)) p7_rows(F); GRID_BAR();
    if (PH(13)) { Gemm g{(const bf16*)(ws + WS_R1), (const bf16*)(ws + WS_WQY), T, 2048, 1024, 1024, 1024}; StaticOrder S; S.init(T, 2048, F.G, (int)blockIdx.x);
      EpiPlain E{(bf16*)(ws + WS_R2), 2048}; gemm_phase<EpiPlain, true>(F.lds, g, S, E); }
    GRID_BAR();
    if (PH(14)) cvt_experts(F);
#if defined(BF_P9)
    if (PH(15)) p9_bruteforce(F);
#else
    if (PH(15)) p9_peer_topk(F);
#if defined(DUP_TOPK)
    p9_peer_topk(F);
#endif
#endif
    GRID_BAR();
#if defined(BF_P10)
    if (PH(16)) p10_bruteforce(F);
#else
#if defined(DUP_P10)
    p10_peer_experts<true>(F);
#endif
    if (PH(16)) p10_peer_experts<false>(F);
#endif
}

extern "C" void kernel_launch(void* const* d_in, const int* in_sizes, int n_in, void* d_out, int out_size, void* d_ws, size_t ws_size, hipStream_t stream) {
    static int grid = 0;
    if (grid == 0) {
        if (n_in != 23 || out_size != T * D || ws_size < WS_END) { fprintf(stderr, "kernel_launch: unexpected shapes (n_in %d out %d ws %zu)\n", n_in, out_size, ws_size); grid = -1; return; }
        int dev = 0, cus = 0, per_cu = 0;
        if (hipGetDevice(&dev) != hipSuccess || hipDeviceGetAttribute(&cus, hipDeviceAttributeMultiprocessorCount, dev) != hipSuccess) { grid = -1; return; }
        if (hipFuncSetAttribute((const void*)fwd_megakernel, hipFuncAttributeMaxDynamicSharedMemorySize, LDS_BYTES) != hipSuccess) { fprintf(stderr, "kernel_launch: hipFuncSetAttribute failed\n"); grid = -1; return; }
        if (hipOccupancyMaxActiveBlocksPerMultiprocessor(&per_cu, (const void*)fwd_megakernel, NWAVES * 64, LDS_BYTES) != hipSuccess || per_cu < 1) { fprintf(stderr, "kernel_launch: note: occupancy query says %d workgroups per CU\n", per_cu); (void)hipGetLastError(); }
        grid = cus;
    }
    if (grid < 0) return;
    (void)hipMemsetAsync((char*)d_ws + WS_CTL, 0, CTL_ZERO_BYTES, stream);
    Args a{};
    for (int i = 0; i < 23; ++i) a.in[i] = (const float*)d_in[i];
    a.out = (float*)d_out; a.ws = (unsigned char*)d_ws;
    hipLaunchKernelGGL(fwd_megakernel, dim3(grid), dim3(NWAVES * 64), LDS_BYTES, stream, a);
}
```

```cpp
#include <hip/hip_runtime.h>
#include <cstdio>
#include <cstdint>

#ifndef DIAG
#define DIAG 0
#endif
#define LAS __attribute__((address_space(3)))
#define GAS __attribute__((address_space(1)))
typedef unsigned short bf16;
typedef short bf16x8 __attribute__((ext_vector_type(8)));
typedef float f32x4 __attribute__((ext_vector_type(4)));
typedef float f32x2 __attribute__((ext_vector_type(2)));
typedef float f32x16 __attribute__((ext_vector_type(16)));
typedef unsigned u32x4 __attribute__((ext_vector_type(4)));
typedef unsigned u32x2 __attribute__((ext_vector_type(2)));
typedef __bf16 bf16x2_t __attribute__((ext_vector_type(2)));

constexpr int NBATCH = 4, SEQ = 4096, T = NBATCH * SEQ, D = 1024;
constexpr int PROJ_N = 3072;
constexpr int NHEAD = 8, QKD = 96, VD = 64;
constexpr float RMS_EPS = 1e-6f;
constexpr float ATT_C2 = 0.10206207261596577f * 1.4426950408889634f;
constexpr int PEER_H = 8, PEER_K = 16;

constexpr size_t MiB = 1u << 20;
constexpr size_t WS_CTL = 0, CTL_ZERO_BYTES = 1 * MiB;
constexpr size_t WS_WIN = 1 * MiB;
constexpr size_t WS_WQ = 7 * MiB;
constexpr size_t WS_WK = WS_WQ + 512 * 1024;
constexpr size_t WS_WV = WS_WK + 256 * 1024;
constexpr size_t WS_WG = 8 * MiB;
constexpr size_t WS_WPO = WS_WG + 512 * 1024;
constexpr size_t WS_WMO = WS_WPO + 1 * MiB;
constexpr size_t WS_WOUT = WS_WMO + 1 * MiB;
constexpr size_t WS_WQY = 13 * MiB;
constexpr size_t WS_SK = 17 * MiB;
constexpr size_t WS_ROPE = WS_SK + 512 * 1024;
constexpr size_t WS_R1 = 18 * MiB;
constexpr size_t WS_R2 = 50 * MiB;
constexpr size_t WS_EIDX = WS_R2 + 64 * MiB;
constexpr size_t WS_GATE = WS_EIDX + 8 * MiB;
constexpr size_t WS_KB = 146 * MiB;
constexpr size_t WS_VT = 170 * MiB;
constexpr size_t WS_MRG = 146 * MiB;
constexpr size_t WS_PIN = 186 * MiB;
constexpr size_t WS_PF = 202 * MiB;
constexpr size_t WS_AO = 218 * MiB;
constexpr size_t WS_EU = 146 * MiB;
constexpr size_t WS_EV = 178 * MiB;
constexpr size_t WS_END = 234 * MiB;
constexpr int CW_BAR = 4096;
constexpr int CW_MOD = 16384;
constexpr int CW_RSQ = CW_MOD + 2 * 4 * 6144;
constexpr int CW_RSK = CW_RSQ + 2 * T;
constexpr int CW_MODF = CW_RSK + 2 * T;
static_assert((CW_MODF + 4 * 6144) * 4 <= (int)CTL_ZERO_BYTES, "ctl");
constexpr double MOD_FX = 1099511627776.0, RS_FX = 16777216.0;
__device__ __forceinline__ void fx_add(long long* p, float v, double scale) { atomicAdd((unsigned long long*)p, (unsigned long long)__double2ll_rn((double)v * scale)); }
__device__ __forceinline__ float fx_get(const long long* p, double inv_scale) { return (float)((double)(*p) * inv_scale); }

__device__ __forceinline__ unsigned cvtpk(float lo, float hi) { f32x2 v = {lo, hi}; bf16x2_t b = __builtin_convertvector(v, bf16x2_t); return __builtin_bit_cast(unsigned, b); }
__device__ __forceinline__ float bflo(unsigned w) { return __uint_as_float(w << 16); }
__device__ __forceinline__ float bfhi(unsigned w) { return __uint_as_float(w & 0xffff0000u); }
__device__ __forceinline__ u32x4 pack8(f32x4 a, f32x4 b) { u32x4 w; w.x = cvtpk(a[0], a[1]); w.y = cvtpk(a[2], a[3]); w.z = cvtpk(b[0], b[1]); w.w = cvtpk(b[2], b[3]); return w; }
__device__ __forceinline__ void unpack8(u32x4 w, f32x4& a, f32x4& b) { a = (f32x4){bflo(w.x), bfhi(w.x), bflo(w.y), bfhi(w.y)}; b = (f32x4){bflo(w.z), bfhi(w.z), bflo(w.w), bfhi(w.w)}; }
__device__ __forceinline__ float sigmoidf_(float x) { return __builtin_amdgcn_rcpf(1.0f + __builtin_amdgcn_exp2f(-1.4426950408889634f * x)); }
__device__ __forceinline__ float wave_sum(float v) {
#pragma unroll
    for (int o = 1; o < 64; o <<= 1) v += __shfl_xor(v, o);
    return v;
}
#define LDS_WAIT() asm volatile("s_waitcnt lgkmcnt(0)" ::: "memory")

namespace pg8 {
typedef unsigned short bf16_t;
constexpr int BM = 256, BK = 64, HALF = 128, HTB = HALF * BK * 2, STAGE_BYTES = 8 * HTB, NXCD = 8, WGM = 8;
__host__ __device__ __forceinline__ int lds_byte(int r, int c) { const int st = (r >> 4) * 2 + (c >> 5), rr = r & 15, cc = c & 31, ob = rr * 64 + cc * 2; return st * 1024 + (ob ^ (((ob >> 9) & 1) << 5)); }
__host__ __device__ __forceinline__ void stage_rc(int b, int& R, int& C) { const int st = b / 1024, sb = b % 1024, swz = sb ^ (((sb >> 9) & 1) << 5); R = (st >> 1) * 16 + swz / 64; C = (st & 1) * 32 + (swz % 64) / 2; }
__host__ __device__ __forceinline__ int perm32(int rho) { const int n = rho >> 4, i = rho & 15; return 8 * (i >> 2) + 4 * n + (i & 3); }
struct Unit { int pm, pn; };
struct Gemm { const bf16_t* A; const bf16_t* Bt; int M, N, K, lda, ldb; };
struct StaticOrder {
    int nM, nN, nwg, G, c;
    __host__ __device__ void init(int M, int N, int G_, int c_) { nM = M / BM; nN = N / BM; nwg = nM * nN; G = G_; c = c_; }
    __host__ __device__ bool next(int i, Unit& u) const {
        const long L = (long)i * G + c; if (L >= nwg) return false;
        int wgid = (int)L; { const int q = nwg / NXCD, r = nwg % NXCD, xcd = wgid % NXCD, off = wgid / NXCD; wgid = (xcd < r ? xcd * (q + 1) : r * (q + 1) + (xcd - r) * q) + off; }
        const int nig = WGM * nN, gid = wgid / nig, fm = gid * WGM, gsz = (nM - fm) < WGM ? (nM - fm) : WGM;
        u.pm = fm + ((wgid % nig) % gsz); u.pn = (wgid % nig) / gsz; return true;
    }
};
template <class Epi, bool ALIGN_EPI>
__device__ __forceinline__ void gemm_phase(LAS unsigned char* lds, const Gemm g, const StaticOrder& S, const Epi& E) {
    int tid_ = threadIdx.x; asm volatile("" : "+v"(tid_));
    const int tid = tid_, wid = __builtin_amdgcn_readfirstlane(tid >> 6), lane = tid & 63, wr = wid >> 2, wc = wid & 3, fr = lane & 15, fq = lane >> 4;
    int K_ = g.K; asm volatile("" : "+s"(K_));
    const int K = K_, nt = K / BK;
    unsigned voffA[2], voffB[2];
#pragma unroll
    for (int i = 0; i < 2; ++i) { int R, C; stage_rc(tid * 16 + i * 8192, R, C); const int Rb = (R & ~31) + perm32(R & 31);
        voffA[i] = (unsigned)(R * g.lda + C) * 2u; voffB[i] = (unsigned)(Rb * g.ldb + C) * 2u; }
    const size_t kstep = (size_t)(BK * 2);
    const size_t hstepA = (size_t)HALF * g.lda * 2, hstepB = (size_t)HALF * g.ldb * 2;
    const size_t tstepA = 2 * hstepA, tstepB = 2 * hstepB;
    const unsigned ldsw = (unsigned)wid * 1024u;
    const int aoff = lds_byte(wr * 64 + fr, fq * 8), boff = lds_byte(wc * 32 + fr, fq * 8);
#define PG8_SA(b, h) (((b) * 2 + (h)) * HTB)
#define PG8_SB(b, h) ((4 + (b) * 2 + (h)) * HTB)
#define PG8_STAGE(bufoff, gbase, voff) do { _Pragma("unroll") for (int _i = 0; _i < 2; ++_i) \
        __builtin_amdgcn_global_load_lds((const unsigned*)((const char*)(gbase) + (voff)[_i]), (LAS unsigned*)(lds + (bufoff) + ldsw + _i * 8192), 16, 0, 0); } while (0)
#define PG8_LDA(dst, b, h) do { _Pragma("unroll") for (int m = 0; m < 4; ++m) _Pragma("unroll") for (int k = 0; k < 2; ++k) dst[m][k] = *(const LAS bf16x8*)(lds + PG8_SA(b, h) + aoff + m * 2048 + k * 1024); } while (0)
#define PG8_LDB(dst, b, h) do { _Pragma("unroll") for (int n = 0; n < 2; ++n) _Pragma("unroll") for (int k = 0; k < 2; ++k) dst[n][k] = *(const LAS bf16x8*)(lds + PG8_SB(b, h) + boff + n * 2048 + k * 1024); } while (0)
#define PG8_MMA(ai, bj, At, Bt) do { __builtin_amdgcn_s_setprio(1); _Pragma("unroll") for (int m = 0; m < 4; ++m) _Pragma("unroll") for (int n = 0; n < 2; ++n) _Pragma("unroll") for (int k = 0; k < 2; ++k) \
        acc[ai][bj][m][n] = __builtin_amdgcn_mfma_f32_16x16x32_bf16(Bt[n][k], At[m][k], acc[ai][bj][m][n], 0, 0, 0); __builtin_amdgcn_s_setprio(0); } while (0)
#define PG8_WAIT_V(n) asm volatile("s_waitcnt vmcnt(" #n ")" ::: "memory")
#define PG8_WAIT_L(n) asm volatile("s_waitcnt lgkmcnt(" #n ")" ::: "memory")
#define PG8_BAR __builtin_amdgcn_s_barrier()
#define PG8_SCHED __builtin_amdgcn_sched_barrier(0)
    Unit cur, nxt; int ui = 0;
    if (!S.next(0, cur)) return;
    f32x4 acc[2][2][4][2];
#pragma unroll
    for (int a = 0; a < 2; ++a)
#pragma unroll
        for (int b = 0; b < 2; ++b)
#pragma unroll
            for (int m = 0; m < 4; ++m)
#pragma unroll
                for (int n = 0; n < 2; ++n) acc[a][b][m][n] = (f32x4){0.f, 0.f, 0.f, 0.f};
    bf16x8 At[4][2], B0[2][2], B1[2][2];
    const char* cA = (const char*)g.A + (size_t)cur.pm * tstepA; const char* cB = (const char*)g.Bt + (size_t)cur.pn * tstepB;
    PG8_STAGE(PG8_SB(0, 0), cB, voffB); PG8_STAGE(PG8_SB(0, 1), cB + hstepB, voffB); PG8_STAGE(PG8_SA(0, 0), cA, voffA); PG8_STAGE(PG8_SA(0, 1), cA + hstepA, voffA);
    if (wr == 1) PG8_BAR;
    PG8_WAIT_V(2); PG8_BAR;
    PG8_STAGE(PG8_SB(1, 0), cB + kstep, voffB); PG8_STAGE(PG8_SA(1, 0), cA + kstep, voffA); PG8_STAGE(PG8_SB(1, 1), cB + hstepB + kstep, voffB);
    PG8_WAIT_V(6); PG8_BAR;
    for (;;) {
        const bool has_next = S.next(ui + 1, nxt);
        const char* nA = has_next ? (const char*)g.A + (size_t)nxt.pm * tstepA : cA; const char* nB = has_next ? (const char*)g.Bt + (size_t)nxt.pn * tstepB : cB;
        for (int t = 0; t < nt; t += 2) {
            const bool last = (t == nt - 2);
            const char* a1 = cA + (size_t)(t + 1) * kstep;
            const char* a2 = last ? nA : cA + (size_t)(t + 2) * kstep; const char* b2 = last ? nB : cB + (size_t)(t + 2) * kstep;
            const char* a3 = a2 + kstep; const char* b3 = b2 + kstep;
            PG8_LDB(B0, 0, 0); PG8_LDB(B1, 0, 1); PG8_SCHED; PG8_LDA(At, 0, 0); PG8_STAGE(PG8_SA(1, 1), a1 + hstepA, voffA);
            PG8_WAIT_V(8); PG8_WAIT_L(0); PG8_BAR; PG8_MMA(0, 0, At, B0); PG8_MMA(0, 1, At, B1); PG8_BAR; PG8_SCHED;
            PG8_LDA(At, 0, 1); PG8_STAGE(PG8_SB(0, 0), b2, voffB); PG8_STAGE(PG8_SB(0, 1), b2 + hstepB, voffB); PG8_STAGE(PG8_SA(0, 0), a2, voffA);
            PG8_WAIT_V(8); PG8_WAIT_L(0); PG8_BAR; PG8_MMA(1, 0, At, B0); PG8_MMA(1, 1, At, B1); PG8_BAR; PG8_SCHED;
            PG8_LDB(B0, 1, 0); PG8_LDB(B1, 1, 1); PG8_SCHED; PG8_LDA(At, 1, 0); PG8_STAGE(PG8_SA(0, 1), a2 + hstepA, voffA);
            PG8_WAIT_V(8); PG8_WAIT_L(0); PG8_BAR; PG8_MMA(0, 0, At, B0); PG8_MMA(0, 1, At, B1); PG8_BAR; PG8_SCHED;
            PG8_LDA(At, 1, 1); PG8_STAGE(PG8_SB(1, 0), b3, voffB); PG8_STAGE(PG8_SB(1, 1), b3 + hstepB, voffB); PG8_STAGE(PG8_SA(1, 0), a3, voffA);
            PG8_WAIT_V(8); PG8_WAIT_L(0); PG8_BAR; PG8_MMA(1, 0, At, B0); PG8_MMA(1, 1, At, B1); PG8_BAR; PG8_SCHED;
        }
        if constexpr (ALIGN_EPI) { if (wr == 0) PG8_BAR; }
        E(acc, cur, wr, wc, fr, fq);
        if (!has_next) break;
#pragma unroll
        for (int a = 0; a < 2; ++a)
#pragma unroll
            for (int b = 0; b < 2; ++b)
#pragma unroll
                for (int m = 0; m < 4; ++m)
#pragma unroll
                    for (int n = 0; n < 2; ++n) acc[a][b][m][n] = (f32x4){0.f, 0.f, 0.f, 0.f};
        cur = nxt; cA = nA; cB = nB; ++ui;
        if constexpr (ALIGN_EPI) { if (wr == 1) PG8_BAR; }
    }
    PG8_WAIT_V(0);
    if constexpr (!ALIGN_EPI) { if (wr == 0) PG8_BAR; }
    PG8_BAR;
#undef PG8_SA
#undef PG8_SB
#undef PG8_STAGE
#undef PG8_LDA
#undef PG8_LDB
#undef PG8_MMA
#undef PG8_WAIT_V
#undef PG8_WAIT_L
#undef PG8_BAR
#undef PG8_SCHED
}

#define EPI_ARGS const f32x4 (&acc)[2][2][4][2], const Unit& u, int wr, int wc, int fr, int fq
__device__ __forceinline__ void rope8(f32x4& v0, f32x4& v1, const float* tab, int e0) {
    const f32x4 c = *(const f32x4*)(tab + e0), s = *(const f32x4*)(tab + 16 + e0);
    const float a0 = v0[0] * c[0] - v0[1] * s[0], b0 = v0[1] * c[0] + v0[0] * s[0];
    const float a1 = v0[2] * c[1] - v0[3] * s[1], b1 = v0[3] * c[1] + v0[2] * s[1];
    const float a2 = v1[0] * c[2] - v1[1] * s[2], b2 = v1[1] * c[2] + v1[0] * s[2];
    const float a3 = v1[2] * c[3] - v1[3] * s[3], b3 = v1[3] * c[3] + v1[2] * s[3];
    v0 = (f32x4){a0, b0, a1, b1}; v1 = (f32x4){a2, b2, a3, b3};
}
struct EpiPlain { bf16* O; int ldc;
    __device__ __forceinline__ void operator()(EPI_ARGS) const {
#pragma unroll
        for (int ai = 0; ai < 2; ++ai)
#pragma unroll
            for (int m = 0; m < 4; ++m) { const int row = u.pm * BM + ai * HALF + wr * 64 + m * 16 + fr;
#pragma unroll
                for (int bj = 0; bj < 2; ++bj) { const int col0 = u.pn * BM + bj * HALF + wc * 32 + 8 * fq;
                    *(u32x4*)(O + (size_t)row * ldc + col0) = pack8(acc[ai][bj][m][0], acc[ai][bj][m][1]); } }
    }
};
struct EpiProj { bf16* P; bf16* Kb; long long* rsq; long long* rsk; const float* rope;
    __device__ __forceinline__ void operator()(EPI_ARGS) const {
        const int pn = u.pn;
#pragma unroll
        for (int ai = 0; ai < 2; ++ai)
#pragma unroll
            for (int m = 0; m < 4; ++m) { const int row = u.pm * BM + ai * HALF + wr * 64 + m * 16 + fr; float ss = 0.f;
#pragma unroll
                for (int bj = 0; bj < 2; ++bj) { const int col0 = pn * BM + bj * HALF + wc * 32 + 8 * fq;
                    f32x4 v0 = acc[ai][bj][m][0], v1 = acc[ai][bj][m][1];
                    if (pn >= 4) {
#pragma unroll
                        for (int i = 0; i < 4; ++i) { v0[i] = sigmoidf_(v0[i]); v1[i] = sigmoidf_(v1[i]); }
                    }
                    *(u32x4*)(P + (size_t)row * PROJ_N + col0) = pack8(v0, v1);
                    if (pn == 2 || (pn == 3 && bj == 0)) ss += (v0[0] * v0[0] + v0[1] * v0[1]) + (v0[2] * v0[2] + v0[3] * v0[3]) + (v1[0] * v1[0] + v1[1] * v1[1]) + (v1[2] * v1[2] + v1[3] * v1[3]);
                    if (pn == 3 && bj == 1 && wc == 0) {
                        rope8(v0, v1, rope + (size_t)(row & (SEQ - 1)) * 32, 4 * fq);
                        const u32x4 w = pack8(v0, v1);
#pragma unroll
                        for (int h = 0; h < NHEAD; ++h) *(u32x4*)(Kb + (size_t)row * (NHEAD * QKD) + h * QKD + 64 + 8 * fq) = w;
                    }
                }
                if (pn == 2 || pn == 3) { ss += __shfl_xor(ss, 16); ss += __shfl_xor(ss, 32);
                    if (fq == 0) fx_add((pn == 2 ? rsq : rsk) + row, ss, RS_FX); }
            }
    }
};
struct EpiQ { bf16* Q; const long long* rsq; const float* rope;
    __device__ __forceinline__ void operator()(EPI_ARGS) const {
#pragma unroll
        for (int ai = 0; ai < 2; ++ai)
#pragma unroll
            for (int m = 0; m < 4; ++m) { const int row = u.pm * BM + ai * HALF + wr * 64 + m * 16 + fr;
                const float sc = rsqrtf(fx_get(rsq + row, 1.0 / RS_FX) * (1.0f / 256.0f) + RMS_EPS) * ATT_C2;
#pragma unroll
                for (int bj = 0; bj < 2; ++bj) { const int col0 = u.pn * BM + bj * HALF + wc * 32 + 8 * fq;
                    f32x4 v0 = acc[ai][bj][m][0] * sc, v1 = acc[ai][bj][m][1] * sc;
                    if (((u.pn * 8 + bj * 4 + wc) % 3) == 2) rope8(v0, v1, rope + (size_t)(row & (SEQ - 1)) * 32, 4 * fq);
                    *(u32x4*)(Q + (size_t)row * (NHEAD * QKD) + col0) = pack8(v0, v1); }
                asm volatile("" ::: "memory"); }
    }
};
struct EpiKn { bf16* Kb; const long long* rsk;
    __device__ __forceinline__ void operator()(EPI_ARGS) const {
#pragma unroll
        for (int ai = 0; ai < 2; ++ai)
#pragma unroll
            for (int m = 0; m < 4; ++m) { const int row = u.pm * BM + ai * HALF + wr * 64 + m * 16 + fr;
                const float sc = rsqrtf(fx_get(rsk + row, 1.0 / RS_FX) * (1.0f / 128.0f) + RMS_EPS);
#pragma unroll
                for (int bj = 0; bj < 2; ++bj) { const int col0 = u.pn * BM + bj * HALF + wc * 32 + 8 * fq; const int h = col0 >> 6, j = col0 & 63;
                    *(u32x4*)(Kb + (size_t)row * (NHEAD * QKD) + h * QKD + j) = pack8(acc[ai][bj][m][0] * sc, acc[ai][bj][m][1] * sc); }
                if (m & 1) asm volatile("" ::: "memory"); }
    }
};
struct EpiVt { bf16* Vt; const long long* rsk;
    __device__ __forceinline__ void operator()(EPI_ARGS) const {
#pragma unroll
        for (int bj = 0; bj < 2; ++bj) { const int col0 = u.pn * BM + bj * HALF + wc * 32 + 8 * fq;
            f32x4 s0, s1;
#pragma unroll
            for (int i = 0; i < 4; ++i) { s0[i] = rsqrtf(fx_get(rsk + col0 + i, 1.0 / RS_FX) * (1.0f / 128.0f) + RMS_EPS); s1[i] = rsqrtf(fx_get(rsk + col0 + 4 + i, 1.0 / RS_FX) * (1.0f / 128.0f) + RMS_EPS); }
#pragma unroll
            for (int ai = 0; ai < 2; ++ai)
#pragma unroll
                for (int m = 0; m < 4; ++m) { const int row = u.pm * BM + ai * HALF + wr * 64 + m * 16 + fr;
                    *(u32x4*)(Vt + (size_t)row * T + col0) = pack8(acc[ai][bj][m][0] * s0, acc[ai][bj][m][1] * s1); }
            asm volatile("" ::: "memory"); }
    }
};
template <int MODE> struct EpiGate { bf16* Y; const bf16* P; int goff;
    __device__ __forceinline__ void operator()(EPI_ARGS) const {
#pragma unroll
        for (int ai = 0; ai < 2; ++ai)
#pragma unroll
            for (int m = 0; m < 4; ++m) { const int row = u.pm * BM + ai * HALF + wr * 64 + m * 16 + fr;
#pragma unroll
                for (int bj = 0; bj < 2; ++bj) { const int col0 = u.pn * BM + bj * HALF + wc * 32 + 8 * fq;
                    f32x4 g0, g1; unpack8(*(const u32x4*)(P + (size_t)row * PROJ_N + goff + col0), g0, g1);
                    f32x4 v0 = acc[ai][bj][m][0] * g0, v1 = acc[ai][bj][m][1] * g1;
                    bf16* yp = Y + (size_t)row * D + col0;
                    if (MODE == 1) { f32x4 y0, y1; unpack8(*(const u32x4*)yp, y0, y1); v0 += y0; v1 += y1; }
                    *(u32x4*)yp = pack8(v0, v1); } }
    }
};
}

#define XB_TMO      128
#define XB_XCNT(j)  (256  + 64 * (j))
#define XB_XSUB(j)  (1280 + 64 * (j))
#define XB_XGEN(j)  (2304 + 64 * (j))
#define XB_TOP      3328
#define XB_TOPGEN   3392
#define XCD_BAR_WORDS 3456
#define XB_SPIN_CAP (1u << 18)
__device__ __forceinline__ unsigned xb_ld(unsigned* p)              { return __hip_atomic_load(p, __ATOMIC_RELAXED, __HIP_MEMORY_SCOPE_AGENT); }
__device__ __forceinline__ unsigned xb_add(unsigned* p, unsigned v) { return __hip_atomic_fetch_add(p, v, __ATOMIC_RELAXED, __HIP_MEMORY_SCOPE_AGENT); }
__device__ __forceinline__ unsigned xb_xcc_id() { return (unsigned)__builtin_amdgcn_s_getreg((3 << 11) | 20) & 0xFu; }
#define XB_SPIN(cond, bar) do { unsigned _sp = 0; while (cond) { __builtin_amdgcn_s_sleep(1); \
    if ((++_sp & 255u) == 0u) { if (xb_ld(&(bar)[XB_TMO])) break; if (_sp > XB_SPIN_CAP) { atomicAdd(&(bar)[XB_TMO], 1u); break; } } } } while (0)
struct XcdBarrier { unsigned* bar; unsigned x; volatile LAS unsigned* st; };
__device__ __forceinline__ XcdBarrier xcd_barrier_post(unsigned* bar, volatile LAS unsigned* st) {
    XcdBarrier b; b.bar = bar; b.x = xb_xcc_id(); b.st = st;
    if (threadIdx.x == 0) (void)xb_add(&bar[XB_XCNT(b.x)], 1u);
    return b;
}
__device__ __forceinline__ void xcd_barrier_complete(unsigned* bar, unsigned x, unsigned& nloc, unsigned& nx) {
    const unsigned G = gridDim.x * gridDim.y * gridDim.z;
    unsigned sum, cnt, mine, sp = 0u;
    for (;;) {
        sum = 0u; cnt = 0u; mine = 0u;
#pragma unroll
        for (unsigned j = 0; j < 16; ++j) { const unsigned c = xb_ld(&bar[XB_XCNT(j)]); sum += c; cnt += (c > 0u) ? 1u : 0u; mine = (j == x) ? c : mine; }
        if (sum == G) break;
        __builtin_amdgcn_s_sleep(1);
        if ((++sp & 255u) == 0u) { if (xb_ld(&bar[XB_TMO])) break; if (sp > XB_SPIN_CAP) { atomicAdd(&bar[XB_TMO], 1u); break; } }
    }
    nloc = mine > 0u ? mine : 1u; nx = cnt > 0u ? cnt : 1u;
}
__device__ __forceinline__ void xcd_barrier(const XcdBarrier& b) {
    asm volatile("s_waitcnt vmcnt(0)" ::: "memory");
    __syncthreads();
    if (threadIdx.x == 0) {
        unsigned* bar = b.bar;
        __builtin_amdgcn_s_waitcnt(0);
        unsigned nloc = b.st[0], nx = b.st[1];
        if (nloc == 0u) { xcd_barrier_complete(bar, b.x, nloc, nx); b.st[0] = nloc; b.st[1] = nx; }
        const unsigned old = xb_add(&bar[XB_XSUB(b.x)], 1u);
        const unsigned gen = old / nloc;
        if (old + 1u == (gen + 1u) * nloc) {
            __builtin_amdgcn_fence(__ATOMIC_RELEASE, "agent");
            asm volatile("s_waitcnt vmcnt(0)" ::: "memory");
            const unsigned og = xb_add(&bar[XB_TOP], 1u);
            const unsigned tg = og / nx;
            if (og + 1u == (tg + 1u) * nx) xb_add(&bar[XB_TOPGEN], 1u);
            else XB_SPIN(xb_ld(&bar[XB_TOPGEN]) == tg, bar);
            __builtin_amdgcn_fence(__ATOMIC_ACQUIRE, "agent");
            xb_add(&bar[XB_XGEN(b.x)], 1u);
            asm volatile("s_waitcnt vmcnt(0)" ::: "memory");
        } else {
            XB_SPIN(xb_ld(&bar[XB_XGEN(b.x)]) == gen, bar);
            __builtin_amdgcn_fence(__ATOMIC_ACQUIRE, "agent");
            asm volatile("s_waitcnt vmcnt(0)" ::: "memory");
        }
    }
    __syncthreads();
}

constexpr int NWAVES = 8;
constexpr int RING_BYTES = 131072, LDSCTL_OFF = RING_BYTES, LDS_BYTES = 147456;
struct Args { const float* in[23]; float* out; unsigned char* ws; };
struct Frame {
    LAS unsigned char* lds; int tid, lane, wave, vcu, G;
    const float* const* in; float* out; unsigned char* ws;
};
enum { I_X = 0, I_C, I_WADA, I_BADA, I_GPRE1, I_GPOST1, I_WIN, I_WPG, I_PSCALE, I_WPO, I_GQ, I_WQUP, I_GKV, I_WKVUP, I_WMO, I_WOUT, I_GPRE2, I_GPOST2, I_WQY, I_SK1, I_SK2, I_EU, I_EV };

__device__ __forceinline__ void tr_block(const float* src, int spitch, int ks, int ns, int perm, const float* gk, const float* gn, bf16* dst, int dpitch, int nd, int kd, LAS float* scr, int lane) {
    if (src) {
        const float gnv = gn ? gn[lane & 31] : 1.0f;
        float tv[32];
#pragma unroll
        for (int i = 0; i < 32; ++i) tv[i] = src[(size_t)(ks + 2 * i + (lane >> 5)) * spitch + ns + (lane & 31)];
#pragma unroll
        for (int i = 0; i < 32; ++i) { const int kk = 2 * i + (lane >> 5); float v = tv[i] * gnv; if (gk) v *= gk[ks + kk]; scr[kk * 33 + (lane & 31)] = v; }
    } else {
#pragma unroll 8
        for (int i = 0; i < 32; ++i) { const int kk = 2 * i + (lane >> 5); scr[kk * 33 + (lane & 31)] = 0.f; }
    }
    LDS_WAIT(); asm volatile("" ::: "memory");
    const int c = lane & 7;
#pragma unroll
    for (int j = 0; j < 4; ++j) { const int n = (lane >> 3) + 8 * j; const int pc = perm ? ((n >> 1) + 16 * (n & 1)) : n; const LAS float* s = scr + (8 * c) * 33 + pc;
        u32x4 o; o.x = cvtpk(s[0 * 33], s[1 * 33]); o.y = cvtpk(s[2 * 33], s[3 * 33]); o.z = cvtpk(s[4 * 33], s[5 * 33]); o.w = cvtpk(s[6 * 33], s[7 * 33]);
        *(u32x4*)(dst + (size_t)(nd + n) * dpitch + kd + 8 * c) = o; }
    LDS_WAIT(); asm volatile("" ::: "memory");
}

__device__ __forceinline__ void p0_prologue(Frame& F) {
    LAS float* scr = (LAS float*)(F.lds + F.wave * 16384);
    int lane_ = F.lane; asm volatile("" : "+v"(lane_));
    const int gw = F.vcu * NWAVES + F.wave, NGW = F.G * NWAVES, lane = lane_;
    unsigned char* ws = F.ws;
    {
        long long* mod = (long long*)((unsigned*)(ws + WS_CTL) + CW_MOD);
        const float* cc = F.in[I_C]; const float* wa = F.in[I_WADA]; const float* ba = F.in[I_BADA];
        for (int it = gw; it < 24 * 64; it += NGW) {
            const int cg = it % 24, kc = it / 24; const int col = cg * 256 + 4 * lane;
            f32x4 a0 = {0, 0, 0, 0}, a1 = a0, a2 = a0, a3 = a0;
            if (kc == 0) { a0 = *(const f32x4*)(ba + col); a1 = a0; a2 = a0; a3 = a0; }
#pragma unroll 4
            for (int k = kc * 16; k < kc * 16 + 16; ++k) {
                const f32x4 w = *(const f32x4*)(wa + (size_t)k * 6144 + col);
                const float c0 = cc[k], c1 = cc[1024 + k], c2 = cc[2048 + k], c3 = cc[3072 + k];
                a0 += w * (c0 * sigmoidf_(c0)); a1 += w * (c1 * sigmoidf_(c1)); a2 += w * (c2 * sigmoidf_(c2)); a3 += w * (c3 * sigmoidf_(c3));
            }
#pragma unroll
            for (int i = 0; i < 4; ++i) { fx_add(mod + col + i, a0[i], MOD_FX); fx_add(mod + 6144 + col + i, a1[i], MOD_FX); fx_add(mod + 2 * 6144 + col + i, a2[i], MOD_FX); fx_add(mod + 3 * 6144 + col + i, a3[i], MOD_FX); }
        }
    }
    {
        bf16* Win = (bf16*)(ws + WS_WIN); bf16* Wq = (bf16*)(ws + WS_WQ); bf16* Wk = (bf16*)(ws + WS_WK); bf16* Wv = (bf16*)(ws + WS_WV); bf16* Wg = (bf16*)(ws + WS_WG);
        bf16* Wpo = (bf16*)(ws + WS_WPO); bf16* Wmo = (bf16*)(ws + WS_WMO); bf16* Wout = (bf16*)(ws + WS_WOUT); bf16* Wqy = (bf16*)(ws + WS_WQY);
        constexpr int N1 = 96 * 16, N2 = 24 * 4, N3 = 16 * 4, N4 = 16 * 4, N5 = 16 * 8, N6 = 32 * 8, N7 = 32 * 8, N8 = 32 * 16, N9 = 64 * 16;
        constexpr int NITEMS = N1 + N2 + N3 + N4 + N5 + N6 + N7 + N8 + N9;
        for (int it = gw; it < NITEMS; it += NGW) {
            int r = it;
            if (r < N1) { const int nb = r % 96, kb = r / 96; const float* s = F.in[I_WIN]; int ns = 32 * nb, pm = 0;
                if (nb == 28) pm = 1; else if (nb >= 29 && nb < 32) s = nullptr; else if (nb >= 32) ns = 928 + 32 * (nb - 32);
                tr_block(s, 2976, 64 * kb, ns, pm, nullptr, nullptr, Win, 1024, 32 * nb, 64 * kb, scr, lane); continue; } r -= N1;
            if (r < N2) { const int nb = r % 24, kb = r / 24; const int h = nb / 3, q = nb % 3;
                tr_block(F.in[I_WQUP], 768, 64 * kb, 96 * h + 32 * q, q == 2, F.in[I_GQ], nullptr, Wq, 256, 32 * nb, 64 * kb, scr, lane); continue; } r -= N2;
            if (r < N3) { const int nb = r % 16, kb = r / 16; const int h = nb / 2, q = nb % 2;
                tr_block(kb < 2 ? F.in[I_WKVUP] : nullptr, 1024, 64 * kb, 128 * h + 32 * q, 0, F.in[I_GKV], nullptr, Wk, 256, 32 * nb, 64 * kb, scr, lane); continue; } r -= N3;
            if (r < N4) { const int nb = r % 16, kb = r / 16; const int h = nb / 2, q = nb % 2;
                tr_block(kb < 2 ? F.in[I_WKVUP] : nullptr, 1024, 64 * kb, 128 * h + 64 + 32 * q, 0, F.in[I_GKV], nullptr, Wv, 256, 32 * nb, 64 * kb, scr, lane); continue; } r -= N4;
            if (r < N5) { const int nb = r % 16, kb = r / 16; const int g = nb / 4; const bool dg = (kb / 2) == g;
                tr_block(dg ? F.in[I_WPG] + (size_t)g * 128 * 128 : nullptr, 128, 64 * (kb % 2), 32 * (nb % 4), 0, nullptr, F.in[I_PSCALE] + g * 128 + 32 * (nb % 4), Wg, 512, 32 * nb, 64 * kb, scr, lane); continue; } r -= N5;
            if (r < N6) { const int nb = r % 32, kb = r / 32; tr_block(F.in[I_WPO], 1024, 64 * kb, 32 * nb, 0, nullptr, nullptr, Wpo, 512, 32 * nb, 64 * kb, scr, lane); continue; } r -= N6;
            if (r < N7) { const int nb = r % 32, kb = r / 32; tr_block(F.in[I_WMO], 1024, 64 * kb, 32 * nb, 0, nullptr, nullptr, Wmo, 512, 32 * nb, 64 * kb, scr, lane); continue; } r -= N7;
            if (r < N8) { const int nb = r % 32, kb = r / 32; tr_block(F.in[I_WOUT], 1024, 64 * kb, 32 * nb, 0, nullptr, nullptr, Wout, 1024, 32 * nb, 64 * kb, scr, lane); continue; } r -= N8;
            { const int nb = r % 64, kb = r / 64; tr_block(F.in[I_WQY], 2048, 64 * kb, 32 * nb, 0, nullptr, nullptr, Wqy, 1024, 32 * nb, 64 * kb, scr, lane); }
        }
    }
    {
        bf16* sk = (bf16*)(ws + WS_SK);
        const int gt = (F.vcu * NWAVES * 64) + F.wave * 64 + lane, NGT = F.G * NWAVES * 64;
        for (int i = gt; i < 2 * 131072 / 8; i += NGT) { const int side = i / 16384, o = (i % 16384) * 8; const float* s = F.in[side ? I_SK2 : I_SK1] + o;
            *(u32x4*)(sk + (size_t)side * 131072 + o) = pack8(*(const f32x4*)s, *(const f32x4*)(s + 4)); }
        float* rope = (float*)(ws + WS_ROPE);
        for (int i = gt; i < SEQ * 16; i += NGT) { const int pos = i >> 4, e = i & 15;
            const float frac[4] = {1.0f, 0.5623413251903491f, 0.31622776601683794f, 0.17782794100389228f};
            const float dec[4] = {1.0f, 0.1f, 0.01f, 0.001f};
            const float inv = (float)((double)dec[e >> 2] * (double)frac[e & 3]);
            const float ang = (float)pos * inv;
            const double rev = (double)ang * 0.15915494309189535;
            const float fr = (float)(rev - floor(rev));
            rope[pos * 32 + e] = __builtin_amdgcn_cosf(fr); rope[pos * 32 + 16 + e] = __builtin_amdgcn_sinf(fr); }
    }
}

__device__ __forceinline__ void p1_xn(Frame& F) {
    int lane_ = F.lane; asm volatile("" : "+v"(lane_));
    const int gw = F.vcu * NWAVES + F.wave, NGW = F.G * NWAVES, lane = lane_;
    const long long* mod = (const long long*)((const unsigned*)(F.ws + WS_CTL) + CW_MOD); const float* g = F.in[I_GPRE1]; bf16* xn = (bf16*)(F.ws + WS_R1);
    { float* modf = (float*)(F.ws + WS_CTL) + CW_MODF; for (int i = gw * 64 + lane; i < 4 * 6144; i += NGW * 64) modf[i] = fx_get(mod + i, 1.0 / MOD_FX); }
    for (int row0 = gw; row0 < T; row0 += 2 * NGW) {
        f32x4 v[2][4]; float s[2] = {0.f, 0.f};
#pragma unroll
        for (int q = 0; q < 2; ++q) { const f32x4* xr = (const f32x4*)(F.in[I_X] + (size_t)(row0 + q * NGW) * D) + lane;
#pragma unroll
            for (int j = 0; j < 4; ++j) v[q][j] = xr[64 * j]; }
#pragma unroll
        for (int q = 0; q < 2; ++q)
#pragma unroll
            for (int j = 0; j < 4; ++j) s[q] += (v[q][j].x * v[q][j].x + v[q][j].y * v[q][j].y) + (v[q][j].z * v[q][j].z + v[q][j].w * v[q][j].w);
#pragma unroll
        for (int q = 0; q < 2; ++q) { const int row = row0 + q * NGW; const long long* mb = mod + (row / SEQ) * 6144;
            const float rstd = rsqrtf(wave_sum(s[q]) * (1.f / D) + RMS_EPS);
#pragma unroll
            for (int j = 0; j < 4; ++j) { const int col = 4 * lane + 256 * j;
                const f32x4 gg = *(const f32x4*)(g + col); f32x4 sh, sc;
#pragma unroll
                for (int i = 0; i < 4; ++i) { sh[i] = fx_get(mb + col + i, 1.0 / MOD_FX); sc[i] = fx_get(mb + 1024 + col + i, 1.0 / MOD_FX); }
                const f32x4 o = v[q][j] * rstd * gg * (sc + 1.0f) + sh;
                u32x2 w; w.x = cvtpk(o.x, o.y); w.y = cvtpk(o.z, o.w); *(u32x2*)(xn + (size_t)row * D + col) = w; } }
    }
}
template <int W> __device__ __forceinline__ void pool_item(const bf16* P, bf16* PI, int t0, int ch) {
    const int s0 = t0 & (SEQ - 1);
    u32x4 raw[W + 7];
#pragma unroll
    for (int i = 0; i < W + 7; ++i) { const int dt = i - (W - 1); raw[i] = (s0 + dt >= 0) ? *(const u32x4*)(P + (size_t)(t0 + dt) * PROJ_N + ch) : (u32x4){0u, 0u, 0u, 0u}; }
    f32x4 a0 = {0, 0, 0, 0}, a1 = a0;
#pragma unroll
    for (int i = 0; i < W - 1; ++i) { f32x4 y0, y1; unpack8(raw[i], y0, y1); a0 += y0; a1 += y1; }
#pragma unroll
    for (int k = 0; k < 8; ++k) {
        f32x4 x0, x1; unpack8(raw[W - 1 + k], x0, x1); a0 += x0; a1 += x1;
        const int s = s0 + k; const float ic = 1.0f / (float)((s + 1 < W) ? s + 1 : W);
        *(u32x4*)(PI + (size_t)(t0 + k) * 512 + ch) = pack8(a0 * ic - x0, a1 * ic - x1);
        f32x4 o0, o1; unpack8(raw[k], o0, o1); a0 -= o0; a1 -= o1;
    }
}
__device__ __forceinline__ void p3_pool(Frame& F) {
    const bf16* P = (const bf16*)(F.ws + WS_R2); bf16* PI = (bf16*)(F.ws + WS_PIN);
    int tid_ = F.tid; asm volatile("" : "+v"(tid_));
    const int gt = (F.vcu * NWAVES * 64) + tid_, NGT = F.G * NWAVES * 64;
    for (int i = gt; i < (T / 8) * 64; i += NGT) {
        const int cg = i & 63, t0 = (i >> 6) * 8, ch = cg * 8, g = cg >> 4;
        if (g == 0) pool_item<2>(P, PI, t0, ch); else if (g == 1) pool_item<4>(P, PI, t0, ch); else if (g == 2) pool_item<8>(P, PI, t0, ch); else pool_item<16>(P, PI, t0, ch);
    }
}
__device__ __forceinline__ void p7_rows(Frame& F) {
    int lane_ = F.lane; asm volatile("" : "+v"(lane_));
    const int gw = F.vcu * NWAVES + F.wave, NGW = F.G * NWAVES, lane = lane_;
    const float* mod = (const float*)(F.ws + WS_CTL) + CW_MODF; const bf16* Z = (const bf16*)(F.ws + WS_R2); bf16* xn = (bf16*)(F.ws + WS_R1);
    const float* gp1 = F.in[I_GPOST1]; const float* gp2 = F.in[I_GPRE2];
    for (int row0 = gw; row0 < T; row0 += 2 * NGW) {
        f32x4 z[2][4], h[2][4], xv[2][4]; float s[2] = {0.f, 0.f}, s2[2] = {0.f, 0.f};
#pragma unroll
        for (int q = 0; q < 2; ++q) { const int row = row0 + q * NGW;
#pragma unroll
            for (int j = 0; j < 4; ++j) { const u32x2 w = *(const u32x2*)(Z + (size_t)row * D + 4 * lane + 256 * j); z[q][j] = (f32x4){bflo(w.x), bfhi(w.x), bflo(w.y), bfhi(w.y)};
                xv[q][j] = *(const f32x4*)(F.in[I_X] + (size_t)row * D + 4 * lane + 256 * j); } }
#pragma unroll
        for (int q = 0; q < 2; ++q)
#pragma unroll
            for (int j = 0; j < 4; ++j) s[q] += (z[q][j].x * z[q][j].x + z[q][j].y * z[q][j].y) + (z[q][j].z * z[q][j].z + z[q][j].w * z[q][j].w);
#pragma unroll
        for (int q = 0; q < 2; ++q) { const int row = row0 + q * NGW; const float* mb = mod + (row / SEQ) * 6144;
            const float rz = rsqrtf(wave_sum(s[q]) * (1.f / D) + RMS_EPS);
#pragma unroll
            for (int j = 0; j < 4; ++j) { const int col = 4 * lane + 256 * j;
                const f32x4 g1 = *(const f32x4*)(mb + 2048 + col), gg = *(const f32x4*)(gp1 + col);
                h[q][j] = xv[q][j] + g1 * (z[q][j] * rz * gg); *(f32x4*)(F.out + (size_t)row * D + col) = h[q][j];
                s2[q] += (h[q][j].x * h[q][j].x + h[q][j].y * h[q][j].y) + (h[q][j].z * h[q][j].z + h[q][j].w * h[q][j].w); } }
#pragma unroll
        for (int q = 0; q < 2; ++q) { const int row = row0 + q * NGW; const float* mb = mod + (row / SEQ) * 6144;
            const float rh = rsqrtf(wave_sum(s2[q]) * (1.f / D) + RMS_EPS);
#pragma unroll
            for (int j = 0; j < 4; ++j) { const int col = 4 * lane + 256 * j;
                const f32x4 gg = *(const f32x4*)(gp2 + col), sh = *(const f32x4*)(mb + 3072 + col), sc = *(const f32x4*)(mb + 4096 + col);
                const f32x4 o = h[q][j] * rh * gg * (sc + 1.0f) + sh;
                u32x2 w; w.x = cvtpk(o.x, o.y); w.y = cvtpk(o.z, o.w); *(u32x2*)(xn + (size_t)row * D + col) = w; } }
    }
}

constexpr int ATT_KP = 208, ATT_VP = 144, ATT_KB = 64 * ATT_KP, ATT_VB = 64 * ATT_VP;
__device__ __forceinline__ void attn_unit(int b, int h, int qb, const bf16* Qb, const bf16* Kb, const bf16* Vt, bf16* O, LAS unsigned char* lds) {
    int tid_ = threadIdx.x; asm volatile("" : "+v"(tid_));
    const int tid = tid_, lane = tid & 63, r32 = lane & 31, hi = lane >> 5; const int wid = __builtin_amdgcn_readfirstlane(tid >> 6);
    const int q0 = qb * 256, tok0 = b * SEQ, NT = (q0 + 256) / 64;
    const int kr0 = tid / 12, kc0 = tid % 12, kr1 = (tid + 512) / 12, kc1 = (tid + 512) % 12;
    const bf16* kg0 = Kb + (size_t)(tok0 + kr0) * 768 + h * QKD + kc0 * 8;
    const bf16* kg1 = Kb + (size_t)(tok0 + kr1) * 768 + h * QKD + kc1 * 8;
    const int kl0 = kr0 * ATT_KP + kc0 * 16, kl1 = kr1 * ATT_KP + kc1 * 16;
    const int vd = tid >> 3, vc = tid & 7;
    const bf16* vg = Vt + (size_t)(h * VD + vd) * T + tok0 + vc * 8;
    const int vl = 2 * ATT_KB + vd * ATT_VP + vc * 16;
    const bool k2 = tid < 256;
    const int qrow = tok0 + q0 + wid * 32 + r32; const int qpos = q0 + wid * 32 + r32;
    bf16x8 qf[6];
#pragma unroll
    for (int s = 0; s < 6; ++s) qf[s] = *(const bf16x8*)(Qb + (size_t)qrow * 768 + h * QKD + 16 * s + 8 * hi);
    const int krow = (r32 & ~12) | ((r32 & 4) << 1) | ((r32 & 8) >> 1);
    const int ka = krow * ATT_KP + hi * 16, va = 2 * ATT_KB + r32 * ATT_VP + hi * 16;
    f32x16 o0 = {}, o1 = {}; float mrun = -INFINITY, lrun = 0.f;
    u32x4 kx0, kx1, vx;
    kx0 = *(const u32x4*)kg0; kx1 = k2 ? *(const u32x4*)kg1 : (u32x4){0, 0, 0, 0}; vx = *(const u32x4*)vg;
    *(LAS u32x4*)(lds + kl0) = kx0; if (k2) *(LAS u32x4*)(lds + kl1) = kx1; *(LAS u32x4*)(lds + vl) = vx;
    __syncthreads();
    for (int t = 0; t < NT; ++t) {
        const int cb = t & 1, nb = cb ^ 1;
        const bool more = t + 1 < NT;
        if (more) { kx0 = *(const u32x4*)(kg0 + (size_t)(t + 1) * 64 * 768); if (k2) kx1 = *(const u32x4*)(kg1 + (size_t)(t + 1) * 64 * 768); vx = *(const u32x4*)(vg + (t + 1) * 64); }
        const int kv0 = t * 64;
        if (kv0 <= q0 + wid * 32 + 31) {
            f32x16 p0 = {}, p1 = {};
            const LAS unsigned char* kb = lds + cb * ATT_KB + ka;
#pragma unroll
            for (int s = 0; s < 6; ++s) {
                const bf16x8 a0 = *(const LAS bf16x8*)(kb + s * 32), a1 = *(const LAS bf16x8*)(kb + 32 * ATT_KP + s * 32);
                p0 = __builtin_amdgcn_mfma_f32_32x32x16_bf16(a0, qf[s], p0, 0, 0, 0);
                p1 = __builtin_amdgcn_mfma_f32_32x32x16_bf16(a1, qf[s], p1, 0, 0, 0);
            }
            if (kv0 + 63 > q0 + wid * 32) {
#pragma unroll
                for (int r = 0; r < 16; ++r) { const int kv = kv0 + (r & 7) + 8 * hi + 16 * (r >> 3); if (kv > qpos) p0[r] = -INFINITY; if (kv + 32 > qpos) p1[r] = -INFINITY; }
            }
            float mx = fmaxf(p0[0], p1[0]);
#pragma unroll
            for (int r = 1; r < 16; ++r) mx = fmaxf(mx, fmaxf(p0[r], p1[r]));
            mx = fmaxf(mx, __shfl_xor(mx, 32));
            const float mnew = fmaxf(mrun, mx); const float alpha = __builtin_amdgcn_exp2f(mrun - mnew); mrun = mnew;
            float ls = 0.f;
#pragma unroll
            for (int r = 0; r < 16; ++r) { p0[r] = __builtin_amdgcn_exp2f(p0[r] - mnew); p1[r] = __builtin_amdgcn_exp2f(p1[r] - mnew); ls += p0[r] + p1[r]; }
            lrun = lrun * alpha + ls;
#pragma unroll
            for (int r = 0; r < 16; ++r) { o0[r] *= alpha; o1[r] *= alpha; }
            u32x4 pb[4];
            pb[0] = (u32x4){cvtpk(p0[0], p0[1]), cvtpk(p0[2], p0[3]), cvtpk(p0[4], p0[5]), cvtpk(p0[6], p0[7])};
            pb[1] = (u32x4){cvtpk(p0[8], p0[9]), cvtpk(p0[10], p0[11]), cvtpk(p0[12], p0[13]), cvtpk(p0[14], p0[15])};
            pb[2] = (u32x4){cvtpk(p1[0], p1[1]), cvtpk(p1[2], p1[3]), cvtpk(p1[4], p1[5]), cvtpk(p1[6], p1[7])};
            pb[3] = (u32x4){cvtpk(p1[8], p1[9]), cvtpk(p1[10], p1[11]), cvtpk(p1[12], p1[13]), cvtpk(p1[14], p1[15])};
            const LAS unsigned char* vb = lds + cb * ATT_VB + va;
#pragma unroll
            for (int ks = 0; ks < 4; ++ks) {
                const bf16x8 a0 = *(const LAS bf16x8*)(vb + ks * 32), a1 = *(const LAS bf16x8*)(vb + 32 * ATT_VP + ks * 32);
                const bf16x8 pbv = __builtin_bit_cast(bf16x8, pb[ks]);
                o0 = __builtin_amdgcn_mfma_f32_32x32x16_bf16(a0, pbv, o0, 0, 0, 0);
                o1 = __builtin_amdgcn_mfma_f32_32x32x16_bf16(a1, pbv, o1, 0, 0, 0);
            }
        }
        if (more) { *(LAS u32x4*)(lds + nb * ATT_KB + kl0) = kx0; if (k2) *(LAS u32x4*)(lds + nb * ATT_KB + kl1) = kx1; *(LAS u32x4*)(lds + nb * ATT_VB + vl) = vx; }
        __syncthreads();
    }
    const float lt = lrun + __shfl_xor(lrun, 32); const float il = 1.0f / lt;
    bf16* op = O + (size_t)qrow * 512 + h * VD;
#pragma unroll
    for (int rg = 0; rg < 4; ++rg) {
        u32x2 w0, w1; w0.x = cvtpk(o0[4 * rg] * il, o0[4 * rg + 1] * il); w0.y = cvtpk(o0[4 * rg + 2] * il, o0[4 * rg + 3] * il);
        w1.x = cvtpk(o1[4 * rg] * il, o1[4 * rg + 1] * il); w1.y = cvtpk(o1[4 * rg + 2] * il, o1[4 * rg + 3] * il);
        *(u32x2*)(op + 8 * rg + 4 * hi) = w0; *(u32x2*)(op + 32 + 8 * rg + 4 * hi) = w1;
    }
}
__device__ __forceinline__ void p4_attention(Frame& F) {
    const bf16* Qb = (const bf16*)(F.ws + WS_R1); const bf16* Kb = (const bf16*)(F.ws + WS_KB); const bf16* Vt = (const bf16*)(F.ws + WS_VT); bf16* O = (bf16*)(F.ws + WS_AO);
    for (int p = F.vcu; p < 256; p += F.G) {
        const int bh = p >> 3, s = p & 7;
        attn_unit(bh >> 3, bh & 7, 15 - s, Qb, Kb, Vt, O, F.lds);
        attn_unit(bh >> 3, bh & 7, s, Qb, Kb, Vt, O, F.lds);
    }
}

__device__ __forceinline__ int mono(float x) { const int b = __float_as_int(x); return b ^ ((b >> 31) & 0x7fffffff); }
__device__ __forceinline__ float unmono(int k) { return __int_as_float(k ^ ((k >> 31) & 0x7fffffff)); }
#define TK_INS(L, xx) do { int _x = (xx); _Pragma("unroll") for (int _i = 0; _i < 16; ++_i) { const int _t = max(L[_i], _x); _x = min(L[_i], _x); L[_i] = _t; } } while (0)
__device__ __forceinline__ void peer_side(const bf16* qp, const bf16* sk, int r32, int hi, int (&L)[16]) {
    bf16x8 qf[8];
#pragma unroll
    for (int s = 0; s < 8; ++s) qf[s] = *(const bf16x8*)(qp + 16 * s + 8 * hi);
#pragma unroll
    for (int i = 0; i < 16; ++i) L[i] = (int)0x80000000;
#pragma unroll
    for (int kt = 0; kt < 4; ++kt) {
        f32x16 acc = {};
#pragma unroll
        for (int s = 0; s < 8; ++s) { const bf16x8 a = *(const bf16x8*)(sk + (size_t)(32 * kt + r32) * 128 + 16 * s + 8 * hi); acc = __builtin_amdgcn_mfma_f32_32x32x16_bf16(a, qf[s], acc, 0, 0, 0); }
#pragma unroll
        for (int r = 0; r < 16; ++r) { const int key = 32 * kt + (r & 3) + 8 * (r >> 2); TK_INS(L, (mono(acc[r]) & ~127) | (127 - key)); }
        asm volatile("" ::: "memory");
    }
    int Oth[16];
#pragma unroll
    for (int i = 0; i < 16; ++i) { L[i] ^= (hi << 2); Oth[i] = __shfl_xor(L[i], 32); }
#pragma unroll
    for (int i = 0; i < 16; ++i) TK_INS(L, Oth[i]);
}
__device__ __forceinline__ void p9_peer_topk(Frame& F) {
    const bf16* QP = (const bf16*)(F.ws + WS_R2); const bf16* SK = (const bf16*)(F.ws + WS_SK);
    int* eidx = (int*)(F.ws + WS_EIDX); float* gate = (float*)(F.ws + WS_GATE);
    int lane_ = F.lane; asm volatile("" : "+v"(lane_));
    const int gw = F.vcu * NWAVES + F.wave, NGW = F.G * NWAVES, lane = lane_, r32 = lane & 31, hi = lane >> 5;
    LAS int* tab = (LAS int*)(F.lds + F.wave * 8192);
    for (int it = gw; it < (T / 32) * PEER_H; it += NGW) {
        const int h = it & 7, tb = it >> 3; const int tok = tb * 32 + r32;
        int L1[16], L2[16], L3[16];
        peer_side(QP + (size_t)tok * 2048 + h * 256, SK + (size_t)h * 16384, r32, hi, L1);
        peer_side(QP + (size_t)tok * 2048 + h * 256 + 128, SK + 131072 + (size_t)h * 16384, r32, hi, L2);
        float v1[16], v2[16];
#pragma unroll
        for (int i = 0; i < 16; ++i) { v1[i] = unmono(L1[i] & ~127); v2[i] = unmono(L2[i] & ~127); tab[i * 64 + lane] = 127 - (L1[i] & 127); tab[(16 + i) * 64 + lane] = 127 - (L2[i] & 127); L3[i] = (int)0x80000000; }
#pragma unroll
        for (int a = 0; a < 16; ++a)
#pragma unroll
            for (int b = 0; b < 16; ++b) if ((a + 1) * (b + 1) <= 16) TK_INS(L3, (mono(v1[a] + v2[b]) & ~255) | (255 - (a * 16 + b)));
        float sc[16], ssum = 0.f; int ei[16];
#pragma unroll
        for (int k = 0; k < 16; ++k) { const int ci = 255 - (L3[k] & 255); sc[k] = unmono(L3[k] & ~255);
            ei[k] = tab[(ci >> 4) * 64 + lane] * 128 + tab[(16 + (ci & 15)) * 64 + lane]; }
        const float smax = sc[0];
#pragma unroll
        for (int k = 0; k < 16; ++k) { sc[k] = __builtin_amdgcn_exp2f((sc[k] - smax) * 1.4426950408889634f); ssum += sc[k]; }
        const float inv = 1.0f / ssum;
        const size_t ob = ((size_t)tok * PEER_H + h) * PEER_K;
        if (hi == 0) {
#pragma unroll
            for (int k = 0; k < 16; k += 4) *(u32x4*)(eidx + ob + k) = (u32x4){(unsigned)ei[k], (unsigned)ei[k + 1], (unsigned)ei[k + 2], (unsigned)ei[k + 3]};
        } else {
#pragma unroll
            for (int k = 0; k < 16; k += 4) *(f32x4*)(gate + ob + k) = (f32x4){sc[k] * inv, sc[k + 1] * inv, sc[k + 2] * inv, sc[k + 3] * inv};
        }
        LDS_WAIT();
    }
}
constexpr float EU_SCALE = 32.0f, EV_SCALE = 8.0f;
__device__ __forceinline__ unsigned pk4_fp8(f32x4 v, float sc) { int r = __builtin_amdgcn_cvt_pk_fp8_f32(v[0] * sc, v[1] * sc, 0, false); r = __builtin_amdgcn_cvt_pk_fp8_f32(v[2] * sc, v[3] * sc, r, true); return (unsigned)r; }
__device__ __forceinline__ void cvt_experts(Frame& F) {
    int tid_ = F.tid; asm volatile("" : "+v"(tid_));
    const int gt = (F.vcu * NWAVES * 64) + tid_, NGT = F.G * NWAVES * 64;
    const float* su = F.in[I_EU]; const float* sv = F.in[I_EV]; unsigned char* du = F.ws + WS_EU; unsigned char* dv = F.ws + WS_EV;
    for (int i = gt; i < 16384 * 1024 / 16; i += NGT) { const size_t o = (size_t)i * 16;
        u32x4 a, b;
        a.x = pk4_fp8(*(const f32x4*)(su + o), EU_SCALE); a.y = pk4_fp8(*(const f32x4*)(su + o + 4), EU_SCALE); a.z = pk4_fp8(*(const f32x4*)(su + o + 8), EU_SCALE); a.w = pk4_fp8(*(const f32x4*)(su + o + 12), EU_SCALE);
        b.x = pk4_fp8(*(const f32x4*)(sv + o), EV_SCALE); b.y = pk4_fp8(*(const f32x4*)(sv + o + 4), EV_SCALE); b.z = pk4_fp8(*(const f32x4*)(sv + o + 8), EV_SCALE); b.w = pk4_fp8(*(const f32x4*)(sv + o + 12), EV_SCALE);
        *(u32x4*)(du + o) = a; *(u32x4*)(dv + o) = b; }
}

#define FMAC_V(acc, a, b) asm("v_fmac_f32_e32 %0, %1, %2" : "+v"(acc) : "v"(a), "v"(b))
#define FMAC_S(acc, ws, b) asm("v_fmac_f32_e32 %0, %1, %2" : "+v"(acc) : "s"(ws), "v"(b))
__device__ __forceinline__ float dot16_fp8(u32x4 r, const float (&x)[16]) {
    float a = 0.f, b = 0.f; f32x2 t;
    t = __builtin_amdgcn_cvt_pk_f32_fp8((int)r.x, false); FMAC_V(a, t.x, x[0]);  FMAC_V(b, t.y, x[1]);
    t = __builtin_amdgcn_cvt_pk_f32_fp8((int)r.x, true);  FMAC_V(a, t.x, x[2]);  FMAC_V(b, t.y, x[3]);
    t = __builtin_amdgcn_cvt_pk_f32_fp8((int)r.y, false); FMAC_V(a, t.x, x[4]);  FMAC_V(b, t.y, x[5]);
    t = __builtin_amdgcn_cvt_pk_f32_fp8((int)r.y, true);  FMAC_V(a, t.x, x[6]);  FMAC_V(b, t.y, x[7]);
    t = __builtin_amdgcn_cvt_pk_f32_fp8((int)r.z, false); FMAC_V(a, t.x, x[8]);  FMAC_V(b, t.y, x[9]);
    t = __builtin_amdgcn_cvt_pk_f32_fp8((int)r.z, true);  FMAC_V(a, t.x, x[10]); FMAC_V(b, t.y, x[11]);
    t = __builtin_amdgcn_cvt_pk_f32_fp8((int)r.w, false); FMAC_V(a, t.x, x[12]); FMAC_V(b, t.y, x[13]);
    t = __builtin_amdgcn_cvt_pk_f32_fp8((int)r.w, true);  FMAC_V(a, t.x, x[14]); FMAC_V(b, t.y, x[15]);
    return a + b;
}
__device__ __forceinline__ void axpy16_fp8(float (&y)[16], float w, u32x4 r) {
    f32x2 t;
    t = __builtin_amdgcn_cvt_pk_f32_fp8((int)r.x, false); FMAC_S(y[0], w, t.x);  FMAC_S(y[1], w, t.y);
    t = __builtin_amdgcn_cvt_pk_f32_fp8((int)r.x, true);  FMAC_S(y[2], w, t.x);  FMAC_S(y[3], w, t.y);
    t = __builtin_amdgcn_cvt_pk_f32_fp8((int)r.y, false); FMAC_S(y[4], w, t.x);  FMAC_S(y[5], w, t.y);
    t = __builtin_amdgcn_cvt_pk_f32_fp8((int)r.y, true);  FMAC_S(y[6], w, t.x);  FMAC_S(y[7], w, t.y);
    t = __builtin_amdgcn_cvt_pk_f32_fp8((int)r.z, false); FMAC_S(y[8], w, t.x);  FMAC_S(y[9], w, t.y);
    t = __builtin_amdgcn_cvt_pk_f32_fp8((int)r.z, true);  FMAC_S(y[10], w, t.x); FMAC_S(y[11], w, t.y);
    t = __builtin_amdgcn_cvt_pk_f32_fp8((int)r.w, false); FMAC_S(y[12], w, t.x); FMAC_S(y[13], w, t.y);
    t = __builtin_amdgcn_cvt_pk_f32_fp8((int)r.w, true);  FMAC_S(y[14], w, t.x); FMAC_S(y[15], w, t.y);
}
__device__ __forceinline__ void sort128(int& k0, int& k1, int lane) {
#pragma unroll
    for (int k = 2; k <= 128; k <<= 1) {
#pragma unroll
        for (int j = k >> 1; j > 0; j >>= 1) {
            if (j == 64) { const int lo = min(k0, k1), hi = max(k0, k1); k0 = lo; k1 = hi; }
            else {
                const bool lower = (lane & j) == 0;
                const int p0 = __shfl_xor(k0, j), p1 = __shfl_xor(k1, j);
                const bool up0 = (k == 128) ? true : (k == 64) ? true : ((lane & k) == 0);
                const bool up1 = (k == 128) ? true : (k == 64) ? false : ((lane & k) == 0);
                k0 = (lower == up0) ? min(k0, p0) : max(k0, p0);
                k1 = (lower == up1) ? min(k1, p1) : max(k1, p1);
            }
        }
    }
}
typedef int i32x4 __attribute__((ext_vector_type(4)));
__device__ __forceinline__ u32x4 row_load(__amdgpu_buffer_rsrc_t rsrc, int lane16, int e) { return __builtin_bit_cast(u32x4, __builtin_amdgcn_raw_buffer_load_b128(rsrc, lane16, e << 10, 0)); }
template <bool DRY> __device__ __forceinline__ void p10_peer_experts(Frame& F) {
    int lane_ = F.lane; asm volatile("" : "+v"(lane_));
    const int gw = F.vcu * NWAVES + F.wave, NGW = F.G * NWAVES, lane = lane_, lane16 = lane * 16;
    const bf16* XN = (const bf16*)(F.ws + WS_R1);
    const __amdgpu_buffer_rsrc_t ru = __builtin_amdgcn_make_buffer_rsrc((void*)(F.ws + WS_EU), 0, 16384 * 1024, 0x00020000), rv = __builtin_amdgcn_make_buffer_rsrc((void*)(F.ws + WS_EV), 0, 16384 * 1024, 0x00020000);
    const int* eidx = (const int*)(F.ws + WS_EIDX); const float* gate = (const float*)(F.ws + WS_GATE);
    const float* mod = (const float*)(F.ws + WS_CTL) + CW_MODF; const float* gp = F.in[I_GPOST2];
    const int b5 = (lane >> 5) & 1, b4 = (lane >> 4) & 1, b3 = (lane >> 3) & 1, b2 = (lane >> 2) & 1;
    const int eloc = b5 * 8 + b4 * 4 + b3 * 2 + b2;
    for (int tok = gw; tok < T; tok += NGW) {
        float x[16];
        { const u32x4 xa = *(const u32x4*)(XN + (size_t)tok * D + 16 * lane), xb = *(const u32x4*)(XN + (size_t)tok * D + 16 * lane + 8);
          x[0] = bflo(xa.x); x[1] = bfhi(xa.x); x[2] = bflo(xa.y); x[3] = bfhi(xa.y); x[4] = bflo(xa.z); x[5] = bfhi(xa.z); x[6] = bflo(xa.w); x[7] = bfhi(xa.w);
          x[8] = bflo(xb.x); x[9] = bfhi(xb.x); x[10] = bflo(xb.y); x[11] = bfhi(xb.y); x[12] = bflo(xb.z); x[13] = bfhi(xb.z); x[14] = bflo(xb.w); x[15] = bfhi(xb.w); }
        int k0 = (eidx[(size_t)tok * 128 + lane] << 7) | lane, k1 = (eidx[(size_t)tok * 128 + 64 + lane] << 7) | (64 + lane);
        sort128(k0, k1, lane);
        float y[16];
#pragma unroll
        for (int i = 0; i < 16; ++i) y[i] = 0.f;
        u32x4 U[16], V[16];
#pragma unroll
        for (int j = 0; j < 16; ++j) U[j] = row_load(ru, lane16, __builtin_amdgcn_readlane(k0, j) >> 7);
        for (int kb = 0; kb < 8; ++kb) {
            const int kv = kb < 4 ? k0 : k1; const int lb = (kb & 3) * 16;
#pragma unroll
            for (int j = 0; j < 16; ++j) V[j] = row_load(rv, lane16, __builtin_amdgcn_readlane(kv, lb + j) >> 7);
            __builtin_amdgcn_sched_barrier(0);
            float p[16];
#pragma unroll
            for (int j = 0; j < 16; ++j) p[j] = dot16_fp8(U[j], x);
            float q[8], r4[4], s2[2], tt;
#pragma unroll
            for (int j = 0; j < 8; ++j) { const float keep = b5 ? p[j + 8] : p[j], send = b5 ? p[j] : p[j + 8]; q[j] = keep + __shfl_xor(send, 32); }
#pragma unroll
            for (int j = 0; j < 4; ++j) { const float keep = b4 ? q[j + 4] : q[j], send = b4 ? q[j] : q[j + 4]; r4[j] = keep + __shfl_xor(send, 16); }
#pragma unroll
            for (int j = 0; j < 2; ++j) { const float keep = b3 ? r4[j + 2] : r4[j], send = b3 ? r4[j] : r4[j + 2]; s2[j] = keep + __shfl_xor(send, 8); }
            { const float keep = b2 ? s2[1] : s2[0], send = b2 ? s2[0] : s2[1]; tt = keep + __shfl_xor(send, 4); }
            tt += __shfl_xor(tt, 2); tt += __shfl_xor(tt, 1);
            tt *= (1.0f / EU_SCALE);
            const int pidx = __shfl(kv, lb + eloc) & 127;
            const float g = gate[(size_t)tok * 128 + pidx];
            const float u3 = 0.7978845608028654f * (tt + 0.044715f * tt * tt * tt);
            const float w = g * tt * sigmoidf_(2.0f * u3) * (1.0f / EV_SCALE);
            if (kb < 7) { const int kn = (kb + 1) < 4 ? k0 : k1; const int ln = ((kb + 1) & 3) * 16;
#pragma unroll
                for (int j = 0; j < 16; ++j) U[j] = row_load(ru, lane16, __builtin_amdgcn_readlane(kn, ln + j) >> 7); }
            __builtin_amdgcn_sched_barrier(0);
#pragma unroll
            for (int j = 0; j < 16; ++j) {
                const int sl = ((j >> 3) & 1) * 32 + ((j >> 2) & 1) * 16 + ((j >> 1) & 1) * 8 + (j & 1) * 4;
                const float wj = __int_as_float(__builtin_amdgcn_readlane(__float_as_int(w), sl));
                axpy16_fp8(y, wj, V[j]); }
        }
        float ss = 0.f;
#pragma unroll
        for (int i = 0; i < 16; ++i) ss += y[i] * y[i];
        const float rstd = rsqrtf(wave_sum(ss) * (1.f / D) + RMS_EPS);
        const float* mb = mod + (tok / SEQ) * 6144 + 5 * 1024; float* orow = DRY ? (float*)(F.ws + WS_AO) + (size_t)(tok & 1023) * D : F.out + (size_t)tok * D;
#pragma unroll
        for (int c = 0; c < 4; ++c) { const int col = 16 * lane + 4 * c;
            const f32x4 yy = {y[4 * c], y[4 * c + 1], y[4 * c + 2], y[4 * c + 3]};
            const f32x4 h0 = *(const f32x4*)(orow + col), g0 = *(const f32x4*)(mb + col), p0 = *(const f32x4*)(gp + col);
            *(f32x4*)(orow + col) = h0 + g0 * (yy * rstd * p0); }
    }
}

__device__ __forceinline__ void p9_bruteforce(Frame& F) {
    const bf16* QP = (const bf16*)(F.ws + WS_R2);
    int* eidx = (int*)(F.ws + WS_EIDX); float* gate = (float*)(F.ws + WS_GATE);
    LAS float* sc = (LAS float*)(F.lds);
    (void)sc;
    float* scr = (float*)(F.ws + WS_PIN);
    (void)scr;
    const int gt = (F.vcu * NWAVES * 64) + F.tid, NGT = F.G * NWAVES * 64;
    for (int it = gt; it < T * 8; it += NGT) {
        const int tok = it >> 3, h = it & 7;
        float v[2][16]; int ix[2][16];
        for (int side = 0; side < 2; ++side) {
            const float* K = F.in[side ? I_SK2 : I_SK1] + (size_t)h * 16384;
            const bf16* q = QP + (size_t)tok * 2048 + h * 256 + side * 128;
            float prev = INFINITY; int previ = -1;
            for (int k = 0; k < 16; ++k) {
                float best = -INFINITY; int bi = -1;
                for (int key = 0; key < 128; ++key) {
                    float s = 0.f;
                    for (int d = 0; d < 128; ++d) s += __uint_as_float((unsigned)q[d] << 16) * K[key * 128 + d];
                    const bool after = (s < prev) || (s == prev && key > previ);
                    if (after && (s > best)) { best = s; bi = key; }
                }
                v[side][k] = best; ix[side][k] = bi; prev = best; previ = bi;
            }
        }
        float prev = INFINITY; int previ = -1; float scs[16]; int es[16];
        for (int k = 0; k < 16; ++k) {
            float best = -INFINITY; int bi = -1;
            for (int c = 0; c < 256; ++c) { const float s = v[0][c >> 4] + v[1][c & 15]; const bool after = (s < prev) || (s == prev && c > previ); if (after && s > best) { best = s; bi = c; } }
            scs[k] = best; es[k] = ix[0][bi >> 4] * 128 + ix[1][bi & 15]; prev = best; previ = bi;
        }
        float ssum = 0.f; for (int k = 0; k < 16; ++k) { scs[k] = __expf(scs[k] - scs[0]); ssum += scs[k]; }
        scs[0] = 1.0f;
        for (int k = 0; k < 16; ++k) { eidx[(size_t)it * 16 + k] = es[k]; gate[(size_t)it * 16 + k] = scs[k] / ssum; }
    }
}
__device__ __forceinline__ void p10_bruteforce(Frame& F) {
    const int gw = F.vcu * NWAVES + F.wave, NGW = F.G * NWAVES, lane = F.lane;
    const bf16* XN = (const bf16*)(F.ws + WS_R1); const float* EU = F.in[I_EU]; const float* EV = F.in[I_EV];
    const int* eidx = (const int*)(F.ws + WS_EIDX); const float* gate = (const float*)(F.ws + WS_GATE);
    const float* mod = (const float*)(F.ws + WS_CTL) + CW_MODF; const float* gp = F.in[I_GPOST2];
    for (int tok = gw; tok < T; tok += NGW) {
        float x[16], y[16];
        for (int i = 0; i < 16; ++i) { x[i] = __uint_as_float((unsigned)XN[(size_t)tok * D + lane + 64 * i] << 16); y[i] = 0.f; }
        for (int k = 0; k < 128; ++k) {
            const int e = eidx[(size_t)tok * 128 + k]; const float g = gate[(size_t)tok * 128 + k];
            float p = 0.f;
            for (int i = 0; i < 16; ++i) p += x[i] * EU[(size_t)e * D + lane + 64 * i];
            p = wave_sum(p);
            const float u3 = 0.7978845608028654f * (p + 0.044715f * p * p * p);
            const float w = g * 0.5f * p * (1.0f + tanhf(u3));
            for (int i = 0; i < 16; ++i) y[i] += w * EV[(size_t)e * D + lane + 64 * i];
        }
        float ss = 0.f; for (int i = 0; i < 16; ++i) ss += y[i] * y[i];
        const float rstd = rsqrtf(wave_sum(ss) * (1.f / D) + RMS_EPS);
        const float* mb = mod + (tok / SEQ) * 6144 + 5 * 1024; float* orow = F.out + (size_t)tok * D;
        for (int i = 0; i < 16; ++i) { const int col = lane + 64 * i; orow[col] = orow[col] + mb[col] * (y[i] * rstd * gp[col]); }
    }
}
#ifndef PH_MASK
#define PH_MASK 0xFFFFFFFFu
#endif
#define PH(k) ((PH_MASK >> (k)) & 1u)
__global__ void __launch_bounds__(NWAVES * 64, 2) fwd_megakernel(Args args) {
    extern __shared__ __attribute__((aligned(16))) unsigned char lds_raw[];
    Frame F;
    F.lds = (LAS unsigned char*)lds_raw;
    F.tid = threadIdx.x; F.lane = F.tid & 63; F.wave = __builtin_amdgcn_readfirstlane(F.tid >> 6);
    F.G = gridDim.x; { const int bx = blockIdx.x; F.vcu = (F.G % 8 == 0) ? (bx % 8) * (F.G / 8) + bx / 8 : bx; }
    F.in = args.in; F.out = args.out; F.ws = args.ws;
    unsigned char* ws = args.ws;
    volatile LAS unsigned* MISC = (volatile LAS unsigned*)(F.lds + LDSCTL_OFF);
    for (int u = F.tid; u < 64; u += NWAVES * 64) MISC[u] = 0u;
    __syncthreads();
    XcdBarrier bar = xcd_barrier_post((unsigned*)(ws + WS_CTL) + CW_BAR, MISC + 8);
#define GRID_BAR() xcd_barrier(bar)
    using namespace pg8;
    long long* rsq = (long long*)((unsigned*)(ws + WS_CTL) + CW_RSQ); long long* rsk = (long long*)((unsigned*)(ws + WS_CTL) + CW_RSK); const float* rope = (const float*)(ws + WS_ROPE);
    bf16* PROJ = (bf16*)(ws + WS_R2);
    if (PH(0)) p0_prologue(F); GRID_BAR();
    if (PH(1)) p1_xn(F); GRID_BAR();
    if (PH(2)) { Gemm g{(const bf16*)(ws + WS_R1), (const bf16*)(ws + WS_WIN), T, PROJ_N, 1024, 1024, 1024}; StaticOrder S; S.init(T, PROJ_N, F.G, (int)blockIdx.x);
      EpiProj E{PROJ, (bf16*)(ws + WS_KB), rsq, rsk, rope}; gemm_phase<EpiProj, true>(F.lds, g, S, E); }
    GRID_BAR();
    if (PH(3)) p3_pool(F);
    if (PH(4)) { Gemm g{PROJ + 512, (const bf16*)(ws + WS_WQ), T, 768, 256, PROJ_N, 256}; StaticOrder S; S.init(T, 768, F.G, (int)blockIdx.x);
      EpiQ E{(bf16*)(ws + WS_R1), rsq, rope}; gemm_phase<EpiQ, true>(F.lds, g, S, E); }
    if (PH(5)) { Gemm g{PROJ + 768, (const bf16*)(ws + WS_WK), T, 512, 256, PROJ_N, 256}; StaticOrder S; S.init(T, 512, F.G, (int)blockIdx.x);
      EpiKn E{(bf16*)(ws + WS_KB), rsk}; gemm_phase<EpiKn, true>(F.lds, g, S, E); }
    if (PH(6)) { Gemm g{(const bf16*)(ws + WS_WV), PROJ + 768, 512, T, 256, 256, PROJ_N}; StaticOrder S; S.init(512, T, F.G, (int)blockIdx.x);
      EpiVt E{(bf16*)(ws + WS_VT), rsk}; gemm_phase<EpiVt, true>(F.lds, g, S, E); }
    GRID_BAR();
    if (PH(7)) { Gemm g{(const bf16*)(ws + WS_PIN), (const bf16*)(ws + WS_WG), T, 512, 512, 512, 512}; StaticOrder S; S.init(T, 512, F.G, (int)blockIdx.x);
      EpiPlain E{(bf16*)(ws + WS_PF), 512}; gemm_phase<EpiPlain, true>(F.lds, g, S, E); }
    if (PH(8)) p4_attention(F);
#if defined(DUP_ATT)
    p4_attention(F);
#endif
    GRID_BAR();
    if (PH(9)) { Gemm g{(const bf16*)(ws + WS_PF), (const bf16*)(ws + WS_WPO), T, 1024, 512, 512, 512}; StaticOrder S; S.init(T, 1024, F.G, (int)blockIdx.x);
      EpiGate<0> E{(bf16*)(ws + WS_MRG), PROJ, 1024}; gemm_phase<EpiGate<0>, true>(F.lds, g, S, E); }
    asm volatile("s_waitcnt vmcnt(0)" ::: "memory"); __syncthreads();
    if (PH(10)) { Gemm g{(const bf16*)(ws + WS_AO), (const bf16*)(ws + WS_WMO), T, 1024, 512, 512, 512}; StaticOrder S; S.init(T, 1024, F.G, (int)blockIdx.x);
      EpiGate<1> E{(bf16*)(ws + WS_MRG), PROJ, 2048}; gemm_phase<EpiGate<1>, true>(F.lds, g, S, E); }
    GRID_BAR();
    if (PH(11)) { Gemm g{(const bf16*)(ws + WS_MRG), (const bf16*)(ws + WS_WOUT), T, 1024, 1024, 1024, 1024}; StaticOrder S; S.init(T, 1024, F.G, (int)blockIdx.x);
      EpiPlain E{(bf16*)(ws + WS_R2), 1024}; gemm_phase<EpiPlain, true>(F.lds, g, S, E); }
    GRID_BAR();
    if (PH(12)) p7_rows(F); GRID_BAR();
    if (PH(13)) { Gemm g{(const bf16*)(ws + WS_R1), (const bf16*)(ws + WS_WQY), T, 2048, 1024, 1024, 1024}; StaticOrder S; S.init(T, 2048, F.G, (int)blockIdx.x);
      EpiPlain E{(bf16*)(ws + WS_R2), 2048}; gemm_phase<EpiPlain, true>(F.lds, g, S, E); }
    GRID_BAR();
    if (PH(14)) cvt_experts(F);
#if defined(BF_P9)
    if (PH(15)) p9_bruteforce(F);
#else
    if (PH(15)) p9_peer_topk(F);
#if defined(DUP_TOPK)
    p9_peer_topk(F);
#endif
#endif
    GRID_BAR();
#if defined(BF_P10)
    if (PH(16)) p10_bruteforce(F);
#else
#if defined(DUP_P10)
    p10_peer_experts<true>(F);
#endif
    if (PH(16)) p10_peer_experts<false>(F);
#endif
}

extern "C" void kernel_launch(void* const* d_in, const int* in_sizes, int n_in, void* d_out, int out_size, void* d_ws, size_t ws_size, hipStream_t stream) {
    static int grid = 0;
    if (grid == 0) {
        if (n_in != 23 || out_size != T * D || ws_size < WS_END) { fprintf(stderr, "kernel_launch: unexpected shapes (n_in %d out %d ws %zu)\n", n_in, out_size, ws_size); grid = -1; return; }
        int dev = 0, cus = 0, per_cu = 0;
        if (hipGetDevice(&dev) != hipSuccess || hipDeviceGetAttribute(&cus, hipDeviceAttributeMultiprocessorCount, dev) != hipSuccess) { grid = -1; return; }
        if (hipFuncSetAttribute((const void*)fwd_megakernel, hipFuncAttributeMaxDynamicSharedMemorySize, LDS_BYTES) != hipSuccess) { fprintf(stderr, "kernel_launch: hipFuncSetAttribute failed\n"); grid = -1; return; }
        if (hipOccupancyMaxActiveBlocksPerMultiprocessor(&per_cu, (const void*)fwd_megakernel, NWAVES * 64, LDS_BYTES) != hipSuccess || per_cu < 1) { fprintf(stderr, "kernel_launch: note: occupancy query says %d workgroups per CU\n", per_cu); (void)hipGetLastError(); }
        grid = cus;
    }
    if (grid < 0) return;
    (void)hipMemsetAsync((char*)d_ws + WS_CTL, 0, CTL_ZERO_BYTES, stream);
    Args a{};
    for (int i = 0; i < 23; ++i) a.in[i] = (const float*)d_in[i];
    a.out = (float*)d_out; a.ws = (unsigned char*)d_ws;
    hipLaunchKernelGGL(fwd_megakernel, dim3(grid), dim3(NWAVES * 64), LDS_BYTES, stream, a);
}
```

```cpp
#include <hip/hip_runtime.h>
#include <cstdio>
#include <cstdint>

#ifndef DIAG
#define DIAG 0
#endif
#define LAS __attribute__((address_space(3)))
#define GAS __attribute__((address_space(1)))
typedef unsigned short bf16;
typedef short bf16x8 __attribute__((ext_vector_type(8)));
typedef float f32x4 __attribute__((ext_vector_type(4)));
typedef float f32x2 __attribute__((ext_vector_type(2)));
typedef float f32x16 __attribute__((ext_vector_type(16)));
typedef unsigned u32x4 __attribute__((ext_vector_type(4)));
typedef unsigned u32x2 __attribute__((ext_vector_type(2)));
typedef __bf16 bf16x2_t __attribute__((ext_vector_type(2)));

constexpr int NBATCH = 4, SEQ = 4096, T = NBATCH * SEQ, D = 1024;
constexpr int PROJ_N = 3072;
constexpr int NHEAD = 8, QKD = 96, VD = 64;
constexpr float RMS_EPS = 1e-6f;
constexpr float ATT_C2 = 0.10206207261596577f * 1.4426950408889634f;
constexpr int PEER_H = 8, PEER_K = 16;

constexpr size_t MiB = 1u << 20;
constexpr size_t WS_CTL = 0, CTL_ZERO_BYTES = 1 * MiB;
constexpr size_t WS_WIN = 1 * MiB;
constexpr size_t WS_WQ = 7 * MiB;
constexpr size_t WS_WK = WS_WQ + 512 * 1024;
constexpr size_t WS_WV = WS_WK + 256 * 1024;
constexpr size_t WS_WG = 8 * MiB;
constexpr size_t WS_WPO = WS_WG + 512 * 1024;
constexpr size_t WS_WMO = WS_WPO + 1 * MiB;
constexpr size_t WS_WOUT = WS_WMO + 1 * MiB;
constexpr size_t WS_WQY = 13 * MiB;
constexpr size_t WS_SK = 17 * MiB;
constexpr size_t WS_ROPE = WS_SK + 512 * 1024;
constexpr size_t WS_R1 = 18 * MiB;
constexpr size_t WS_R2 = 50 * MiB;
constexpr size_t WS_EIDX = WS_R2 + 64 * MiB;
constexpr size_t WS_GATE = WS_EIDX + 8 * MiB;
constexpr size_t WS_KB = 146 * MiB;
constexpr size_t WS_VT = 170 * MiB;
constexpr size_t WS_MRG = 146 * MiB;
constexpr size_t WS_PIN = 186 * MiB;
constexpr size_t WS_PF = 202 * MiB;
constexpr size_t WS_AO = 218 * MiB;
constexpr size_t WS_EU = 146 * MiB;
constexpr size_t WS_EV = 178 * MiB;
constexpr size_t WS_END = 234 * MiB;
constexpr int CW_BAR = 4096;
constexpr int CW_MOD = 16384;
constexpr int CW_RSQ = CW_MOD + 2 * 4 * 6144;
constexpr int CW_RSK = CW_RSQ + 2 * T;
constexpr int CW_MODF = CW_RSK + 2 * T;
static_assert((CW_MODF + 4 * 6144) * 4 <= (int)CTL_ZERO_BYTES, "ctl");
constexpr double MOD_FX = 1099511627776.0, RS_FX = 16777216.0;
__device__ __forceinline__ void fx_add(long long* p, float v, double scale) { atomicAdd((unsigned long long*)p, (unsigned long long)__double2ll_rn((double)v * scale)); }
__device__ __forceinline__ float fx_get(const long long* p, double inv_scale) { return (float)((double)(*p) * inv_scale); }

__device__ __forceinline__ unsigned cvtpk(float lo, float hi) { f32x2 v = {lo, hi}; bf16x2_t b = __builtin_convertvector(v, bf16x2_t); return __builtin_bit_cast(unsigned, b); }
__device__ __forceinline__ float bflo(unsigned w) { return __uint_as_float(w << 16); }
__device__ __forceinline__ float bfhi(unsigned w) { return __uint_as_float(w & 0xffff0000u); }
__device__ __forceinline__ u32x4 pack8(f32x4 a, f32x4 b) { u32x4 w; w.x = cvtpk(a[0], a[1]); w.y = cvtpk(a[2], a[3]); w.z = cvtpk(b[0], b[1]); w.w = cvtpk(b[2], b[3]); return w; }
__device__ __forceinline__ void unpack8(u32x4 w, f32x4& a, f32x4& b) { a = (f32x4){bflo(w.x), bfhi(w.x), bflo(w.y), bfhi(w.y)}; b = (f32x4){bflo(w.z), bfhi(w.z), bflo(w.w), bfhi(w.w)}; }
__device__ __forceinline__ float sigmoidf_(float x) { return __builtin_amdgcn_rcpf(1.0f + __builtin_amdgcn_exp2f(-1.4426950408889634f * x)); }
__device__ __forceinline__ float wave_sum(float v) {
#pragma unroll
    for (int o = 1; o < 64; o <<= 1) v += __shfl_xor(v, o);
    return v;
}
#define LDS_WAIT() asm volatile("s_waitcnt lgkmcnt(0)" ::: "memory")

namespace pg8 {
typedef unsigned short bf16_t;
constexpr int BM = 256, BK = 64, HALF = 128, HTB = HALF * BK * 2, STAGE_BYTES = 8 * HTB, NXCD = 8, WGM = 8;
__host__ __device__ __forceinline__ int lds_byte(int r, int c) { const int st = (r >> 4) * 2 + (c >> 5), rr = r & 15, cc = c & 31, ob = rr * 64 + cc * 2; return st * 1024 + (ob ^ (((ob >> 9) & 1) << 5)); }
__host__ __device__ __forceinline__ void stage_rc(int b, int& R, int& C) { const int st = b / 1024, sb = b % 1024, swz = sb ^ (((sb >> 9) & 1) << 5); R = (st >> 1) * 16 + swz / 64; C = (st & 1) * 32 + (swz % 64) / 2; }
__host__ __device__ __forceinline__ int perm32(int rho) { const int n = rho >> 4, i = rho & 15; return 8 * (i >> 2) + 4 * n + (i & 3); }
struct Unit { int pm, pn; };
struct Gemm { const bf16_t* A; const bf16_t* Bt; int M, N, K, lda, ldb; };
struct StaticOrder {
    int nM, nN, nwg, G, c;
    __host__ __device__ void init(int M, int N, int G_, int c_) { nM = M / BM; nN = N / BM; nwg = nM * nN; G = G_; c = c_; }
    __host__ __device__ bool next(int i, Unit& u) const {
        const long L = (long)i * G + c; if (L >= nwg) return false;
        int wgid = (int)L; { const int q = nwg / NXCD, r = nwg % NXCD, xcd = wgid % NXCD, off = wgid / NXCD; wgid = (xcd < r ? xcd * (q + 1) : r * (q + 1) + (xcd - r) * q) + off; }
        const int nig = WGM * nN, gid = wgid / nig, fm = gid * WGM, gsz = (nM - fm) < WGM ? (nM - fm) : WGM;
        u.pm = fm + ((wgid % nig) % gsz); u.pn = (wgid % nig) / gsz; return true;
    }
};
template <class Epi, bool ALIGN_EPI>
__device__ __forceinline__ void gemm_phase(LAS unsigned char* lds, const Gemm g, const StaticOrder& S, const Epi& E) {
    int tid_ = threadIdx.x; asm volatile("" : "+v"(tid_));
    const int tid = tid_, wid = __builtin_amdgcn_readfirstlane(tid >> 6), lane = tid & 63, wr = wid >> 2, wc = wid & 3, fr = lane & 15, fq = lane >> 4;
    int K_ = g.K; asm volatile("" : "+s"(K_));
    const int K = K_, nt = K / BK;
    unsigned voffA[2], voffB[2];
#pragma unroll
    for (int i = 0; i < 2; ++i) { int R, C; stage_rc(tid * 16 + i * 8192, R, C); const int Rb = (R & ~31) + perm32(R & 31);
        voffA[i] = (unsigned)(R * g.lda + C) * 2u; voffB[i] = (unsigned)(Rb * g.ldb + C) * 2u; }
    const size_t kstep = (size_t)(BK * 2);
    const size_t hstepA = (size_t)HALF * g.lda * 2, hstepB = (size_t)HALF * g.ldb * 2;
    const size_t tstepA = 2 * hstepA, tstepB = 2 * hstepB;
    const unsigned ldsw = (unsigned)wid * 1024u;
    const int aoff = lds_byte(wr * 64 + fr, fq * 8), boff = lds_byte(wc * 32 + fr, fq * 8);
#define PG8_SA(b, h) (((b) * 2 + (h)) * HTB)
#define PG8_SB(b, h) ((4 + (b) * 2 + (h)) * HTB)
#define PG8_STAGE(bufoff, gbase, voff) do { _Pragma("unroll") for (int _i = 0; _i < 2; ++_i) \
        __builtin_amdgcn_global_load_lds((const unsigned*)((const char*)(gbase) + (voff)[_i]), (LAS unsigned*)(lds + (bufoff) + ldsw + _i * 8192), 16, 0, 0); } while (0)
#define PG8_LDA(dst, b, h) do { _Pragma("unroll") for (int m = 0; m < 4; ++m) _Pragma("unroll") for (int k = 0; k < 2; ++k) dst[m][k] = *(const LAS bf16x8*)(lds + PG8_SA(b, h) + aoff + m * 2048 + k * 1024); } while (0)
#define PG8_LDB(dst, b, h) do { _Pragma("unroll") for (int n = 0; n < 2; ++n) _Pragma("unroll") for (int k = 0; k < 2; ++k) dst[n][k] = *(const LAS bf16x8*)(lds + PG8_SB(b, h) + boff + n * 2048 + k * 1024); } while (0)
#define PG8_MMA(ai, bj, At, Bt) do { __builtin_amdgcn_s_setprio(1); _Pragma("unroll") for (int m = 0; m < 4; ++m) _Pragma("unroll") for (int n = 0; n < 2; ++n) _Pragma("unroll") for (int k = 0; k < 2; ++k) \
        acc[ai][bj][m][n] = __builtin_amdgcn_mfma_f32_16x16x32_bf16(Bt[n][k], At[m][k], acc[ai][bj][m][n], 0, 0, 0); __builtin_amdgcn_s_setprio(0); } while (0)
#define PG8_WAIT_V(n) asm volatile("s_waitcnt vmcnt(" #n ")" ::: "memory")
#define PG8_WAIT_L(n) asm volatile("s_waitcnt lgkmcnt(" #n ")" ::: "memory")
#define PG8_BAR __builtin_amdgcn_s_barrier()
#define PG8_SCHED __builtin_amdgcn_sched_barrier(0)
    Unit cur, nxt; int ui = 0;
    if (!S.next(0, cur)) return;
    f32x4 acc[2][2][4][2];
#pragma unroll
    for (int a = 0; a < 2; ++a)
#pragma unroll
        for (int b = 0; b < 2; ++b)
#pragma unroll
            for (int m = 0; m < 4; ++m)
#pragma unroll
                for (int n = 0; n < 2; ++n) acc[a][b][m][n] = (f32x4){0.f, 0.f, 0.f, 0.f};
    bf16x8 At[4][2], B0[2][2], B1[2][2];
    const char* cA = (const char*)g.A + (size_t)cur.pm * tstepA; const char* cB = (const char*)g.Bt + (size_t)cur.pn * tstepB;
    PG8_STAGE(PG8_SB(0, 0), cB, voffB); PG8_STAGE(PG8_SB(0, 1), cB + hstepB, voffB); PG8_STAGE(PG8_SA(0, 0), cA, voffA); PG8_STAGE(PG8_SA(0, 1), cA + hstepA, voffA);
    if (wr == 1) PG8_BAR;
    PG8_WAIT_V(2); PG8_BAR;
    PG8_STAGE(PG8_SB(1, 0), cB + kstep, voffB); PG8_STAGE(PG8_SA(1, 0), cA + kstep, voffA); PG8_STAGE(PG8_SB(1, 1), cB + hstepB + kstep, voffB);
    PG8_WAIT_V(6); PG8_BAR;
    for (;;) {
        const bool has_next = S.next(ui + 1, nxt);
        const char* nA = has_next ? (const char*)g.A + (size_t)nxt.pm * tstepA : cA; const char* nB = has_next ? (const char*)g.Bt + (size_t)nxt.pn * tstepB : cB;
        for (int t = 0; t < nt; t += 2) {
            const bool last = (t == nt - 2);
            const char* a1 = cA + (size_t)(t + 1) * kstep;
            const char* a2 = last ? nA : cA + (size_t)(t + 2) * kstep; const char* b2 = last ? nB : cB + (size_t)(t + 2) * kstep;
            const char* a3 = a2 + kstep; const char* b3 = b2 + kstep;
            PG8_LDB(B0, 0, 0); PG8_LDB(B1, 0, 1); PG8_SCHED; PG8_LDA(At, 0, 0); PG8_STAGE(PG8_SA(1, 1), a1 + hstepA, voffA);
            PG8_WAIT_V(8); PG8_WAIT_L(0); PG8_BAR; PG8_MMA(0, 0, At, B0); PG8_MMA(0, 1, At, B1); PG8_BAR; PG8_SCHED;
            PG8_LDA(At, 0, 1); PG8_STAGE(PG8_SB(0, 0), b2, voffB); PG8_STAGE(PG8_SB(0, 1), b2 + hstepB, voffB); PG8_STAGE(PG8_SA(0, 0), a2, voffA);
            PG8_WAIT_V(8); PG8_WAIT_L(0); PG8_BAR; PG8_MMA(1, 0, At, B0); PG8_MMA(1, 1, At, B1); PG8_BAR; PG8_SCHED;
            PG8_LDB(B0, 1, 0); PG8_LDB(B1, 1, 1); PG8_SCHED; PG8_LDA(At, 1, 0); PG8_STAGE(PG8_SA(0, 1), a2 + hstepA, voffA);
            PG8_WAIT_V(8); PG8_WAIT_L(0); PG8_BAR; PG8_MMA(0, 0, At, B0); PG8_MMA(0, 1, At, B1); PG8_BAR; PG8_SCHED;
            PG8_LDA(At, 1, 1); PG8_STAGE(PG8_SB(1, 0), b3, voffB); PG8_STAGE(PG8_SB(1, 1), b3 + hstepB, voffB); PG8_STAGE(PG8_SA(1, 0), a3, voffA);
            PG8_WAIT_V(8); PG8_WAIT_L(0); PG8_BAR; PG8_MMA(1, 0, At, B0); PG8_MMA(1, 1, At, B1); PG8_BAR; PG8_SCHED;
        }
        if constexpr (ALIGN_EPI) { if (wr == 0) PG8_BAR; }
        E(acc, cur, wr, wc, fr, fq);
        if (!has_next) break;
#pragma unroll
        for (int a = 0; a < 2; ++a)
#pragma unroll
            for (int b = 0; b < 2; ++b)
#pragma unroll
                for (int m = 0; m < 4; ++m)
#pragma unroll
                    for (int n = 0; n < 2; ++n) acc[a][b][m][n] = (f32x4){0.f, 0.f, 0.f, 0.f};
        cur = nxt; cA = nA; cB = nB; ++ui;
        if constexpr (ALIGN_EPI) { if (wr == 1) PG8_BAR; }
    }
    PG8_WAIT_V(0);
    if constexpr (!ALIGN_EPI) { if (wr == 0) PG8_BAR; }
    PG8_BAR;
#undef PG8_SA
#undef PG8_SB
#undef PG8_STAGE
#undef PG8_LDA
#undef PG8_LDB
#undef PG8_MMA
#undef PG8_WAIT_V
#undef PG8_WAIT_L
#undef PG8_BAR
#undef PG8_SCHED
}

#define EPI_ARGS const f32x4 (&acc)[2][2][4][2], const Unit& u, int wr, int wc, int fr, int fq
__device__ __forceinline__ void rope8(f32x4& v0, f32x4& v1, const float* tab, int e0) {
    const f32x4 c = *(const f32x4*)(tab + e0), s = *(const f32x4*)(tab + 16 + e0);
    const float a0 = v0[0] * c[0] - v0[1] * s[0], b0 = v0[1] * c[0] + v0[0] * s[0];
    const float a1 = v0[2] * c[1] - v0[3] * s[1], b1 = v0[3] * c[1] + v0[2] * s[1];
    const float a2 = v1[0] * c[2] - v1[1] * s[2], b2 = v1[1] * c[2] + v1[0] * s[2];
    const float a3 = v1[2] * c[3] - v1[3] * s[3], b3 = v1[3] * c[3] + v1[2] * s[3];
    v0 = (f32x4){a0, b0, a1, b1}; v1 = (f32x4){a2, b2, a3, b3};
}
struct EpiPlain { bf16* O; int ldc;
    __device__ __forceinline__ void operator()(EPI_ARGS) const {
#pragma unroll
        for (int ai = 0; ai < 2; ++ai)
#pragma unroll
            for (int m = 0; m < 4; ++m) { const int row = u.pm * BM + ai * HALF + wr * 64 + m * 16 + fr;
#pragma unroll
                for (int bj = 0; bj < 2; ++bj) { const int col0 = u.pn * BM + bj * HALF + wc * 32 + 8 * fq;
                    *(u32x4*)(O + (size_t)row * ldc + col0) = pack8(acc[ai][bj][m][0], acc[ai][bj][m][1]); } }
    }
};
struct EpiProj { bf16* P; bf16* Kb; long long* rsq; long long* rsk; const float* rope;
    __device__ __forceinline__ void operator()(EPI_ARGS) const {
        const int pn = u.pn;
#pragma unroll
        for (int ai = 0; ai < 2; ++ai)
#pragma unroll
            for (int m = 0; m < 4; ++m) { const int row = u.pm * BM + ai * HALF + wr * 64 + m * 16 + fr; float ss = 0.f;
#pragma unroll
                for (int bj = 0; bj < 2; ++bj) { const int col0 = pn * BM + bj * HALF + wc * 32 + 8 * fq;
                    f32x4 v0 = acc[ai][bj][m][0], v1 = acc[ai][bj][m][1];
                    if (pn >= 4) {
#pragma unroll
                        for (int i = 0; i < 4; ++i) { v0[i] = sigmoidf_(v0[i]); v1[i] = sigmoidf_(v1[i]); }
                    }
                    *(u32x4*)(P + (size_t)row * PROJ_N + col0) = pack8(v0, v1);
                    if (pn == 2 || (pn == 3 && bj == 0)) ss += (v0[0] * v0[0] + v0[1] * v0[1]) + (v0[2] * v0[2] + v0[3] * v0[3]) + (v1[0] * v1[0] + v1[1] * v1[1]) + (v1[2] * v1[2] + v1[3] * v1[3]);
                    if (pn == 3 && bj == 1 && wc == 0) {
                        rope8(v0, v1, rope + (size_t)(row & (SEQ - 1)) * 32, 4 * fq);
                        const u32x4 w = pack8(v0, v1);
#pragma unroll
                        for (int h = 0; h < NHEAD; ++h) *(u32x4*)(Kb + (size_t)row * (NHEAD * QKD) + h * QKD + 64 + 8 * fq) = w;
                    }
                }
                if (pn == 2 || pn == 3) { ss += __shfl_xor(ss, 16); ss += __shfl_xor(ss, 32);
                    if (fq == 0) fx_add((pn == 2 ? rsq : rsk) + row, ss, RS_FX); }
            }
    }
};
struct EpiQ { bf16* Q; const long long* rsq; const float* rope;
    __device__ __forceinline__ void operator()(EPI_ARGS) const {
#pragma unroll
        for (int ai = 0; ai < 2; ++ai)
#pragma unroll
            for (int m = 0; m < 4; ++m) { const int row = u.pm * BM + ai * HALF + wr * 64 + m * 16 + fr;
                const float sc = rsqrtf(fx_get(rsq + row, 1.0 / RS_FX) * (1.0f / 256.0f) + RMS_EPS) * ATT_C2;
#pragma unroll
                for (int bj = 0; bj < 2; ++bj) { const int col0 = u.pn * BM + bj * HALF + wc * 32 + 8 * fq;
                    f32x4 v0 = acc[ai][bj][m][0] * sc, v1 = acc[ai][bj][m][1] * sc;
                    if (((u.pn * 8 + bj * 4 + wc) % 3) == 2) rope8(v0, v1, rope + (size_t)(row & (SEQ - 1)) * 32, 4 * fq);
                    *(u32x4*)(Q + (size_t)row * (NHEAD * QKD) + col0) = pack8(v0, v1); }
                asm volatile("" ::: "memory"); }
    }
};
struct EpiKn { bf16* Kb; const long long* rsk;
    __device__ __forceinline__ void operator()(EPI_ARGS) const {
#pragma unroll
        for (int ai = 0; ai < 2; ++ai)
#pragma unroll
            for (int m = 0; m < 4; ++m) { const int row = u.pm * BM + ai * HALF + wr * 64 + m * 16 + fr;
                const float sc = rsqrtf(fx_get(rsk + row, 1.0 / RS_FX) * (1.0f / 128.0f) + RMS_EPS);
#pragma unroll
                for (int bj = 0; bj < 2; ++bj) { const int col0 = u.pn * BM + bj * HALF + wc * 32 + 8 * fq; const int h = col0 >> 6, j = col0 & 63;
                    *(u32x4*)(Kb + (size_t)row * (NHEAD * QKD) + h * QKD + j) = pack8(acc[ai][bj][m][0] * sc, acc[ai][bj][m][1] * sc); }
                if (m & 1) asm volatile("" ::: "memory"); }
    }
};
struct EpiVt { bf16* Vt; const long long* rsk;
    __device__ __forceinline__ void operator()(EPI_ARGS) const {
#pragma unroll
        for (int bj = 0; bj < 2; ++bj) { const int col0 = u.pn * BM + bj * HALF + wc * 32 + 8 * fq;
            f32x4 s0, s1;
#pragma unroll
            for (int i = 0; i < 4; ++i) { s0[i] = rsqrtf(fx_get(rsk + col0 + i, 1.0 / RS_FX) * (1.0f / 128.0f) + RMS_EPS); s1[i] = rsqrtf(fx_get(rsk + col0 + 4 + i, 1.0 / RS_FX) * (1.0f / 128.0f) + RMS_EPS); }
#pragma unroll
            for (int ai = 0; ai < 2; ++ai)
#pragma unroll
                for (int m = 0; m < 4; ++m) { const int row = u.pm * BM + ai * HALF + wr * 64 + m * 16 + fr;
                    *(u32x4*)(Vt + (size_t)row * T + col0) = pack8(acc[ai][bj][m][0] * s0, acc[ai][bj][m][1] * s1); }
            asm volatile("" ::: "memory"); }
    }
};
template <int MODE> struct EpiGate { bf16* Y; const bf16* P; int goff;
    __device__ __forceinline__ void operator()(EPI_ARGS) const {
#pragma unroll
        for (int ai = 0; ai < 2; ++ai)
#pragma unroll
            for (int m = 0; m < 4; ++m) { const int row = u.pm * BM + ai * HALF + wr * 64 + m * 16 + fr;
#pragma unroll
                for (int bj = 0; bj < 2; ++bj) { const int col0 = u.pn * BM + bj * HALF + wc * 32 + 8 * fq;
                    f32x4 g0, g1; unpack8(*(const u32x4*)(P + (size_t)row * PROJ_N + goff + col0), g0, g1);
                    f32x4 v0 = acc[ai][bj][m][0] * g0, v1 = acc[ai][bj][m][1] * g1;
                    bf16* yp = Y + (size_t)row * D + col0;
                    if (MODE == 1) { f32x4 y0, y1; unpack8(*(const u32x4*)yp, y0, y1); v0 += y0; v1 += y1; }
                    *(u32x4*)yp = pack8(v0, v1); } }
    }
};
}

#define XB_TMO      128
#define XB_XCNT(j)  (256  + 64 * (j))
#define XB_XSUB(j)  (1280 + 64 * (j))
#define XB_XGEN(j)  (2304 + 64 * (j))
#define XB_TOP      3328
#define XB_TOPGEN   3392
#define XCD_BAR_WORDS 3456
#define XB_SPIN_CAP (1u << 18)
__device__ __forceinline__ unsigned xb_ld(unsigned* p)              { return __hip_atomic_load(p, __ATOMIC_RELAXED, __HIP_MEMORY_SCOPE_AGENT); }
__device__ __forceinline__ unsigned xb_add(unsigned* p, unsigned v) { return __hip_atomic_fetch_add(p, v, __ATOMIC_RELAXED, __HIP_MEMORY_SCOPE_AGENT); }
__device__ __forceinline__ unsigned xb_xcc_id() { return (unsigned)__builtin_amdgcn_s_getreg((3 << 11) | 20) & 0xFu; }
#define XB_SPIN(cond, bar) do { unsigned _sp = 0; while (cond) { __builtin_amdgcn_s_sleep(1); \
    if ((++_sp & 255u) == 0u) { if (xb_ld(&(bar)[XB_TMO])) break; if (_sp > XB_SPIN_CAP) { atomicAdd(&(bar)[XB_TMO], 1u); break; } } } } while (0)
struct XcdBarrier { unsigned* bar; unsigned x; volatile LAS unsigned* st; };
__device__ __forceinline__ XcdBarrier xcd_barrier_post(unsigned* bar, volatile LAS unsigned* st) {
    XcdBarrier b; b.bar = bar; b.x = xb_xcc_id(); b.st = st;
    if (threadIdx.x == 0) (void)xb_add(&bar[XB_XCNT(b.x)], 1u);
    return b;
}
__device__ __forceinline__ void xcd_barrier_complete(unsigned* bar, unsigned x, unsigned& nloc, unsigned& nx) {
    const unsigned G = gridDim.x * gridDim.y * gridDim.z;
    unsigned sum, cnt, mine, sp = 0u;
    for (;;) {
        sum = 0u; cnt = 0u; mine = 0u;
#pragma unroll
        for (unsigned j = 0; j < 16; ++j) { const unsigned c = xb_ld(&bar[XB_XCNT(j)]); sum += c; cnt += (c > 0u) ? 1u : 0u; mine = (j == x) ? c : mine; }
        if (sum == G) break;
        __builtin_amdgcn_s_sleep(1);
        if ((++sp & 255u) == 0u) { if (xb_ld(&bar[XB_TMO])) break; if (sp > XB_SPIN_CAP) { atomicAdd(&bar[XB_TMO], 1u); break; } }
    }
    nloc = mine > 0u ? mine : 1u; nx = cnt > 0u ? cnt : 1u;
}
__device__ __forceinline__ void xcd_barrier(const XcdBarrier& b) {
    asm volatile("s_waitcnt vmcnt(0)" ::: "memory");
    __syncthreads();
    if (threadIdx.x == 0) {
        unsigned* bar = b.bar;
        __builtin_amdgcn_s_waitcnt(0);
        unsigned nloc = b.st[0], nx = b.st[1];
        if (nloc == 0u) { xcd_barrier_complete(bar, b.x, nloc, nx); b.st[0] = nloc; b.st[1] = nx; }
        const unsigned old = xb_add(&bar[XB_XSUB(b.x)], 1u);
        const unsigned gen = old / nloc;
        if (old + 1u == (gen + 1u) * nloc) {
            __builtin_amdgcn_fence(__ATOMIC_RELEASE, "agent");
            asm volatile("s_waitcnt vmcnt(0)" ::: "memory");
            const unsigned og = xb_add(&bar[XB_TOP], 1u);
            const unsigned tg = og / nx;
            if (og + 1u == (tg + 1u) * nx) xb_add(&bar[XB_TOPGEN], 1u);
            else XB_SPIN(xb_ld(&bar[XB_TOPGEN]) == tg, bar);
            __builtin_amdgcn_fence(__ATOMIC_ACQUIRE, "agent");
            xb_add(&bar[XB_XGEN(b.x)], 1u);
            asm volatile("s_waitcnt vmcnt(0)" ::: "memory");
        } else {
            XB_SPIN(xb_ld(&bar[XB_XGEN(b.x)]) == gen, bar);
            __builtin_amdgcn_fence(__ATOMIC_ACQUIRE, "agent");
            asm volatile("s_waitcnt vmcnt(0)" ::: "memory");
        }
    }
    __syncthreads();
}

constexpr int NWAVES = 8;
constexpr int RING_BYTES = 131072, LDSCTL_OFF = RING_BYTES, LDS_BYTES = 147456;
struct Args { const float* in[23]; float* out; unsigned char* ws; };
struct Frame {
    LAS unsigned char* lds; int tid, lane, wave, vcu, G;
    const float* const* in; float* out; unsigned char* ws;
};
enum { I_X = 0, I_C, I_WADA, I_BADA, I_GPRE1, I_GPOST1, I_WIN, I_WPG, I_PSCALE, I_WPO, I_GQ, I_WQUP, I_GKV, I_WKVUP, I_WMO, I_WOUT, I_GPRE2, I_GPOST2, I_WQY, I_SK1, I_SK2, I_EU, I_EV };

__device__ __forceinline__ void tr_block(const float* src, int spitch, int ks, int ns, int perm, const float* gk, const float* gn, bf16* dst, int dpitch, int nd, int kd, LAS float* scr, int lane) {
    if (src) {
        const float gnv = gn ? gn[lane & 31] : 1.0f;
        float tv[32];
#pragma unroll
        for (int i = 0; i < 32; ++i) tv[i] = src[(size_t)(ks + 2 * i + (lane >> 5)) * spitch + ns + (lane & 31)];
#pragma unroll
        for (int i = 0; i < 32; ++i) { const int kk = 2 * i + (lane >> 5); float v = tv[i] * gnv; if (gk) v *= gk[ks + kk]; scr[kk * 33 + (lane & 31)] = v; }
    } else {
#pragma unroll 8
        for (int i = 0; i < 32; ++i) { const int kk = 2 * i + (lane >> 5); scr[kk * 33 + (lane & 31)] = 0.f; }
    }
    LDS_WAIT(); asm volatile("" ::: "memory");
    const int c = lane & 7;
#pragma unroll
    for (int j = 0; j < 4; ++j) { const int n = (lane >> 3) + 8 * j; const int pc = perm ? ((n >> 1) + 16 * (n & 1)) : n; const LAS float* s = scr + (8 * c) * 33 + pc;
        u32x4 o; o.x = cvtpk(s[0 * 33], s[1 * 33]); o.y = cvtpk(s[2 * 33], s[3 * 33]); o.z = cvtpk(s[4 * 33], s[5 * 33]); o.w = cvtpk(s[6 * 33], s[7 * 33]);
        *(u32x4*)(dst + (size_t)(nd + n) * dpitch + kd + 8 * c) = o; }
    LDS_WAIT(); asm volatile("" ::: "memory");
}

__device__ __forceinline__ void p0_prologue(Frame& F) {
    LAS float* scr = (LAS float*)(F.lds + F.wave * 16384);
    int lane_ = F.lane; asm volatile("" : "+v"(lane_));
    const int gw = F.vcu * NWAVES + F.wave, NGW = F.G * NWAVES, lane = lane_;
    unsigned char* ws = F.ws;
    {
        long long* mod = (long long*)((unsigned*)(ws + WS_CTL) + CW_MOD);
        const float* cc = F.in[I_C]; const float* wa = F.in[I_WADA]; const float* ba = F.in[I_BADA];
        for (int it = gw; it < 24 * 64; it += NGW) {
            const int cg = it % 24, kc = it / 24; const int col = cg * 256 + 4 * lane;
            f32x4 a0 = {0, 0, 0, 0}, a1 = a0, a2 = a0, a3 = a0;
            if (kc == 0) { a0 = *(const f32x4*)(ba + col); a1 = a0; a2 = a0; a3 = a0; }
#pragma unroll 4
            for (int k = kc * 16; k < kc * 16 + 16; ++k) {
                const f32x4 w = *(const f32x4*)(wa + (size_t)k * 6144 + col);
                const float c0 = cc[k], c1 = cc[1024 + k], c2 = cc[2048 + k], c3 = cc[3072 + k];
                a0 += w * (c0 * sigmoidf_(c0)); a1 += w * (c1 * sigmoidf_(c1)); a2 += w * (c2 * sigmoidf_(c2)); a3 += w * (c3 * sigmoidf_(c3));
            }
#pragma unroll
            for (int i = 0; i < 4; ++i) { fx_add(mod + col + i, a0[i], MOD_FX); fx_add(mod + 6144 + col + i, a1[i], MOD_FX); fx_add(mod + 2 * 6144 + col + i, a2[i], MOD_FX); fx_add(mod + 3 * 6144 + col + i, a3[i], MOD_FX); }
        }
    }
    {
        bf16* Win = (bf16*)(ws + WS_WIN); bf16* Wq = (bf16*)(ws + WS_WQ); bf16* Wk = (bf16*)(ws + WS_WK); bf16* Wv = (bf16*)(ws + WS_WV); bf16* Wg = (bf16*)(ws + WS_WG);
        bf16* Wpo = (bf16*)(ws + WS_WPO); bf16* Wmo = (bf16*)(ws + WS_WMO); bf16* Wout = (bf16*)(ws + WS_WOUT); bf16* Wqy = (bf16*)(ws + WS_WQY);
        constexpr int N1 = 96 * 16, N2 = 24 * 4, N3 = 16 * 4, N4 = 16 * 4, N5 = 16 * 8, N6 = 32 * 8, N7 = 32 * 8, N8 = 32 * 16, N9 = 64 * 16;
        constexpr int NITEMS = N1 + N2 + N3 + N4 + N5 + N6 + N7 + N8 + N9;
        for (int it = gw; it < NITEMS; it += NGW) {
            int r = it;
            if (r < N1) { const int nb = r % 96, kb = r / 96; const float* s = F.in[I_WIN]; int ns = 32 * nb, pm = 0;
                if (nb == 28) pm = 1; else if (nb >= 29 && nb < 32) s = nullptr; else if (nb >= 32) ns = 928 + 32 * (nb - 32);
                tr_block(s, 2976, 64 * kb, ns, pm, nullptr, nullptr, Win, 1024, 32 * nb, 64 * kb, scr, lane); continue; } r -= N1;
            if (r < N2) { const int nb = r % 24, kb = r / 24; const int h = nb / 3, q = nb % 3;
                tr_block(F.in[I_WQUP], 768, 64 * kb, 96 * h + 32 * q, q == 2, F.in[I_GQ], nullptr, Wq, 256, 32 * nb, 64 * kb, scr, lane); continue; } r -= N2;
            if (r < N3) { const int nb = r % 16, kb = r / 16; const int h = nb / 2, q = nb % 2;
                tr_block(kb < 2 ? F.in[I_WKVUP] : nullptr, 1024, 64 * kb, 128 * h + 32 * q, 0, F.in[I_GKV], nullptr, Wk, 256, 32 * nb, 64 * kb, scr, lane); continue; } r -= N3;
            if (r < N4) { const int nb = r % 16, kb = r / 16; const int h = nb / 2, q = nb % 2;
                tr_block(kb < 2 ? F.in[I_WKVUP] : nullptr, 1024, 64 * kb, 128 * h + 64 + 32 * q, 0, F.in[I_GKV], nullptr, Wv, 256, 32 * nb, 64 * kb, scr, lane); continue; } r -= N4;
            if (r < N5) { const int nb = r % 16, kb = r / 16; const int g = nb / 4; const bool dg = (kb / 2) == g;
                tr_block(dg ? F.in[I_WPG] + (size_t)g * 128 * 128 : nullptr, 128, 64 * (kb % 2), 32 * (nb % 4), 0, nullptr, F.in[I_PSCALE] + g * 128 + 32 * (nb % 4), Wg, 512, 32 * nb, 64 * kb, scr, lane); continue; } r -= N5;
            if (r < N6) { const int nb = r % 32, kb = r / 32; tr_block(F.in[I_WPO], 1024, 64 * kb, 32 * nb, 0, nullptr, nullptr, Wpo, 512, 32 * nb, 64 * kb, scr, lane); continue; } r -= N6;
            if (r < N7) { const int nb = r % 32, kb = r / 32; tr_block(F.in[I_WMO], 1024, 64 * kb, 32 * nb, 0, nullptr, nullptr, Wmo, 512, 32 * nb, 64 * kb, scr, lane); continue; } r -= N7;
            if (r < N8) { const int nb = r % 32, kb = r / 32; tr_block(F.in[I_WOUT], 1024, 64 * kb, 32 * nb, 0, nullptr, nullptr, Wout, 1024, 32 * nb, 64 * kb, scr, lane); continue; } r -= N8;
            { const int nb = r % 64, kb = r / 64; tr_block(F.in[I_WQY], 2048, 64 * kb, 32 * nb, 0, nullptr, nullptr, Wqy, 1024, 32 * nb, 64 * kb, scr, lane); }
        }
    }
    {
        bf16* sk = (bf16*)(ws + WS_SK);
        const int gt = (F.vcu * NWAVES * 64) + F.wave * 64 + lane, NGT = F.G * NWAVES * 64;
        for (int i = gt; i < 2 * 131072 / 8; i += NGT) { const int side = i / 16384, o = (i % 16384) * 8; const float* s = F.in[side ? I_SK2 : I_SK1] + o;
            *(u32x4*)(sk + (size_t)side * 131072 + o) = pack8(*(const f32x4*)s, *(const f32x4*)(s + 4)); }
        float* rope = (float*)(ws + WS_ROPE);
        for (int i = gt; i < SEQ * 16; i += NGT) { const int pos = i >> 4, e = i & 15;
            const float frac[4] = {1.0f, 0.5623413251903491f, 0.31622776601683794f, 0.17782794100389228f};
            const float dec[4] = {1.0f, 0.1f, 0.01f, 0.001f};
            const float inv = (float)((double)dec[e >> 2] * (double)frac[e & 3]);
            const float ang = (float)pos * inv;
            const double rev = (double)ang * 0.15915494309189535;
            const float fr = (float)(rev - floor(rev));
            rope[pos * 32 + e] = __builtin_amdgcn_cosf(fr); rope[pos * 32 + 16 + e] = __builtin_amdgcn_sinf(fr); }
    }
}

__device__ __forceinline__ void p1_xn(Frame& F) {
    int lane_ = F.lane; asm volatile("" : "+v"(lane_));
    const int gw = F.vcu * NWAVES + F.wave, NGW = F.G * NWAVES, lane = lane_;
    const long long* mod = (const long long*)((const unsigned*)(F.ws + WS_CTL) + CW_MOD); const float* g = F.in[I_GPRE1]; bf16* xn = (bf16*)(F.ws + WS_R1);
    { float* modf = (float*)(F.ws + WS_CTL) + CW_MODF; for (int i = gw * 64 + lane; i < 4 * 6144; i += NGW * 64) modf[i] = fx_get(mod + i, 1.0 / MOD_FX); }
    for (int row0 = gw; row0 < T; row0 += 2 * NGW) {
        f32x4 v[2][4]; float s[2] = {0.f, 0.f};
#pragma unroll
        for (int q = 0; q < 2; ++q) { const f32x4* xr = (const f32x4*)(F.in[I_X] + (size_t)(row0 + q * NGW) * D) + lane;
#pragma unroll
            for (int j = 0; j < 4; ++j) v[q][j] = xr[64 * j]; }
#pragma unroll
        for (int q = 0; q < 2; ++q)
#pragma unroll
            for (int j = 0; j < 4; ++j) s[q] += (v[q][j].x * v[q][j].x + v[q][j].y * v[q][j].y) + (v[q][j].z * v[q][j].z + v[q][j].w * v[q][j].w);
#pragma unroll
        for (int q = 0; q < 2; ++q) { const int row = row0 + q * NGW; const long long* mb = mod + (row / SEQ) * 6144;
            const float rstd = rsqrtf(wave_sum(s[q]) * (1.f / D) + RMS_EPS);
#pragma unroll
            for (int j = 0; j < 4; ++j) { const int col = 4 * lane + 256 * j;
                const f32x4 gg = *(const f32x4*)(g + col); f32x4 sh, sc;
#pragma unroll
                for (int i = 0; i < 4; ++i) { sh[i] = fx_get(mb + col + i, 1.0 / MOD_FX); sc[i] = fx_get(mb + 1024 + col + i, 1.0 / MOD_FX); }
                const f32x4 o = v[q][j] * rstd * gg * (sc + 1.0f) + sh;
                u32x2 w; w.x = cvtpk(o.x, o.y); w.y = cvtpk(o.z, o.w); *(u32x2*)(xn + (size_t)row * D + col) = w; } }
    }
}
template <int W> __device__ __forceinline__ void pool_item(const bf16* P, bf16* PI, int t0, int ch) {
    const int s0 = t0 & (SEQ - 1);
    u32x4 raw[W + 7];
#pragma unroll
    for (int i = 0; i < W + 7; ++i) { const int dt = i - (W - 1); raw[i] = (s0 + dt >= 0) ? *(const u32x4*)(P + (size_t)(t0 + dt) * PROJ_N + ch) : (u32x4){0u, 0u, 0u, 0u}; }
    f32x4 a0 = {0, 0, 0, 0}, a1 = a0;
#pragma unroll
    for (int i = 0; i < W - 1; ++i) { f32x4 y0, y1; unpack8(raw[i], y0, y1); a0 += y0; a1 += y1; }
#pragma unroll
    for (int k = 0; k < 8; ++k) {
        f32x4 x0, x1; unpack8(raw[W - 1 + k], x0, x1); a0 += x0; a1 += x1;
        const int s = s0 + k; const float ic = 1.0f / (float)((s + 1 < W) ? s + 1 : W);
        *(u32x4*)(PI + (size_t)(t0 + k) * 512 + ch) = pack8(a0 * ic - x0, a1 * ic - x1);
        f32x4 o0, o1; unpack8(raw[k], o0, o1); a0 -= o0; a1 -= o1;
    }
}
__device__ __forceinline__ void p3_pool(Frame& F) {
    const bf16* P = (const bf16*)(F.ws + WS_R2); bf16* PI = (bf16*)(F.ws + WS_PIN);
    int tid_ = F.tid; asm volatile("" : "+v"(tid_));
    const int gt = (F.vcu * NWAVES * 64) + tid_, NGT = F.G * NWAVES * 64;
    for (int i = gt; i < (T / 8) * 64; i += NGT) {
        const int cg = i & 63, t0 = (i >> 6) * 8, ch = cg * 8, g = cg >> 4;
        if (g == 0) pool_item<2>(P, PI, t0, ch); else if (g == 1) pool_item<4>(P, PI, t0, ch); else if (g == 2) pool_item<8>(P, PI, t0, ch); else pool_item<16>(P, PI, t0, ch);
    }
}
__device__ __forceinline__ void p7_rows(Frame& F) {
    int lane_ = F.lane; asm volatile("" : "+v"(lane_));
    const int gw = F.vcu * NWAVES + F.wave, NGW = F.G * NWAVES, lane = lane_;
    const float* mod = (const float*)(F.ws + WS_CTL) + CW_MODF; const bf16* Z = (const bf16*)(F.ws + WS_R2); bf16* xn = (bf16*)(F.ws + WS_R1);
    const float* gp1 = F.in[I_GPOST1]; const float* gp2 = F.in[I_GPRE2];
    for (int row0 = gw; row0 < T; row0 += 2 * NGW) {
        f32x4 z[2][4], h[2][4], xv[2][4]; float s[2] = {0.f, 0.f}, s2[2] = {0.f, 0.f};
#pragma unroll
        for (int q = 0; q < 2; ++q) { const int row = row0 + q * NGW;
#pragma unroll
            for (int j = 0; j < 4; ++j) { const u32x2 w = *(const u32x2*)(Z + (size_t)row * D + 4 * lane + 256 * j); z[q][j] = (f32x4){bflo(w.x), bfhi(w.x), bflo(w.y), bfhi(w.y)};
                xv[q][j] = *(const f32x4*)(F.in[I_X] + (size_t)row * D + 4 * lane + 256 * j); } }
#pragma unroll
        for (int q = 0; q < 2; ++q)
#pragma unroll
            for (int j = 0; j < 4; ++j) s[q] += (z[q][j].x * z[q][j].x + z[q][j].y * z[q][j].y) + (z[q][j].z * z[q][j].z + z[q][j].w * z[q][j].w);
#pragma unroll
        for (int q = 0; q < 2; ++q) { const int row = row0 + q * NGW; const float* mb = mod + (row / SEQ) * 6144;
            const float rz = rsqrtf(wave_sum(s[q]) * (1.f / D) + RMS_EPS);
#pragma unroll
            for (int j = 0; j < 4; ++j) { const int col = 4 * lane + 256 * j;
                const f32x4 g1 = *(const f32x4*)(mb + 2048 + col), gg = *(const f32x4*)(gp1 + col);
                h[q][j] = xv[q][j] + g1 * (z[q][j] * rz * gg); *(f32x4*)(F.out + (size_t)row * D + col) = h[q][j];
                s2[q] += (h[q][j].x * h[q][j].x + h[q][j].y * h[q][j].y) + (h[q][j].z * h[q][j].z + h[q][j].w * h[q][j].w); } }
#pragma unroll
        for (int q = 0; q < 2; ++q) { const int row = row0 + q * NGW; const float* mb = mod + (row / SEQ) * 6144;
            const float rh = rsqrtf(wave_sum(s2[q]) * (1.f / D) + RMS_EPS);
#pragma unroll
            for (int j = 0; j < 4; ++j) { const int col = 4 * lane + 256 * j;
                const f32x4 gg = *(const f32x4*)(gp2 + col), sh = *(const f32x4*)(mb + 3072 + col), sc = *(const f32x4*)(mb + 4096 + col);
                const f32x4 o = h[q][j] * rh * gg * (sc + 1.0f) + sh;
                u32x2 w; w.x = cvtpk(o.x, o.y); w.y = cvtpk(o.z, o.w); *(u32x2*)(xn + (size_t)row * D + col) = w; } }
    }
}

constexpr int ATT_KP = 208, ATT_VP = 144, ATT_KB = 64 * ATT_KP, ATT_VB = 64 * ATT_VP;
__device__ __forceinline__ void attn_unit(int b, int h, int qb, const bf16* Qb, const bf16* Kb, const bf16* Vt, bf16* O, LAS unsigned char* lds) {
    int tid_ = threadIdx.x; asm volatile("" : "+v"(tid_));
    const int tid = tid_, lane = tid & 63, r32 = lane & 31, hi = lane >> 5; const int wid = __builtin_amdgcn_readfirstlane(tid >> 6);
    const int q0 = qb * 256, tok0 = b * SEQ, NT = (q0 + 256) / 64;
    const int kr0 = tid / 12, kc0 = tid % 12, kr1 = (tid + 512) / 12, kc1 = (tid + 512) % 12;
    const bf16* kg0 = Kb + (size_t)(tok0 + kr0) * 768 + h * QKD + kc0 * 8;
    const bf16* kg1 = Kb + (size_t)(tok0 + kr1) * 768 + h * QKD + kc1 * 8;
    const int kl0 = kr0 * ATT_KP + kc0 * 16, kl1 = kr1 * ATT_KP + kc1 * 16;
    const int vd = tid >> 3, vc = tid & 7;
    const bf16* vg = Vt + (size_t)(h * VD + vd) * T + tok0 + vc * 8;
    const int vl = 2 * ATT_KB + vd * ATT_VP + vc * 16;
    const bool k2 = tid < 256;
    const int qrow = tok0 + q0 + wid * 32 + r32; const int qpos = q0 + wid * 32 + r32;
    bf16x8 qf[6];
#pragma unroll
    for (int s = 0; s < 6; ++s) qf[s] = *(const bf16x8*)(Qb + (size_t)qrow * 768 + h * QKD + 16 * s + 8 * hi);
    const int krow = (r32 & ~12) | ((r32 & 4) << 1) | ((r32 & 8) >> 1);
    const int ka = krow * ATT_KP + hi * 16, va = 2 * ATT_KB + r32 * ATT_VP + hi * 16;
    f32x16 o0 = {}, o1 = {}; float mrun = -INFINITY, lrun = 0.f;
    u32x4 kx0, kx1, vx;
    kx0 = *(const u32x4*)kg0; kx1 = k2 ? *(const u32x4*)kg1 : (u32x4){0, 0, 0, 0}; vx = *(const u32x4*)vg;
    *(LAS u32x4*)(lds + kl0) = kx0; if (k2) *(LAS u32x4*)(lds + kl1) = kx1; *(LAS u32x4*)(lds + vl) = vx;
    __syncthreads();
    for (int t = 0; t < NT; ++t) {
        const int cb = t & 1, nb = cb ^ 1;
        const bool more = t + 1 < NT;
        if (more) { kx0 = *(const u32x4*)(kg0 + (size_t)(t + 1) * 64 * 768); if (k2) kx1 = *(const u32x4*)(kg1 + (size_t)(t + 1) * 64 * 768); vx = *(const u32x4*)(vg + (t + 1) * 64); }
        const int kv0 = t * 64;
        if (kv0 <= q0 + wid * 32 + 31) {
            f32x16 p0 = {}, p1 = {};
            const LAS unsigned char* kb = lds + cb * ATT_KB + ka;
#pragma unroll
            for (int s = 0; s < 6; ++s) {
                const bf16x8 a0 = *(const LAS bf16x8*)(kb + s * 32), a1 = *(const LAS bf16x8*)(kb + 32 * ATT_KP + s * 32);
                p0 = __builtin_amdgcn_mfma_f32_32x32x16_bf16(a0, qf[s], p0, 0, 0, 0);
                p1 = __builtin_amdgcn_mfma_f32_32x32x16_bf16(a1, qf[s], p1, 0, 0, 0);
            }
            if (kv0 + 63 > q0 + wid * 32) {
#pragma unroll
                for (int r = 0; r < 16; ++r) { const int kv = kv0 + (r & 7) + 8 * hi + 16 * (r >> 3); if (kv > qpos) p0[r] = -INFINITY; if (kv + 32 > qpos) p1[r] = -INFINITY; }
            }
            float mx = fmaxf(p0[0], p1[0]);
#pragma unroll
            for (int r = 1; r < 16; ++r) mx = fmaxf(mx, fmaxf(p0[r], p1[r]));
            mx = fmaxf(mx, __shfl_xor(mx, 32));
            const float mnew = fmaxf(mrun, mx); const float alpha = __builtin_amdgcn_exp2f(mrun - mnew); mrun = mnew;
            float ls = 0.f;
#pragma unroll
            for (int r = 0; r < 16; ++r) { p0[r] = __builtin_amdgcn_exp2f(p0[r] - mnew); p1[r] = __builtin_amdgcn_exp2f(p1[r] - mnew); ls += p0[r] + p1[r]; }
            lrun = lrun * alpha + ls;
#pragma unroll
            for (int r = 0; r < 16; ++r) { o0[r] *= alpha; o1[r] *= alpha; }
            u32x4 pb[4];
            pb[0] = (u32x4){cvtpk(p0[0], p0[1]), cvtpk(p0[2], p0[3]), cvtpk(p0[4], p0[5]), cvtpk(p0[6], p0[7])};
            pb[1] = (u32x4){cvtpk(p0[8], p0[9]), cvtpk(p0[10], p0[11]), cvtpk(p0[12], p0[13]), cvtpk(p0[14], p0[15])};
            pb[2] = (u32x4){cvtpk(p1[0], p1[1]), cvtpk(p1[2], p1[3]), cvtpk(p1[4], p1[5]), cvtpk(p1[6], p1[7])};
            pb[3] = (u32x4){cvtpk(p1[8], p1[9]), cvtpk(p1[10], p1[11]), cvtpk(p1[12], p1[13]), cvtpk(p1[14], p1[15])};
            const LAS unsigned char* vb = lds + cb * ATT_VB + va;
#pragma unroll
            for (int ks = 0; ks < 4; ++ks) {
                const bf16x8 a0 = *(const LAS bf16x8*)(vb + ks * 32), a1 = *(const LAS bf16x8*)(vb + 32 * ATT_VP + ks * 32);
                const bf16x8 pbv = __builtin_bit_cast(bf16x8, pb[ks]);
                o0 = __builtin_amdgcn_mfma_f32_32x32x16_bf16(a0, pbv, o0, 0, 0, 0);
                o1 = __builtin_amdgcn_mfma_f32_32x32x16_bf16(a1, pbv, o1, 0, 0, 0);
            }
        }
        if (more) { *(LAS u32x4*)(lds + nb * ATT_KB + kl0) = kx0; if (k2) *(LAS u32x4*)(lds + nb * ATT_KB + kl1) = kx1; *(LAS u32x4*)(lds + nb * ATT_VB + vl) = vx; }
        __syncthreads();
    }
    const float lt = lrun + __shfl_xor(lrun, 32); const float il = 1.0f / lt;
    bf16* op = O + (size_t)qrow * 512 + h * VD;
#pragma unroll
    for (int rg = 0; rg < 4; ++rg) {
        u32x2 w0, w1; w0.x = cvtpk(o0[4 * rg] * il, o0[4 * rg + 1] * il); w0.y = cvtpk(o0[4 * rg + 2] * il, o0[4 * rg + 3] * il);
        w1.x = cvtpk(o1[4 * rg] * il, o1[4 * rg + 1] * il); w1.y = cvtpk(o1[4 * rg + 2] * il, o1[4 * rg + 3] * il);
        *(u32x2*)(op + 8 * rg + 4 * hi) = w0; *(u32x2*)(op + 32 + 8 * rg + 4 * hi) = w1;
    }
}
__device__ __forceinline__ void p4_attention(Frame& F) {
    const bf16* Qb = (const bf16*)(F.ws + WS_R1); const bf16* Kb = (const bf16*)(F.ws + WS_KB); const bf16* Vt = (const bf16*)(F.ws + WS_VT); bf16* O = (bf16*)(F.ws + WS_AO);
    for (int p = F.vcu; p < 256; p += F.G) {
        const int bh = p >> 3, s = p & 7;
        attn_unit(bh >> 3, bh & 7, 15 - s, Qb, Kb, Vt, O, F.lds);
        attn_unit(bh >> 3, bh & 7, s, Qb, Kb, Vt, O, F.lds);
    }
}

__device__ __forceinline__ int mono(float x) { const int b = __float_as_int(x); return b ^ ((b >> 31) & 0x7fffffff); }
__device__ __forceinline__ float unmono(int k) { return __int_as_float(k ^ ((k >> 31) & 0x7fffffff)); }
#define TK_INS(L, xx) do { int _x = (xx); _Pragma("unroll") for (int _i = 0; _i < 16; ++_i) { const int _t = max(L[_i], _x); _x = min(L[_i], _x); L[_i] = _t; } } while (0)
__device__ __forceinline__ void sort16_desc(int (&v)[16]) {
#pragma unroll
    for (int k = 2; k <= 16; k <<= 1)
#pragma unroll
        for (int j = k >> 1; j > 0; j >>= 1)
#pragma unroll
            for (int i = 0; i < 16; ++i) { const int l = i ^ j; if (l > i) { const int hi_ = max(v[i], v[l]), lo_ = min(v[i], v[l]); const bool desc = (i & k) == 0; v[i] = desc ? hi_ : lo_; v[l] = desc ? lo_ : hi_; } }
}
__device__ __forceinline__ void merge16_desc(int (&top)[16], const int (&b)[16]) {
#pragma unroll
    for (int i = 0; i < 16; ++i) top[i] = max(top[i], b[15 - i]);
#pragma unroll
    for (int j = 8; j > 0; j >>= 1)
#pragma unroll
        for (int i = 0; i < 16; ++i) { const int l = i ^ j; if (l > i) { const int hi_ = max(top[i], top[l]), lo_ = min(top[i], top[l]); top[i] = hi_; top[l] = lo_; } }
}
__device__ __forceinline__ void peer_side(const bf16* qp, const bf16* sk, int r32, int hi, int (&L)[16]) {
    bf16x8 qf[8];
#pragma unroll
    for (int s = 0; s < 8; ++s) qf[s] = *(const bf16x8*)(qp + 16 * s + 8 * hi);
#pragma unroll
    for (int kt = 0; kt < 4; ++kt) {
        f32x16 acc = {};
#pragma unroll
        for (int s = 0; s < 8; ++s) { const bf16x8 a = *(const bf16x8*)(sk + (size_t)(32 * kt + r32) * 128 + 16 * s + 8 * hi); acc = __builtin_amdgcn_mfma_f32_32x32x16_bf16(a, qf[s], acc, 0, 0, 0); }
        int tv[16];
#pragma unroll
        for (int r = 0; r < 16; ++r) { const int key = 32 * kt + (r & 3) + 8 * (r >> 2); tv[r] = (mono(acc[r]) & ~127) | (127 - key); }
        sort16_desc(tv);
        if (kt == 0) {
#pragma unroll
            for (int i = 0; i < 16; ++i) L[i] = tv[i];
        } else merge16_desc(L, tv);
        asm volatile("" ::: "memory");
    }
    int Oth[16];
#pragma unroll
    for (int i = 0; i < 16; ++i) { L[i] ^= (hi << 2); Oth[i] = __shfl_xor(L[i], 32); }
    merge16_desc(L, Oth);
}
__device__ __forceinline__ void p9_peer_topk(Frame& F) {
    const bf16* QP = (const bf16*)(F.ws + WS_R2); const bf16* SK = (const bf16*)(F.ws + WS_SK);
    int* eidx = (int*)(F.ws + WS_EIDX); float* gate = (float*)(F.ws + WS_GATE);
    int lane_ = F.lane; asm volatile("" : "+v"(lane_));
    const int gw = F.vcu * NWAVES + F.wave, NGW = F.G * NWAVES, lane = lane_, r32 = lane & 31, hi = lane >> 5;
    LAS int* tab = (LAS int*)(F.lds + F.wave * 8192);
    for (int it = gw; it < (T / 32) * PEER_H; it += NGW) {
        const int h = it & 7, tb = it >> 3; const int tok = tb * 32 + r32;
        int L1[16], L2[16], L3[16];
        peer_side(QP + (size_t)tok * 2048 + h * 256, SK + (size_t)h * 16384, r32, hi, L1);
        peer_side(QP + (size_t)tok * 2048 + h * 256 + 128, SK + 131072 + (size_t)h * 16384, r32, hi, L2);
        float v1[16], v2[16];
#pragma unroll
        for (int i = 0; i < 16; ++i) { v1[i] = unmono(L1[i] & ~127); v2[i] = unmono(L2[i] & ~127); tab[i * 64 + lane] = 127 - (L1[i] & 127); tab[(16 + i) * 64 + lane] = 127 - (L2[i] & 127); L3[i] = (int)0x80000000; }
#define CAND(a, b) ((mono(v1[a] + v2[b]) & ~255) | (255 - ((a) * 16 + (b))))
        {
#pragma unroll
            for (int b = 0; b < 16; ++b) L3[b] = CAND(0, b);
            int gB[16] = {CAND(1, 0), CAND(1, 1), CAND(1, 2), CAND(1, 3), CAND(1, 4), CAND(1, 5), CAND(1, 6), CAND(1, 7), CAND(2, 0), CAND(2, 1), CAND(2, 2), CAND(2, 3), CAND(2, 4), CAND(4, 0), CAND(4, 1), CAND(4, 2)};
            sort16_desc(gB); merge16_desc(L3, gB);
            int gC[16] = {CAND(3, 0), CAND(3, 1), CAND(3, 2), CAND(3, 3), CAND(5, 0), CAND(5, 1), CAND(6, 0), CAND(6, 1), CAND(7, 0), CAND(7, 1), CAND(8, 0), CAND(9, 0), CAND(10, 0), CAND(11, 0), CAND(12, 0), CAND(13, 0)};
            sort16_desc(gC); merge16_desc(L3, gC);
            TK_INS(L3, CAND(14, 0)); TK_INS(L3, CAND(15, 0));
        }
#undef CAND
        float sc[16], ssum = 0.f; int ei[16];
#pragma unroll
        for (int k = 0; k < 16; ++k) { const int ci = 255 - (L3[k] & 255); sc[k] = unmono(L3[k] & ~255);
            ei[k] = tab[(ci >> 4) * 64 + lane] * 128 + tab[(16 + (ci & 15)) * 64 + lane]; }
        const float smax = sc[0];
#pragma unroll
        for (int k = 0; k < 16; ++k) { sc[k] = __builtin_amdgcn_exp2f((sc[k] - smax) * 1.4426950408889634f); ssum += sc[k]; }
        const float inv = 1.0f / ssum;
        const size_t ob = ((size_t)tok * PEER_H + h) * PEER_K;
        if (hi == 0) {
#pragma unroll
            for (int k = 0; k < 16; k += 4) *(u32x4*)(eidx + ob + k) = (u32x4){(unsigned)ei[k], (unsigned)ei[k + 1], (unsigned)ei[k + 2], (unsigned)ei[k + 3]};
        } else {
#pragma unroll
            for (int k = 0; k < 16; k += 4) *(f32x4*)(gate + ob + k) = (f32x4){sc[k] * inv, sc[k + 1] * inv, sc[k + 2] * inv, sc[k + 3] * inv};
        }
        LDS_WAIT();
    }
}
constexpr float EU_SCALE = 32.0f, EV_SCALE = 8.0f;
__device__ __forceinline__ unsigned pk4_fp8(f32x4 v, float sc) { int r = __builtin_amdgcn_cvt_pk_fp8_f32(v[0] * sc, v[1] * sc, 0, false); r = __builtin_amdgcn_cvt_pk_fp8_f32(v[2] * sc, v[3] * sc, r, true); return (unsigned)r; }
__device__ __forceinline__ void cvt_experts(Frame& F) {
    int tid_ = F.tid; asm volatile("" : "+v"(tid_));
    const int gt = (F.vcu * NWAVES * 64) + tid_, NGT = F.G * NWAVES * 64;
    const float* su = F.in[I_EU]; const float* sv = F.in[I_EV]; unsigned char* du = F.ws + WS_EU; unsigned char* dv = F.ws + WS_EV;
    for (int i = gt; i < 16384 * 1024 / 16; i += NGT) { const size_t o = (size_t)i * 16;
        u32x4 a, b;
        a.x = pk4_fp8(*(const f32x4*)(su + o), EU_SCALE); a.y = pk4_fp8(*(const f32x4*)(su + o + 4), EU_SCALE); a.z = pk4_fp8(*(const f32x4*)(su + o + 8), EU_SCALE); a.w = pk4_fp8(*(const f32x4*)(su + o + 12), EU_SCALE);
        b.x = pk4_fp8(*(const f32x4*)(sv + o), EV_SCALE); b.y = pk4_fp8(*(const f32x4*)(sv + o + 4), EV_SCALE); b.z = pk4_fp8(*(const f32x4*)(sv + o + 8), EV_SCALE); b.w = pk4_fp8(*(const f32x4*)(sv + o + 12), EV_SCALE);
        *(u32x4*)(du + o) = a; *(u32x4*)(dv + o) = b; }
}

#define FMAC_V(acc, a, b) asm("v_fmac_f32_e32 %0, %1, %2" : "+v"(acc) : "v"(a), "v"(b))
#define FMAC_S(acc, ws, b) asm("v_fmac_f32_e32 %0, %1, %2" : "+v"(acc) : "s"(ws), "v"(b))
__device__ __forceinline__ float dot16_fp8(u32x4 r, const float (&x)[16]) {
    float a = 0.f, b = 0.f; f32x2 t;
    t = __builtin_amdgcn_cvt_pk_f32_fp8((int)r.x, false); FMAC_V(a, t.x, x[0]);  FMAC_V(b, t.y, x[1]);
    t = __builtin_amdgcn_cvt_pk_f32_fp8((int)r.x, true);  FMAC_V(a, t.x, x[2]);  FMAC_V(b, t.y, x[3]);
    t = __builtin_amdgcn_cvt_pk_f32_fp8((int)r.y, false); FMAC_V(a, t.x, x[4]);  FMAC_V(b, t.y, x[5]);
    t = __builtin_amdgcn_cvt_pk_f32_fp8((int)r.y, true);  FMAC_V(a, t.x, x[6]);  FMAC_V(b, t.y, x[7]);
    t = __builtin_amdgcn_cvt_pk_f32_fp8((int)r.z, false); FMAC_V(a, t.x, x[8]);  FMAC_V(b, t.y, x[9]);
    t = __builtin_amdgcn_cvt_pk_f32_fp8((int)r.z, true);  FMAC_V(a, t.x, x[10]); FMAC_V(b, t.y, x[11]);
    t = __builtin_amdgcn_cvt_pk_f32_fp8((int)r.w, false); FMAC_V(a, t.x, x[12]); FMAC_V(b, t.y, x[13]);
    t = __builtin_amdgcn_cvt_pk_f32_fp8((int)r.w, true);  FMAC_V(a, t.x, x[14]); FMAC_V(b, t.y, x[15]);
    return a + b;
}
__device__ __forceinline__ void axpy16_fp8(float (&y)[16], float w, u32x4 r) {
    f32x2 t;
    t = __builtin_amdgcn_cvt_pk_f32_fp8((int)r.x, false); FMAC_S(y[0], w, t.x);  FMAC_S(y[1], w, t.y);
    t = __builtin_amdgcn_cvt_pk_f32_fp8((int)r.x, true);  FMAC_S(y[2], w, t.x);  FMAC_S(y[3], w, t.y);
    t = __builtin_amdgcn_cvt_pk_f32_fp8((int)r.y, false); FMAC_S(y[4], w, t.x);  FMAC_S(y[5], w, t.y);
    t = __builtin_amdgcn_cvt_pk_f32_fp8((int)r.y, true);  FMAC_S(y[6], w, t.x);  FMAC_S(y[7], w, t.y);
    t = __builtin_amdgcn_cvt_pk_f32_fp8((int)r.z, false); FMAC_S(y[8], w, t.x);  FMAC_S(y[9], w, t.y);
    t = __builtin_amdgcn_cvt_pk_f32_fp8((int)r.z, true);  FMAC_S(y[10], w, t.x); FMAC_S(y[11], w, t.y);
    t = __builtin_amdgcn_cvt_pk_f32_fp8((int)r.w, false); FMAC_S(y[12], w, t.x); FMAC_S(y[13], w, t.y);
    t = __builtin_amdgcn_cvt_pk_f32_fp8((int)r.w, true);  FMAC_S(y[14], w, t.x); FMAC_S(y[15], w, t.y);
}
__device__ __forceinline__ void sort128(int& k0, int& k1, int lane) {
#pragma unroll
    for (int k = 2; k <= 128; k <<= 1) {
#pragma unroll
        for (int j = k >> 1; j > 0; j >>= 1) {
            if (j == 64) { const int lo = min(k0, k1), hi = max(k0, k1); k0 = lo; k1 = hi; }
            else {
                const bool lower = (lane & j) == 0;
                const int p0 = __shfl_xor(k0, j), p1 = __shfl_xor(k1, j);
                const bool up0 = (k == 128) ? true : (k == 64) ? true : ((lane & k) == 0);
                const bool up1 = (k == 128) ? true : (k == 64) ? false : ((lane & k) == 0);
                k0 = (lower == up0) ? min(k0, p0) : max(k0, p0);
                k1 = (lower == up1) ? min(k1, p1) : max(k1, p1);
            }
        }
    }
}
typedef int i32x4 __attribute__((ext_vector_type(4)));
__device__ __forceinline__ u32x4 row_load(__amdgpu_buffer_rsrc_t rsrc, int lane16, int e) { return __builtin_bit_cast(u32x4, __builtin_amdgcn_raw_buffer_load_b128(rsrc, lane16, e << 10, 0)); }
template <bool DRY> __device__ __forceinline__ void p10_peer_experts(Frame& F) {
    int lane_ = F.lane; asm volatile("" : "+v"(lane_));
    const int gw = F.vcu * NWAVES + F.wave, NGW = F.G * NWAVES, lane = lane_, lane16 = lane * 16;
    const bf16* XN = (const bf16*)(F.ws + WS_R1);
    const __amdgpu_buffer_rsrc_t ru = __builtin_amdgcn_make_buffer_rsrc((void*)(F.ws + WS_EU), 0, 16384 * 1024, 0x00020000), rv = __builtin_amdgcn_make_buffer_rsrc((void*)(F.ws + WS_EV), 0, 16384 * 1024, 0x00020000);
    const int* eidx = (const int*)(F.ws + WS_EIDX); const float* gate = (const float*)(F.ws + WS_GATE);
    const float* mod = (const float*)(F.ws + WS_CTL) + CW_MODF; const float* gp = F.in[I_GPOST2];
    const int b5 = (lane >> 5) & 1, b4 = (lane >> 4) & 1, b3 = (lane >> 3) & 1, b2 = (lane >> 2) & 1;
    const int eloc = b5 * 8 + b4 * 4 + b3 * 2 + b2;
    for (int tok = gw; tok < T; tok += NGW) {
        float x[16];
        { const u32x4 xa = *(const u32x4*)(XN + (size_t)tok * D + 16 * lane), xb = *(const u32x4*)(XN + (size_t)tok * D + 16 * lane + 8);
          x[0] = bflo(xa.x); x[1] = bfhi(xa.x); x[2] = bflo(xa.y); x[3] = bfhi(xa.y); x[4] = bflo(xa.z); x[5] = bfhi(xa.z); x[6] = bflo(xa.w); x[7] = bfhi(xa.w);
          x[8] = bflo(xb.x); x[9] = bfhi(xb.x); x[10] = bflo(xb.y); x[11] = bfhi(xb.y); x[12] = bflo(xb.z); x[13] = bfhi(xb.z); x[14] = bflo(xb.w); x[15] = bfhi(xb.w); }
        int k0 = (eidx[(size_t)tok * 128 + lane] << 7) | lane, k1 = (eidx[(size_t)tok * 128 + 64 + lane] << 7) | (64 + lane);
        sort128(k0, k1, lane);
        float y[16];
#pragma unroll
        for (int i = 0; i < 16; ++i) y[i] = 0.f;
        u32x4 U[16], V[16];
#pragma unroll
        for (int j = 0; j < 16; ++j) U[j] = row_load(ru, lane16, __builtin_amdgcn_readlane(k0, j) >> 7);
        for (int kb = 0; kb < 8; ++kb) {
            const int kv = kb < 4 ? k0 : k1; const int lb = (kb & 3) * 16;
#pragma unroll
            for (int j = 0; j < 16; ++j) V[j] = row_load(rv, lane16, __builtin_amdgcn_readlane(kv, lb + j) >> 7);
            __builtin_amdgcn_sched_barrier(0);
            float p[16];
#pragma unroll
            for (int j = 0; j < 16; ++j) p[j] = dot16_fp8(U[j], x);
            float q[8], r4[4], s2[2], tt;
#pragma unroll
            for (int j = 0; j < 8; ++j) { const float keep = b5 ? p[j + 8] : p[j], send = b5 ? p[j] : p[j + 8]; q[j] = keep + __shfl_xor(send, 32); }
#pragma unroll
            for (int j = 0; j < 4; ++j) { const float keep = b4 ? q[j + 4] : q[j], send = b4 ? q[j] : q[j + 4]; r4[j] = keep + __shfl_xor(send, 16); }
#pragma unroll
            for (int j = 0; j < 2; ++j) { const float keep = b3 ? r4[j + 2] : r4[j], send = b3 ? r4[j] : r4[j + 2]; s2[j] = keep + __shfl_xor(send, 8); }
            { const float keep = b2 ? s2[1] : s2[0], send = b2 ? s2[0] : s2[1]; tt = keep + __shfl_xor(send, 4); }
            tt += __shfl_xor(tt, 2); tt += __shfl_xor(tt, 1);
            tt *= (1.0f / EU_SCALE);
            const int pidx = __shfl(kv, lb + eloc) & 127;
            const float g = gate[(size_t)tok * 128 + pidx];
            const float u3 = 0.7978845608028654f * (tt + 0.044715f * tt * tt * tt);
            const float w = g * tt * sigmoidf_(2.0f * u3) * (1.0f / EV_SCALE);
            if (kb < 7) { const int kn = (kb + 1) < 4 ? k0 : k1; const int ln = ((kb + 1) & 3) * 16;
#pragma unroll
                for (int j = 0; j < 16; ++j) U[j] = row_load(ru, lane16, __builtin_amdgcn_readlane(kn, ln + j) >> 7); }
            __builtin_amdgcn_sched_barrier(0);
#pragma unroll
            for (int j = 0; j < 16; ++j) {
                const int sl = ((j >> 3) & 1) * 32 + ((j >> 2) & 1) * 16 + ((j >> 1) & 1) * 8 + (j & 1) * 4;
                const float wj = __int_as_float(__builtin_amdgcn_readlane(__float_as_int(w), sl));
                axpy16_fp8(y, wj, V[j]); }
        }
        float ss = 0.f;
#pragma unroll
        for (int i = 0; i < 16; ++i) ss += y[i] * y[i];
        const float rstd = rsqrtf(wave_sum(ss) * (1.f / D) + RMS_EPS);
        const float* mb = mod + (tok / SEQ) * 6144 + 5 * 1024; float* orow = DRY ? (float*)(F.ws + WS_AO) + (size_t)(tok & 1023) * D : F.out + (size_t)tok * D;
#pragma unroll
        for (int c = 0; c < 4; ++c) { const int col = 16 * lane + 4 * c;
            const f32x4 yy = {y[4 * c], y[4 * c + 1], y[4 * c + 2], y[4 * c + 3]};
            const f32x4 h0 = *(const f32x4*)(orow + col), g0 = *(const f32x4*)(mb + col), p0 = *(const f32x4*)(gp + col);
            *(f32x4*)(orow + col) = h0 + g0 * (yy * rstd * p0); }
    }
}

__device__ __forceinline__ void p9_bruteforce(Frame& F) {
    const bf16* QP = (const bf16*)(F.ws + WS_R2);
    int* eidx = (int*)(F.ws + WS_EIDX); float* gate = (float*)(F.ws + WS_GATE);
    LAS float* sc = (LAS float*)(F.lds);
    (void)sc;
    float* scr = (float*)(F.ws + WS_PIN);
    (void)scr;
    const int gt = (F.vcu * NWAVES * 64) + F.tid, NGT = F.G * NWAVES * 64;
    for (int it = gt; it < T * 8; it += NGT) {
        const int tok = it >> 3, h = it & 7;
        float v[2][16]; int ix[2][16];
        for (int side = 0; side < 2; ++side) {
            const float* K = F.in[side ? I_SK2 : I_SK1] + (size_t)h * 16384;
            const bf16* q = QP + (size_t)tok * 2048 + h * 256 + side * 128;
            float prev = INFINITY; int previ = -1;
            for (int k = 0; k < 16; ++k) {
                float best = -INFINITY; int bi = -1;
                for (int key = 0; key < 128; ++key) {
                    float s = 0.f;
                    for (int d = 0; d < 128; ++d) s += __uint_as_float((unsigned)q[d] << 16) * K[key * 128 + d];
                    const bool after = (s < prev) || (s == prev && key > previ);
                    if (after && (s > best)) { best = s; bi = key; }
                }
                v[side][k] = best; ix[side][k] = bi; prev = best; previ = bi;
            }
        }
        float prev = INFINITY; int previ = -1; float scs[16]; int es[16];
        for (int k = 0; k < 16; ++k) {
            float best = -INFINITY; int bi = -1;
            for (int c = 0; c < 256; ++c) { const float s = v[0][c >> 4] + v[1][c & 15]; const bool after = (s < prev) || (s == prev && c > previ); if (after && s > best) { best = s; bi = c; } }
            scs[k] = best; es[k] = ix[0][bi >> 4] * 128 + ix[1][bi & 15]; prev = best; previ = bi;
        }
        float ssum = 0.f; for (int k = 0; k < 16; ++k) { scs[k] = __expf(scs[k] - scs[0]); ssum += scs[k]; }
        scs[0] = 1.0f;
        for (int k = 0; k < 16; ++k) { eidx[(size_t)it * 16 + k] = es[k]; gate[(size_t)it * 16 + k] = scs[k] / ssum; }
    }
}
__device__ __forceinline__ void p10_bruteforce(Frame& F) {
    const int gw = F.vcu * NWAVES + F.wave, NGW = F.G * NWAVES, lane = F.lane;
    const bf16* XN = (const bf16*)(F.ws + WS_R1); const float* EU = F.in[I_EU]; const float* EV = F.in[I_EV];
    const int* eidx = (const int*)(F.ws + WS_EIDX); const float* gate = (const float*)(F.ws + WS_GATE);
    const float* mod = (const float*)(F.ws + WS_CTL) + CW_MODF; const float* gp = F.in[I_GPOST2];
    for (int tok = gw; tok < T; tok += NGW) {
        float x[16], y[16];
        for (int i = 0; i < 16; ++i) { x[i] = __uint_as_float((unsigned)XN[(size_t)tok * D + lane + 64 * i] << 16); y[i] = 0.f; }
        for (int k = 0; k < 128; ++k) {
            const int e = eidx[(size_t)tok * 128 + k]; const float g = gate[(size_t)tok * 128 + k];
            float p = 0.f;
            for (int i = 0; i < 16; ++i) p += x[i] * EU[(size_t)e * D + lane + 64 * i];
            p = wave_sum(p);
            const float u3 = 0.7978845608028654f * (p + 0.044715f * p * p * p);
            const float w = g * 0.5f * p * (1.0f + tanhf(u3));
            for (int i = 0; i < 16; ++i) y[i] += w * EV[(size_t)e * D + lane + 64 * i];
        }
        float ss = 0.f; for (int i = 0; i < 16; ++i) ss += y[i] * y[i];
        const float rstd = rsqrtf(wave_sum(ss) * (1.f / D) + RMS_EPS);
        const float* mb = mod + (tok / SEQ) * 6144 + 5 * 1024; float* orow = F.out + (size_t)tok * D;
        for (int i = 0; i < 16; ++i) { const int col = lane + 64 * i; orow[col] = orow[col] + mb[col] * (y[i] * rstd * gp[col]); }
    }
}
#ifndef PH_MASK
#define PH_MASK 0xFFFFFFFFu
#endif
#define PH(k) ((PH_MASK >> (k)) & 1u)
__global__ void __launch_bounds__(NWAVES * 64, 2) fwd_megakernel(Args args) {
    extern __shared__ __attribute__((aligned(16))) unsigned char lds_raw[];
    Frame F;
    F.lds = (LAS unsigned char*)lds_raw;
    F.tid = threadIdx.x; F.lane = F.tid & 63; F.wave = __builtin_amdgcn_readfirstlane(F.tid >> 6);
    F.G = gridDim.x; { const int bx = blockIdx.x; F.vcu = (F.G % 8 == 0) ? (bx % 8) * (F.G / 8) + bx / 8 : bx; }
    F.in = args.in; F.out = args.out; F.ws = args.ws;
    unsigned char* ws = args.ws;
    volatile LAS unsigned* MISC = (volatile LAS unsigned*)(F.lds + LDSCTL_OFF);
    for (int u = F.tid; u < 64; u += NWAVES * 64) MISC[u] = 0u;
    __syncthreads();
    XcdBarrier bar = xcd_barrier_post((unsigned*)(ws + WS_CTL) + CW_BAR, MISC + 8);
#define GRID_BAR() xcd_barrier(bar)
    using namespace pg8;
    long long* rsq = (long long*)((unsigned*)(ws + WS_CTL) + CW_RSQ); long long* rsk = (long long*)((unsigned*)(ws + WS_CTL) + CW_RSK); const float* rope = (const float*)(ws + WS_ROPE);
    bf16* PROJ = (bf16*)(ws + WS_R2);
    if (PH(0)) p0_prologue(F); GRID_BAR();
    if (PH(1)) p1_xn(F); GRID_BAR();
    if (PH(2)) { Gemm g{(const bf16*)(ws + WS_R1), (const bf16*)(ws + WS_WIN), T, PROJ_N, 1024, 1024, 1024}; StaticOrder S; S.init(T, PROJ_N, F.G, (int)blockIdx.x);
      EpiProj E{PROJ, (bf16*)(ws + WS_KB), rsq, rsk, rope}; gemm_phase<EpiProj, true>(F.lds, g, S, E); }
    GRID_BAR();
    if (PH(3)) p3_pool(F);
    if (PH(4)) { Gemm g{PROJ + 512, (const bf16*)(ws + WS_WQ), T, 768, 256, PROJ_N, 256}; StaticOrder S; S.init(T, 768, F.G, (int)blockIdx.x);
      EpiQ E{(bf16*)(ws + WS_R1), rsq, rope}; gemm_phase<EpiQ, true>(F.lds, g, S, E); }
    if (PH(5)) { Gemm g{PROJ + 768, (const bf16*)(ws + WS_WK), T, 512, 256, PROJ_N, 256}; StaticOrder S; S.init(T, 512, F.G, (int)blockIdx.x);
      EpiKn E{(bf16*)(ws + WS_KB), rsk}; gemm_phase<EpiKn, true>(F.lds, g, S, E); }
    if (PH(6)) { Gemm g{(const bf16*)(ws + WS_WV), PROJ + 768, 512, T, 256, 256, PROJ_N}; StaticOrder S; S.init(512, T, F.G, (int)blockIdx.x);
      EpiVt E{(bf16*)(ws + WS_VT), rsk}; gemm_phase<EpiVt, true>(F.lds, g, S, E); }
    GRID_BAR();
    if (PH(7)) { Gemm g{(const bf16*)(ws + WS_PIN), (const bf16*)(ws + WS_WG), T, 512, 512, 512, 512}; StaticOrder S; S.init(T, 512, F.G, (int)blockIdx.x);
      EpiPlain E{(bf16*)(ws + WS_PF), 512}; gemm_phase<EpiPlain, true>(F.lds, g, S, E); }
    if (PH(8)) p4_attention(F);
#if defined(DUP_ATT)
    p4_attention(F);
#endif
    GRID_BAR();
    if (PH(9)) { Gemm g{(const bf16*)(ws + WS_PF), (const bf16*)(ws + WS_WPO), T, 1024, 512, 512, 512}; StaticOrder S; S.init(T, 1024, F.G, (int)blockIdx.x);
      EpiGate<0> E{(bf16*)(ws + WS_MRG), PROJ, 1024}; gemm_phase<EpiGate<0>, true>(F.lds, g, S, E); }
    asm volatile("s_waitcnt vmcnt(0)" ::: "memory"); __syncthreads();
    if (PH(10)) { Gemm g{(const bf16*)(ws + WS_AO), (const bf16*)(ws + WS_WMO), T, 1024, 512, 512, 512}; StaticOrder S; S.init(T, 1024, F.G, (int)blockIdx.x);
      EpiGate<1> E{(bf16*)(ws + WS_MRG), PROJ, 2048}; gemm_phase<EpiGate<1>, true>(F.lds, g, S, E); }
    GRID_BAR();
    if (PH(11)) { Gemm g{(const bf16*)(ws + WS_MRG), (const bf16*)(ws + WS_WOUT), T, 1024, 1024, 1024, 1024}; StaticOrder S; S.init(T, 1024, F.G, (int)blockIdx.x);
      EpiPlain E{(bf16*)(ws + WS_R2), 1024}; gemm_phase<EpiPlain, true>(F.lds, g, S, E); }
    GRID_BAR();
    if (PH(12)) p7_rows(F); GRID_BAR();
    if (PH(13)) { Gemm g{(const bf16*)(ws + WS_R1), (const bf16*)(ws + WS_WQY), T, 2048, 1024, 1024, 1024}; StaticOrder S; S.init(T, 2048, F.G, (int)blockIdx.x);
      EpiPlain E{(bf16*)(ws + WS_R2), 2048}; gemm_phase<EpiPlain, true>(F.lds, g, S, E); }
    GRID_BAR();
    if (PH(14)) cvt_experts(F);
#if defined(BF_P9)
    if (PH(15)) p9_bruteforce(F);
#else
    if (PH(15)) p9_peer_topk(F);
#if defined(DUP_TOPK)
    p9_peer_topk(F);
#endif
#endif
    GRID_BAR();
#if defined(BF_P10)
    if (PH(16)) p10_bruteforce(F);
#else
#if defined(DUP_P10)
    p10_peer_experts<true>(F);
#endif
    if (PH(16)) p10_peer_experts<false>(F);
#endif
}

extern "C" void kernel_launch(void* const* d_in, const int* in_sizes, int n_in, void* d_out, int out_size, void* d_ws, size_t ws_size, hipStream_t stream) {
    static int grid = 0;
    if (grid == 0) {
        if (n_in != 23 || out_size != T * D || ws_size < WS_END) { fprintf(stderr, "kernel_launch: unexpected shapes (n_in %d out %d ws %zu)\n", n_in, out_size, ws_size); grid = -1; return; }
        int dev = 0, cus = 0, per_cu = 0;
        if (hipGetDevice(&dev) != hipSuccess || hipDeviceGetAttribute(&cus, hipDeviceAttributeMultiprocessorCount, dev) != hipSuccess) { grid = -1; return; }
        if (hipFuncSetAttribute((const void*)fwd_megakernel, hipFuncAttributeMaxDynamicSharedMemorySize, LDS_BYTES) != hipSuccess) { fprintf(stderr, "kernel_launch: hipFuncSetAttribute failed\n"); grid = -1; return; }
        if (hipOccupancyMaxActiveBlocksPerMultiprocessor(&per_cu, (const void*)fwd_megakernel, NWAVES * 64, LDS_BYTES) != hipSuccess || per_cu < 1) { fprintf(stderr, "kernel_launch: note: occupancy query says %d workgroups per CU\n", per_cu); (void)hipGetLastError(); }
        grid = cus;
    }
    if (grid < 0) return;
    (void)hipMemsetAsync((char*)d_ws + WS_CTL, 0, CTL_ZERO_BYTES, stream);
    Args a{};
    for (int i = 0; i < 23; ++i) a.in[i] = (const float*)d_in[i];
    a.out = (float*)d_out; a.ws = (unsigned char*)d_ws;
    hipLaunchKernelGGL(fwd_megakernel, dim3(grid), dim3(NWAVES * 64), LDS_BYTES, stream, a);
}
```

```cpp
#include <hip/hip_runtime.h>
#include <cstdio>
#include <cstdint>

#ifndef DIAG
#define DIAG 0
#endif
#define LAS __attribute__((address_space(3)))
#define GAS __attribute__((address_space(1)))
typedef unsigned short bf16;
typedef short bf16x8 __attribute__((ext_vector_type(8)));
typedef float f32x4 __attribute__((ext_vector_type(4)));
typedef float f32x2 __attribute__((ext_vector_type(2)));
typedef float f32x16 __attribute__((ext_vector_type(16)));
typedef unsigned u32x4 __attribute__((ext_vector_type(4)));
typedef unsigned u32x2 __attribute__((ext_vector_type(2)));
typedef __bf16 bf16x2_t __attribute__((ext_vector_type(2)));

constexpr int NBATCH = 4, SEQ = 4096, T = NBATCH * SEQ, D = 1024;
constexpr int PROJ_N = 3072;
constexpr int NHEAD = 8, QKD = 96, VD = 64;
constexpr float RMS_EPS = 1e-6f;
constexpr float ATT_C2 = 0.10206207261596577f * 1.4426950408889634f;
constexpr int PEER_H = 8, PEER_K = 16;

constexpr size_t MiB = 1u << 20;
constexpr size_t WS_CTL = 0, CTL_ZERO_BYTES = 1 * MiB;
constexpr size_t WS_WIN = 1 * MiB;
constexpr size_t WS_WQ = 7 * MiB;
constexpr size_t WS_WK = WS_WQ + 512 * 1024;
constexpr size_t WS_WV = WS_WK + 256 * 1024;
constexpr size_t WS_WG = 8 * MiB;
constexpr size_t WS_WPO = WS_WG + 512 * 1024;
constexpr size_t WS_WMO = WS_WPO + 1 * MiB;
constexpr size_t WS_WOUT = WS_WMO + 1 * MiB;
constexpr size_t WS_WQY = 13 * MiB;
constexpr size_t WS_SK = 17 * MiB;
constexpr size_t WS_ROPE = WS_SK + 512 * 1024;
constexpr size_t WS_R1 = 18 * MiB;
constexpr size_t WS_R2 = 50 * MiB;
constexpr size_t WS_EIDX = WS_R2 + 64 * MiB;
constexpr size_t WS_GATE = WS_EIDX + 8 * MiB;
constexpr size_t WS_KB = 146 * MiB;
constexpr size_t WS_VT = 170 * MiB;
constexpr size_t WS_MRG = 146 * MiB;
constexpr size_t WS_PIN = 186 * MiB;
constexpr size_t WS_PF = 202 * MiB;
constexpr size_t WS_AO = 218 * MiB;
constexpr size_t WS_EU = 146 * MiB;
constexpr size_t WS_EV = 154 * MiB;
constexpr size_t WS_ESC = 162 * MiB;
constexpr size_t WS_END = 234 * MiB;
constexpr int CW_BAR = 4096;
constexpr int CW_MOD = 16384;
constexpr int CW_RSQ = CW_MOD + 2 * 4 * 6144;
constexpr int CW_RSK = CW_RSQ + 2 * T;
constexpr int CW_MODF = CW_RSK + 2 * T;
static_assert((CW_MODF + 4 * 6144) * 4 <= (int)CTL_ZERO_BYTES, "ctl");
constexpr double MOD_FX = 1099511627776.0, RS_FX = 16777216.0;
__device__ __forceinline__ void fx_add(long long* p, float v, double scale) { atomicAdd((unsigned long long*)p, (unsigned long long)__double2ll_rn((double)v * scale)); }
__device__ __forceinline__ float fx_get(const long long* p, double inv_scale) { return (float)((double)(*p) * inv_scale); }

__device__ __forceinline__ unsigned cvtpk(float lo, float hi) { f32x2 v = {lo, hi}; bf16x2_t b = __builtin_convertvector(v, bf16x2_t); return __builtin_bit_cast(unsigned, b); }
__device__ __forceinline__ float bflo(unsigned w) { return __uint_as_float(w << 16); }
__device__ __forceinline__ float bfhi(unsigned w) { return __uint_as_float(w & 0xffff0000u); }
__device__ __forceinline__ u32x4 pack8(f32x4 a, f32x4 b) { u32x4 w; w.x = cvtpk(a[0], a[1]); w.y = cvtpk(a[2], a[3]); w.z = cvtpk(b[0], b[1]); w.w = cvtpk(b[2], b[3]); return w; }
__device__ __forceinline__ void unpack8(u32x4 w, f32x4& a, f32x4& b) { a = (f32x4){bflo(w.x), bfhi(w.x), bflo(w.y), bfhi(w.y)}; b = (f32x4){bflo(w.z), bfhi(w.z), bflo(w.w), bfhi(w.w)}; }
__device__ __forceinline__ float sigmoidf_(float x) { return __builtin_amdgcn_rcpf(1.0f + __builtin_amdgcn_exp2f(-1.4426950408889634f * x)); }
__device__ __forceinline__ float wave_sum(float v) {
#pragma unroll
    for (int o = 1; o < 64; o <<= 1) v += __shfl_xor(v, o);
    return v;
}
#define LDS_WAIT() asm volatile("s_waitcnt lgkmcnt(0)" ::: "memory")

namespace pg8 {
typedef unsigned short bf16_t;
constexpr int BM = 256, BK = 64, HALF = 128, HTB = HALF * BK * 2, STAGE_BYTES = 8 * HTB, NXCD = 8, WGM = 8;
__host__ __device__ __forceinline__ int lds_byte(int r, int c) { const int st = (r >> 4) * 2 + (c >> 5), rr = r & 15, cc = c & 31, ob = rr * 64 + cc * 2; return st * 1024 + (ob ^ (((ob >> 9) & 1) << 5)); }
__host__ __device__ __forceinline__ void stage_rc(int b, int& R, int& C) { const int st = b / 1024, sb = b % 1024, swz = sb ^ (((sb >> 9) & 1) << 5); R = (st >> 1) * 16 + swz / 64; C = (st & 1) * 32 + (swz % 64) / 2; }
__host__ __device__ __forceinline__ int perm32(int rho) { const int n = rho >> 4, i = rho & 15; return 8 * (i >> 2) + 4 * n + (i & 3); }
struct Unit { int pm, pn; };
struct Gemm { const bf16_t* A; const bf16_t* Bt; int M, N, K, lda, ldb; };
struct StaticOrder {
    int nM, nN, nwg, G, c;
    __host__ __device__ void init(int M, int N, int G_, int c_) { nM = M / BM; nN = N / BM; nwg = nM * nN; G = G_; c = c_; }
    __host__ __device__ bool next(int i, Unit& u) const {
        const long L = (long)i * G + c; if (L >= nwg) return false;
        int wgid = (int)L; { const int q = nwg / NXCD, r = nwg % NXCD, xcd = wgid % NXCD, off = wgid / NXCD; wgid = (xcd < r ? xcd * (q + 1) : r * (q + 1) + (xcd - r) * q) + off; }
        const int nig = WGM * nN, gid = wgid / nig, fm = gid * WGM, gsz = (nM - fm) < WGM ? (nM - fm) : WGM;
        u.pm = fm + ((wgid % nig) % gsz); u.pn = (wgid % nig) / gsz; return true;
    }
};
template <class Epi, bool ALIGN_EPI>
__device__ __forceinline__ void gemm_phase(LAS unsigned char* lds, const Gemm g, const StaticOrder& S, const Epi& E) {
    int tid_ = threadIdx.x; asm volatile("" : "+v"(tid_));
    const int tid = tid_, wid = __builtin_amdgcn_readfirstlane(tid >> 6), lane = tid & 63, wr = wid >> 2, wc = wid & 3, fr = lane & 15, fq = lane >> 4;
    int K_ = g.K; asm volatile("" : "+s"(K_));
    const int K = K_, nt = K / BK;
    unsigned voffA[2], voffB[2];
#pragma unroll
    for (int i = 0; i < 2; ++i) { int R, C; stage_rc(tid * 16 + i * 8192, R, C); const int Rb = (R & ~31) + perm32(R & 31);
        voffA[i] = (unsigned)(R * g.lda + C) * 2u; voffB[i] = (unsigned)(Rb * g.ldb + C) * 2u; }
    const size_t kstep = (size_t)(BK * 2);
    const size_t hstepA = (size_t)HALF * g.lda * 2, hstepB = (size_t)HALF * g.ldb * 2;
    const size_t tstepA = 2 * hstepA, tstepB = 2 * hstepB;
    const unsigned ldsw = (unsigned)wid * 1024u;
    const int aoff = lds_byte(wr * 64 + fr, fq * 8), boff = lds_byte(wc * 32 + fr, fq * 8);
#define PG8_SA(b, h) (((b) * 2 + (h)) * HTB)
#define PG8_SB(b, h) ((4 + (b) * 2 + (h)) * HTB)
#define PG8_STAGE(bufoff, gbase, voff) do { _Pragma("unroll") for (int _i = 0; _i < 2; ++_i) \
        __builtin_amdgcn_global_load_lds((const unsigned*)((const char*)(gbase) + (voff)[_i]), (LAS unsigned*)(lds + (bufoff) + ldsw + _i * 8192), 16, 0, 0); } while (0)
#define PG8_LDA(dst, b, h) do { _Pragma("unroll") for (int m = 0; m < 4; ++m) _Pragma("unroll") for (int k = 0; k < 2; ++k) dst[m][k] = *(const LAS bf16x8*)(lds + PG8_SA(b, h) + aoff + m * 2048 + k * 1024); } while (0)
#define PG8_LDB(dst, b, h) do { _Pragma("unroll") for (int n = 0; n < 2; ++n) _Pragma("unroll") for (int k = 0; k < 2; ++k) dst[n][k] = *(const LAS bf16x8*)(lds + PG8_SB(b, h) + boff + n * 2048 + k * 1024); } while (0)
#define PG8_MMA(ai, bj, At, Bt) do { __builtin_amdgcn_s_setprio(1); _Pragma("unroll") for (int m = 0; m < 4; ++m) _Pragma("unroll") for (int n = 0; n < 2; ++n) _Pragma("unroll") for (int k = 0; k < 2; ++k) \
        acc[ai][bj][m][n] = __builtin_amdgcn_mfma_f32_16x16x32_bf16(Bt[n][k], At[m][k], acc[ai][bj][m][n], 0, 0, 0); __builtin_amdgcn_s_setprio(0); } while (0)
#define PG8_WAIT_V(n) asm volatile("s_waitcnt vmcnt(" #n ")" ::: "memory")
#define PG8_WAIT_L(n) asm volatile("s_waitcnt lgkmcnt(" #n ")" ::: "memory")
#define PG8_BAR __builtin_amdgcn_s_barrier()
#define PG8_SCHED __builtin_amdgcn_sched_barrier(0)
    Unit cur, nxt; int ui = 0;
    if (!S.next(0, cur)) return;
    f32x4 acc[2][2][4][2];
#pragma unroll
    for (int a = 0; a < 2; ++a)
#pragma unroll
        for (int b = 0; b < 2; ++b)
#pragma unroll
            for (int m = 0; m < 4; ++m)
#pragma unroll
                for (int n = 0; n < 2; ++n) acc[a][b][m][n] = (f32x4){0.f, 0.f, 0.f, 0.f};
    bf16x8 At[4][2], B0[2][2], B1[2][2];
    const char* cA = (const char*)g.A + (size_t)cur.pm * tstepA; const char* cB = (const char*)g.Bt + (size_t)cur.pn * tstepB;
    PG8_STAGE(PG8_SB(0, 0), cB, voffB); PG8_STAGE(PG8_SB(0, 1), cB + hstepB, voffB); PG8_STAGE(PG8_SA(0, 0), cA, voffA); PG8_STAGE(PG8_SA(0, 1), cA + hstepA, voffA);
    if (wr == 1) PG8_BAR;
    PG8_WAIT_V(2); PG8_BAR;
    PG8_STAGE(PG8_SB(1, 0), cB + kstep, voffB); PG8_STAGE(PG8_SA(1, 0), cA + kstep, voffA); PG8_STAGE(PG8_SB(1, 1), cB + hstepB + kstep, voffB);
    PG8_WAIT_V(6); PG8_BAR;
    for (;;) {
        const bool has_next = S.next(ui + 1, nxt);
        const char* nA = has_next ? (const char*)g.A + (size_t)nxt.pm * tstepA : cA; const char* nB = has_next ? (const char*)g.Bt + (size_t)nxt.pn * tstepB : cB;
        for (int t = 0; t < nt; t += 2) {
            const bool last = (t == nt - 2);
            const char* a1 = cA + (size_t)(t + 1) * kstep;
            const char* a2 = last ? nA : cA + (size_t)(t + 2) * kstep; const char* b2 = last ? nB : cB + (size_t)(t + 2) * kstep;
            const char* a3 = a2 + kstep; const char* b3 = b2 + kstep;
            PG8_LDB(B0, 0, 0); PG8_LDB(B1, 0, 1); PG8_SCHED; PG8_LDA(At, 0, 0); PG8_STAGE(PG8_SA(1, 1), a1 + hstepA, voffA);
            PG8_WAIT_V(8); PG8_WAIT_L(0); PG8_BAR; PG8_MMA(0, 0, At, B0); PG8_MMA(0, 1, At, B1); PG8_BAR; PG8_SCHED;
            PG8_LDA(At, 0, 1); PG8_STAGE(PG8_SB(0, 0), b2, voffB); PG8_STAGE(PG8_SB(0, 1), b2 + hstepB, voffB); PG8_STAGE(PG8_SA(0, 0), a2, voffA);
            PG8_WAIT_V(8); PG8_WAIT_L(0); PG8_BAR; PG8_MMA(1, 0, At, B0); PG8_MMA(1, 1, At, B1); PG8_BAR; PG8_SCHED;
            PG8_LDB(B0, 1, 0); PG8_LDB(B1, 1, 1); PG8_SCHED; PG8_LDA(At, 1, 0); PG8_STAGE(PG8_SA(0, 1), a2 + hstepA, voffA);
            PG8_WAIT_V(8); PG8_WAIT_L(0); PG8_BAR; PG8_MMA(0, 0, At, B0); PG8_MMA(0, 1, At, B1); PG8_BAR; PG8_SCHED;
            PG8_LDA(At, 1, 1); PG8_STAGE(PG8_SB(1, 0), b3, voffB); PG8_STAGE(PG8_SB(1, 1), b3 + hstepB, voffB); PG8_STAGE(PG8_SA(1, 0), a3, voffA);
            PG8_WAIT_V(8); PG8_WAIT_L(0); PG8_BAR; PG8_MMA(1, 0, At, B0); PG8_MMA(1, 1, At, B1); PG8_BAR; PG8_SCHED;
        }
        if constexpr (ALIGN_EPI) { if (wr == 0) PG8_BAR; }
        E(acc, cur, wr, wc, fr, fq);
        if (!has_next) break;
#pragma unroll
        for (int a = 0; a < 2; ++a)
#pragma unroll
            for (int b = 0; b < 2; ++b)
#pragma unroll
                for (int m = 0; m < 4; ++m)
#pragma unroll
                    for (int n = 0; n < 2; ++n) acc[a][b][m][n] = (f32x4){0.f, 0.f, 0.f, 0.f};
        cur = nxt; cA = nA; cB = nB; ++ui;
        if constexpr (ALIGN_EPI) { if (wr == 1) PG8_BAR; }
    }
    PG8_WAIT_V(0);
    if constexpr (!ALIGN_EPI) { if (wr == 0) PG8_BAR; }
    PG8_BAR;
#undef PG8_SA
#undef PG8_SB
#undef PG8_STAGE
#undef PG8_LDA
#undef PG8_LDB
#undef PG8_MMA
#undef PG8_WAIT_V
#undef PG8_WAIT_L
#undef PG8_BAR
#undef PG8_SCHED
}

#define EPI_ARGS const f32x4 (&acc)[2][2][4][2], const Unit& u, int wr, int wc, int fr, int fq
__device__ __forceinline__ void rope8(f32x4& v0, f32x4& v1, const float* tab, int e0) {
    const f32x4 c = *(const f32x4*)(tab + e0), s = *(const f32x4*)(tab + 16 + e0);
    const float a0 = v0[0] * c[0] - v0[1] * s[0], b0 = v0[1] * c[0] + v0[0] * s[0];
    const float a1 = v0[2] * c[1] - v0[3] * s[1], b1 = v0[3] * c[1] + v0[2] * s[1];
    const float a2 = v1[0] * c[2] - v1[1] * s[2], b2 = v1[1] * c[2] + v1[0] * s[2];
    const float a3 = v1[2] * c[3] - v1[3] * s[3], b3 = v1[3] * c[3] + v1[2] * s[3];
    v0 = (f32x4){a0, b0, a1, b1}; v1 = (f32x4){a2, b2, a3, b3};
}
struct EpiPlain { bf16* O; int ldc;
    __device__ __forceinline__ void operator()(EPI_ARGS) const {
#pragma unroll
        for (int ai = 0; ai < 2; ++ai)
#pragma unroll
            for (int m = 0; m < 4; ++m) { const int row = u.pm * BM + ai * HALF + wr * 64 + m * 16 + fr;
#pragma unroll
                for (int bj = 0; bj < 2; ++bj) { const int col0 = u.pn * BM + bj * HALF + wc * 32 + 8 * fq;
                    *(u32x4*)(O + (size_t)row * ldc + col0) = pack8(acc[ai][bj][m][0], acc[ai][bj][m][1]); } }
    }
};
struct EpiProj { bf16* P; bf16* Kb; long long* rsq; long long* rsk; const float* rope;
    __device__ __forceinline__ void operator()(EPI_ARGS) const {
        const int pn = u.pn;
#pragma unroll
        for (int ai = 0; ai < 2; ++ai)
#pragma unroll
            for (int m = 0; m < 4; ++m) { const int row = u.pm * BM + ai * HALF + wr * 64 + m * 16 + fr; float ss = 0.f;
#pragma unroll
                for (int bj = 0; bj < 2; ++bj) { const int col0 = pn * BM + bj * HALF + wc * 32 + 8 * fq;
                    f32x4 v0 = acc[ai][bj][m][0], v1 = acc[ai][bj][m][1];
                    if (pn >= 4) {
#pragma unroll
                        for (int i = 0; i < 4; ++i) { v0[i] = sigmoidf_(v0[i]); v1[i] = sigmoidf_(v1[i]); }
                    }
                    *(u32x4*)(P + (size_t)row * PROJ_N + col0) = pack8(v0, v1);
                    if (pn == 2 || (pn == 3 && bj == 0)) ss += (v0[0] * v0[0] + v0[1] * v0[1]) + (v0[2] * v0[2] + v0[3] * v0[3]) + (v1[0] * v1[0] + v1[1] * v1[1]) + (v1[2] * v1[2] + v1[3] * v1[3]);
                    if (pn == 3 && bj == 1 && wc == 0) {
                        rope8(v0, v1, rope + (size_t)(row & (SEQ - 1)) * 32, 4 * fq);
                        const u32x4 w = pack8(v0, v1);
#pragma unroll
                        for (int h = 0; h < NHEAD; ++h) *(u32x4*)(Kb + (size_t)row * (NHEAD * QKD) + h * QKD + 64 + 8 * fq) = w;
                    }
                }
                if (pn == 2 || pn == 3) { ss += __shfl_xor(ss, 16); ss += __shfl_xor(ss, 32);
                    if (fq == 0) fx_add((pn == 2 ? rsq : rsk) + row, ss, RS_FX); }
            }
    }
};
struct EpiQ { bf16* Q; const long long* rsq; const float* rope;
    __device__ __forceinline__ void operator()(EPI_ARGS) const {
#pragma unroll
        for (int ai = 0; ai < 2; ++ai)
#pragma unroll
            for (int m = 0; m < 4; ++m) { const int row = u.pm * BM + ai * HALF + wr * 64 + m * 16 + fr;
                const float sc = rsqrtf(fx_get(rsq + row, 1.0 / RS_FX) * (1.0f / 256.0f) + RMS_EPS) * ATT_C2;
#pragma unroll
                for (int bj = 0; bj < 2; ++bj) { const int col0 = u.pn * BM + bj * HALF + wc * 32 + 8 * fq;
                    f32x4 v0 = acc[ai][bj][m][0] * sc, v1 = acc[ai][bj][m][1] * sc;
                    if (((u.pn * 8 + bj * 4 + wc) % 3) == 2) rope8(v0, v1, rope + (size_t)(row & (SEQ - 1)) * 32, 4 * fq);
                    *(u32x4*)(Q + (size_t)row * (NHEAD * QKD) + col0) = pack8(v0, v1); }
                asm volatile("" ::: "memory"); }
    }
};
struct EpiKn { bf16* Kb; const long long* rsk;
    __device__ __forceinline__ void operator()(EPI_ARGS) const {
#pragma unroll
        for (int ai = 0; ai < 2; ++ai)
#pragma unroll
            for (int m = 0; m < 4; ++m) { const int row = u.pm * BM + ai * HALF + wr * 64 + m * 16 + fr;
                const float sc = rsqrtf(fx_get(rsk + row, 1.0 / RS_FX) * (1.0f / 128.0f) + RMS_EPS);
#pragma unroll
                for (int bj = 0; bj < 2; ++bj) { const int col0 = u.pn * BM + bj * HALF + wc * 32 + 8 * fq; const int h = col0 >> 6, j = col0 & 63;
                    *(u32x4*)(Kb + (size_t)row * (NHEAD * QKD) + h * QKD + j) = pack8(acc[ai][bj][m][0] * sc, acc[ai][bj][m][1] * sc); }
                if (m & 1) asm volatile("" ::: "memory"); }
    }
};
struct EpiVt { bf16* Vt; const long long* rsk;
    __device__ __forceinline__ void operator()(EPI_ARGS) const {
#pragma unroll
        for (int bj = 0; bj < 2; ++bj) { const int col0 = u.pn * BM + bj * HALF + wc * 32 + 8 * fq;
            f32x4 s0, s1;
#pragma unroll
            for (int i = 0; i < 4; ++i) { s0[i] = rsqrtf(fx_get(rsk + col0 + i, 1.0 / RS_FX) * (1.0f / 128.0f) + RMS_EPS); s1[i] = rsqrtf(fx_get(rsk + col0 + 4 + i, 1.0 / RS_FX) * (1.0f / 128.0f) + RMS_EPS); }
#pragma unroll
            for (int ai = 0; ai < 2; ++ai)
#pragma unroll
                for (int m = 0; m < 4; ++m) { const int row = u.pm * BM + ai * HALF + wr * 64 + m * 16 + fr;
                    *(u32x4*)(Vt + (size_t)row * T + col0) = pack8(acc[ai][bj][m][0] * s0, acc[ai][bj][m][1] * s1); }
            asm volatile("" ::: "memory"); }
    }
};
template <int MODE> struct EpiGate { bf16* Y; const bf16* P; int goff;
    __device__ __forceinline__ void operator()(EPI_ARGS) const {
#pragma unroll
        for (int ai = 0; ai < 2; ++ai)
#pragma unroll
            for (int m = 0; m < 4; ++m) { const int row = u.pm * BM + ai * HALF + wr * 64 + m * 16 + fr;
#pragma unroll
                for (int bj = 0; bj < 2; ++bj) { const int col0 = u.pn * BM + bj * HALF + wc * 32 + 8 * fq;
                    f32x4 g0, g1; unpack8(*(const u32x4*)(P + (size_t)row * PROJ_N + goff + col0), g0, g1);
                    f32x4 v0 = acc[ai][bj][m][0] * g0, v1 = acc[ai][bj][m][1] * g1;
                    bf16* yp = Y + (size_t)row * D + col0;
                    if (MODE == 1) { f32x4 y0, y1; unpack8(*(const u32x4*)yp, y0, y1); v0 += y0; v1 += y1; }
                    *(u32x4*)yp = pack8(v0, v1); } }
    }
};
}

#define XB_TMO      128
#define XB_XCNT(j)  (256  + 64 * (j))
#define XB_XSUB(j)  (1280 + 64 * (j))
#define XB_XGEN(j)  (2304 + 64 * (j))
#define XB_TOP      3328
#define XB_TOPGEN   3392
#define XCD_BAR_WORDS 3456
#define XB_SPIN_CAP (1u << 18)
__device__ __forceinline__ unsigned xb_ld(unsigned* p)              { return __hip_atomic_load(p, __ATOMIC_RELAXED, __HIP_MEMORY_SCOPE_AGENT); }
__device__ __forceinline__ unsigned xb_add(unsigned* p, unsigned v) { return __hip_atomic_fetch_add(p, v, __ATOMIC_RELAXED, __HIP_MEMORY_SCOPE_AGENT); }
__device__ __forceinline__ unsigned xb_xcc_id() { return (unsigned)__builtin_amdgcn_s_getreg((3 << 11) | 20) & 0xFu; }
#define XB_SPIN(cond, bar) do { unsigned _sp = 0; while (cond) { __builtin_amdgcn_s_sleep(1); \
    if ((++_sp & 255u) == 0u) { if (xb_ld(&(bar)[XB_TMO])) break; if (_sp > XB_SPIN_CAP) { atomicAdd(&(bar)[XB_TMO], 1u); break; } } } } while (0)
struct XcdBarrier { unsigned* bar; unsigned x; volatile LAS unsigned* st; };
__device__ __forceinline__ XcdBarrier xcd_barrier_post(unsigned* bar, volatile LAS unsigned* st) {
    XcdBarrier b; b.bar = bar; b.x = xb_xcc_id(); b.st = st;
    if (threadIdx.x == 0) (void)xb_add(&bar[XB_XCNT(b.x)], 1u);
    return b;
}
__device__ __forceinline__ void xcd_barrier_complete(unsigned* bar, unsigned x, unsigned& nloc, unsigned& nx) {
    const unsigned G = gridDim.x * gridDim.y * gridDim.z;
    unsigned sum, cnt, mine, sp = 0u;
    for (;;) {
        sum = 0u; cnt = 0u; mine = 0u;
#pragma unroll
        for (unsigned j = 0; j < 16; ++j) { const unsigned c = xb_ld(&bar[XB_XCNT(j)]); sum += c; cnt += (c > 0u) ? 1u : 0u; mine = (j == x) ? c : mine; }
        if (sum == G) break;
        __builtin_amdgcn_s_sleep(1);
        if ((++sp & 255u) == 0u) { if (xb_ld(&bar[XB_TMO])) break; if (sp > XB_SPIN_CAP) { atomicAdd(&bar[XB_TMO], 1u); break; } }
    }
    nloc = mine > 0u ? mine : 1u; nx = cnt > 0u ? cnt : 1u;
}
__device__ __forceinline__ void xcd_barrier(const XcdBarrier& b) {
    asm volatile("s_waitcnt vmcnt(0)" ::: "memory");
    __syncthreads();
    if (threadIdx.x == 0) {
        unsigned* bar = b.bar;
        __builtin_amdgcn_s_waitcnt(0);
        unsigned nloc = b.st[0], nx = b.st[1];
        if (nloc == 0u) { xcd_barrier_complete(bar, b.x, nloc, nx); b.st[0] = nloc; b.st[1] = nx; }
        const unsigned old = xb_add(&bar[XB_XSUB(b.x)], 1u);
        const unsigned gen = old / nloc;
        if (old + 1u == (gen + 1u) * nloc) {
            __builtin_amdgcn_fence(__ATOMIC_RELEASE, "agent");
            asm volatile("s_waitcnt vmcnt(0)" ::: "memory");
            const unsigned og = xb_add(&bar[XB_TOP], 1u);
            const unsigned tg = og / nx;
            if (og + 1u == (tg + 1u) * nx) xb_add(&bar[XB_TOPGEN], 1u);
            else XB_SPIN(xb_ld(&bar[XB_TOPGEN]) == tg, bar);
            __builtin_amdgcn_fence(__ATOMIC_ACQUIRE, "agent");
            xb_add(&bar[XB_XGEN(b.x)], 1u);
            asm volatile("s_waitcnt vmcnt(0)" ::: "memory");
        } else {
            XB_SPIN(xb_ld(&bar[XB_XGEN(b.x)]) == gen, bar);
            __builtin_amdgcn_fence(__ATOMIC_ACQUIRE, "agent");
            asm volatile("s_waitcnt vmcnt(0)" ::: "memory");
        }
    }
    __syncthreads();
}

constexpr int NWAVES = 8;
constexpr int RING_BYTES = 131072, LDSCTL_OFF = RING_BYTES, LDS_BYTES = 147456;
struct Args { const float* in[23]; float* out; unsigned char* ws; };
struct Frame {
    LAS unsigned char* lds; int tid, lane, wave, vcu, G;
    const float* const* in; float* out; unsigned char* ws;
};
enum { I_X = 0, I_C, I_WADA, I_BADA, I_GPRE1, I_GPOST1, I_WIN, I_WPG, I_PSCALE, I_WPO, I_GQ, I_WQUP, I_GKV, I_WKVUP, I_WMO, I_WOUT, I_GPRE2, I_GPOST2, I_WQY, I_SK1, I_SK2, I_EU, I_EV };

__device__ __forceinline__ void tr_block(const float* src, int spitch, int ks, int ns, int perm, const float* gk, const float* gn, bf16* dst, int dpitch, int nd, int kd, LAS float* scr, int lane) {
    if (src) {
        const float gnv = gn ? gn[lane & 31] : 1.0f;
        float tv[32];
#pragma unroll
        for (int i = 0; i < 32; ++i) tv[i] = src[(size_t)(ks + 2 * i + (lane >> 5)) * spitch + ns + (lane & 31)];
#pragma unroll
        for (int i = 0; i < 32; ++i) { const int kk = 2 * i + (lane >> 5); float v = tv[i] * gnv; if (gk) v *= gk[ks + kk]; scr[kk * 33 + (lane & 31)] = v; }
    } else {
#pragma unroll 8
        for (int i = 0; i < 32; ++i) { const int kk = 2 * i + (lane >> 5); scr[kk * 33 + (lane & 31)] = 0.f; }
    }
    LDS_WAIT(); asm volatile("" ::: "memory");
    const int c = lane & 7;
#pragma unroll
    for (int j = 0; j < 4; ++j) { const int n = (lane >> 3) + 8 * j; const int pc = perm ? ((n >> 1) + 16 * (n & 1)) : n; const LAS float* s = scr + (8 * c) * 33 + pc;
        u32x4 o; o.x = cvtpk(s[0 * 33], s[1 * 33]); o.y = cvtpk(s[2 * 33], s[3 * 33]); o.z = cvtpk(s[4 * 33], s[5 * 33]); o.w = cvtpk(s[6 * 33], s[7 * 33]);
        *(u32x4*)(dst + (size_t)(nd + n) * dpitch + kd + 8 * c) = o; }
    LDS_WAIT(); asm volatile("" ::: "memory");
}

__device__ __forceinline__ void p0_prologue(Frame& F) {
    LAS float* scr = (LAS float*)(F.lds + F.wave * 16384);
    int lane_ = F.lane; asm volatile("" : "+v"(lane_));
    const int gw = F.vcu * NWAVES + F.wave, NGW = F.G * NWAVES, lane = lane_;
    unsigned char* ws = F.ws;
    {
        long long* mod = (long long*)((unsigned*)(ws + WS_CTL) + CW_MOD);
        const float* cc = F.in[I_C]; const float* wa = F.in[I_WADA]; const float* ba = F.in[I_BADA];
        for (int it = gw; it < 24 * 64; it += NGW) {
            const int cg = it % 24, kc = it / 24; const int col = cg * 256 + 4 * lane;
            f32x4 a0 = {0, 0, 0, 0}, a1 = a0, a2 = a0, a3 = a0;
            if (kc == 0) { a0 = *(const f32x4*)(ba + col); a1 = a0; a2 = a0; a3 = a0; }
#pragma unroll 4
            for (int k = kc * 16; k < kc * 16 + 16; ++k) {
                const f32x4 w = *(const f32x4*)(wa + (size_t)k * 6144 + col);
                const float c0 = cc[k], c1 = cc[1024 + k], c2 = cc[2048 + k], c3 = cc[3072 + k];
                a0 += w * (c0 * sigmoidf_(c0)); a1 += w * (c1 * sigmoidf_(c1)); a2 += w * (c2 * sigmoidf_(c2)); a3 += w * (c3 * sigmoidf_(c3));
            }
#pragma unroll
            for (int i = 0; i < 4; ++i) { fx_add(mod + col + i, a0[i], MOD_FX); fx_add(mod + 6144 + col + i, a1[i], MOD_FX); fx_add(mod + 2 * 6144 + col + i, a2[i], MOD_FX); fx_add(mod + 3 * 6144 + col + i, a3[i], MOD_FX); }
        }
    }
    {
        bf16* Win = (bf16*)(ws + WS_WIN); bf16* Wq = (bf16*)(ws + WS_WQ); bf16* Wk = (bf16*)(ws + WS_WK); bf16* Wv = (bf16*)(ws + WS_WV); bf16* Wg = (bf16*)(ws + WS_WG);
        bf16* Wpo = (bf16*)(ws + WS_WPO); bf16* Wmo = (bf16*)(ws + WS_WMO); bf16* Wout = (bf16*)(ws + WS_WOUT); bf16* Wqy = (bf16*)(ws + WS_WQY);
        constexpr int N1 = 96 * 16, N2 = 24 * 4, N3 = 16 * 4, N4 = 16 * 4, N5 = 16 * 8, N6 = 32 * 8, N7 = 32 * 8, N8 = 32 * 16, N9 = 64 * 16;
        constexpr int NITEMS = N1 + N2 + N3 + N4 + N5 + N6 + N7 + N8 + N9;
        for (int it = gw; it < NITEMS; it += NGW) {
            int r = it;
            if (r < N1) { const int nb = r % 96, kb = r / 96; const float* s = F.in[I_WIN]; int ns = 32 * nb, pm = 0;
                if (nb == 28) pm = 1; else if (nb >= 29 && nb < 32) s = nullptr; else if (nb >= 32) ns = 928 + 32 * (nb - 32);
                tr_block(s, 2976, 64 * kb, ns, pm, nullptr, nullptr, Win, 1024, 32 * nb, 64 * kb, scr, lane); continue; } r -= N1;
            if (r < N2) { const int nb = r % 24, kb = r / 24; const int h = nb / 3, q = nb % 3;
                tr_block(F.in[I_WQUP], 768, 64 * kb, 96 * h + 32 * q, q == 2, F.in[I_GQ], nullptr, Wq, 256, 32 * nb, 64 * kb, scr, lane); continue; } r -= N2;
            if (r < N3) { const int nb = r % 16, kb = r / 16; const int h = nb / 2, q = nb % 2;
                tr_block(kb < 2 ? F.in[I_WKVUP] : nullptr, 1024, 64 * kb, 128 * h + 32 * q, 0, F.in[I_GKV], nullptr, Wk, 256, 32 * nb, 64 * kb, scr, lane); continue; } r -= N3;
            if (r < N4) { const int nb = r % 16, kb = r / 16; const int h = nb / 2, q = nb % 2;
                tr_block(kb < 2 ? F.in[I_WKVUP] : nullptr, 1024, 64 * kb, 128 * h + 64 + 32 * q, 0, F.in[I_GKV], nullptr, Wv, 256, 32 * nb, 64 * kb, scr, lane); continue; } r -= N4;
            if (r < N5) { const int nb = r % 16, kb = r / 16; const int g = nb / 4; const bool dg = (kb / 2) == g;
                tr_block(dg ? F.in[I_WPG] + (size_t)g * 128 * 128 : nullptr, 128, 64 * (kb % 2), 32 * (nb % 4), 0, nullptr, F.in[I_PSCALE] + g * 128 + 32 * (nb % 4), Wg, 512, 32 * nb, 64 * kb, scr, lane); continue; } r -= N5;
            if (r < N6) { const int nb = r % 32, kb = r / 32; tr_block(F.in[I_WPO], 1024, 64 * kb, 32 * nb, 0, nullptr, nullptr, Wpo, 512, 32 * nb, 64 * kb, scr, lane); continue; } r -= N6;
            if (r < N7) { const int nb = r % 32, kb = r / 32; tr_block(F.in[I_WMO], 1024, 64 * kb, 32 * nb, 0, nullptr, nullptr, Wmo, 512, 32 * nb, 64 * kb, scr, lane); continue; } r -= N7;
            if (r < N8) { const int nb = r % 32, kb = r / 32; tr_block(F.in[I_WOUT], 1024, 64 * kb, 32 * nb, 0, nullptr, nullptr, Wout, 1024, 32 * nb, 64 * kb, scr, lane); continue; } r -= N8;
            { const int nb = r % 64, kb = r / 64; tr_block(F.in[I_WQY], 2048, 64 * kb, 32 * nb, 0, nullptr, nullptr, Wqy, 1024, 32 * nb, 64 * kb, scr, lane); }
        }
    }
    {
        bf16* sk = (bf16*)(ws + WS_SK);
        const int gt = (F.vcu * NWAVES * 64) + F.wave * 64 + lane, NGT = F.G * NWAVES * 64;
        for (int i = gt; i < 2 * 131072 / 8; i += NGT) { const int side = i / 16384, o = (i % 16384) * 8; const float* s = F.in[side ? I_SK2 : I_SK1] + o;
            *(u32x4*)(sk + (size_t)side * 131072 + o) = pack8(*(const f32x4*)s, *(const f32x4*)(s + 4)); }
        float* rope = (float*)(ws + WS_ROPE);
        for (int i = gt; i < SEQ * 16; i += NGT) { const int pos = i >> 4, e = i & 15;
            const float frac[4] = {1.0f, 0.5623413251903491f, 0.31622776601683794f, 0.17782794100389228f};
            const float dec[4] = {1.0f, 0.1f, 0.01f, 0.001f};
            const float inv = (float)((double)dec[e >> 2] * (double)frac[e & 3]);
            const float ang = (float)pos * inv;
            const double rev = (double)ang * 0.15915494309189535;
            const float fr = (float)(rev - floor(rev));
            rope[pos * 32 + e] = __builtin_amdgcn_cosf(fr); rope[pos * 32 + 16 + e] = __builtin_amdgcn_sinf(fr); }
    }
}

__device__ __forceinline__ void p1_xn(Frame& F) {
    int lane_ = F.lane; asm volatile("" : "+v"(lane_));
    const int gw = F.vcu * NWAVES + F.wave, NGW = F.G * NWAVES, lane = lane_;
    const long long* mod = (const long long*)((const unsigned*)(F.ws + WS_CTL) + CW_MOD); const float* g = F.in[I_GPRE1]; bf16* xn = (bf16*)(F.ws + WS_R1);
    { float* modf = (float*)(F.ws + WS_CTL) + CW_MODF; for (int i = gw * 64 + lane; i < 4 * 6144; i += NGW * 64) modf[i] = fx_get(mod + i, 1.0 / MOD_FX); }
    for (int row0 = gw; row0 < T; row0 += 2 * NGW) {
        f32x4 v[2][4]; float s[2] = {0.f, 0.f};
#pragma unroll
        for (int q = 0; q < 2; ++q) { const f32x4* xr = (const f32x4*)(F.in[I_X] + (size_t)(row0 + q * NGW) * D) + lane;
#pragma unroll
            for (int j = 0; j < 4; ++j) v[q][j] = xr[64 * j]; }
#pragma unroll
        for (int q = 0; q < 2; ++q)
#pragma unroll
            for (int j = 0; j < 4; ++j) s[q] += (v[q][j].x * v[q][j].x + v[q][j].y * v[q][j].y) + (v[q][j].z * v[q][j].z + v[q][j].w * v[q][j].w);
#pragma unroll
        for (int q = 0; q < 2; ++q) { const int row = row0 + q * NGW; const long long* mb = mod + (row / SEQ) * 6144;
            const float rstd = rsqrtf(wave_sum(s[q]) * (1.f / D) + RMS_EPS);
#pragma unroll
            for (int j = 0; j < 4; ++j) { const int col = 4 * lane + 256 * j;
                const f32x4 gg = *(const f32x4*)(g + col); f32x4 sh, sc;
#pragma unroll
                for (int i = 0; i < 4; ++i) { sh[i] = fx_get(mb + col + i, 1.0 / MOD_FX); sc[i] = fx_get(mb + 1024 + col + i, 1.0 / MOD_FX); }
                const f32x4 o = v[q][j] * rstd * gg * (sc + 1.0f) + sh;
                u32x2 w; w.x = cvtpk(o.x, o.y); w.y = cvtpk(o.z, o.w); *(u32x2*)(xn + (size_t)row * D + col) = w; } }
    }
}
template <int W> __device__ __forceinline__ void pool_item(const bf16* P, bf16* PI, int t0, int ch) {
    const int s0 = t0 & (SEQ - 1);
    u32x4 raw[W + 7];
#pragma unroll
    for (int i = 0; i < W + 7; ++i) { const int dt = i - (W - 1); raw[i] = (s0 + dt >= 0) ? *(const u32x4*)(P + (size_t)(t0 + dt) * PROJ_N + ch) : (u32x4){0u, 0u, 0u, 0u}; }
    f32x4 a0 = {0, 0, 0, 0}, a1 = a0;
#pragma unroll
    for (int i = 0; i < W - 1; ++i) { f32x4 y0, y1; unpack8(raw[i], y0, y1); a0 += y0; a1 += y1; }
#pragma unroll
    for (int k = 0; k < 8; ++k) {
        f32x4 x0, x1; unpack8(raw[W - 1 + k], x0, x1); a0 += x0; a1 += x1;
        const int s = s0 + k; const float ic = 1.0f / (float)((s + 1 < W) ? s + 1 : W);
        *(u32x4*)(PI + (size_t)(t0 + k) * 512 + ch) = pack8(a0 * ic - x0, a1 * ic - x1);
        f32x4 o0, o1; unpack8(raw[k], o0, o1); a0 -= o0; a1 -= o1;
    }
}
__device__ __forceinline__ void p3_pool(Frame& F) {
    const bf16* P = (const bf16*)(F.ws + WS_R2); bf16* PI = (bf16*)(F.ws + WS_PIN);
    int tid_ = F.tid; asm volatile("" : "+v"(tid_));
    const int gt = (F.vcu * NWAVES * 64) + tid_, NGT = F.G * NWAVES * 64;
    for (int i = gt; i < (T / 8) * 64; i += NGT) {
        const int cg = i & 63, t0 = (i >> 6) * 8, ch = cg * 8, g = cg >> 4;
        if (g == 0) pool_item<2>(P, PI, t0, ch); else if (g == 1) pool_item<4>(P, PI, t0, ch); else if (g == 2) pool_item<8>(P, PI, t0, ch); else pool_item<16>(P, PI, t0, ch);
    }
}
__device__ __forceinline__ void p7_rows(Frame& F) {
    int lane_ = F.lane; asm volatile("" : "+v"(lane_));
    const int gw = F.vcu * NWAVES + F.wave, NGW = F.G * NWAVES, lane = lane_;
    const float* mod = (const float*)(F.ws + WS_CTL) + CW_MODF; const bf16* Z = (const bf16*)(F.ws + WS_R2); bf16* xn = (bf16*)(F.ws + WS_R1);
    const float* gp1 = F.in[I_GPOST1]; const float* gp2 = F.in[I_GPRE2];
    for (int row0 = gw; row0 < T; row0 += 2 * NGW) {
        f32x4 z[2][4], h[2][4], xv[2][4]; float s[2] = {0.f, 0.f}, s2[2] = {0.f, 0.f};
#pragma unroll
        for (int q = 0; q < 2; ++q) { const int row = row0 + q * NGW;
#pragma unroll
            for (int j = 0; j < 4; ++j) { const u32x2 w = *(const u32x2*)(Z + (size_t)row * D + 4 * lane + 256 * j); z[q][j] = (f32x4){bflo(w.x), bfhi(w.x), bflo(w.y), bfhi(w.y)};
                xv[q][j] = *(const f32x4*)(F.in[I_X] + (size_t)row * D + 4 * lane + 256 * j); } }
#pragma unroll
        for (int q = 0; q < 2; ++q)
#pragma unroll
            for (int j = 0; j < 4; ++j) s[q] += (z[q][j].x * z[q][j].x + z[q][j].y * z[q][j].y) + (z[q][j].z * z[q][j].z + z[q][j].w * z[q][j].w);
#pragma unroll
        for (int q = 0; q < 2; ++q) { const int row = row0 + q * NGW; const float* mb = mod + (row / SEQ) * 6144;
            const float rz = rsqrtf(wave_sum(s[q]) * (1.f / D) + RMS_EPS);
#pragma unroll
            for (int j = 0; j < 4; ++j) { const int col = 4 * lane + 256 * j;
                const f32x4 g1 = *(const f32x4*)(mb + 2048 + col), gg = *(const f32x4*)(gp1 + col);
                h[q][j] = xv[q][j] + g1 * (z[q][j] * rz * gg); *(f32x4*)(F.out + (size_t)row * D + col) = h[q][j];
                s2[q] += (h[q][j].x * h[q][j].x + h[q][j].y * h[q][j].y) + (h[q][j].z * h[q][j].z + h[q][j].w * h[q][j].w); } }
#pragma unroll
        for (int q = 0; q < 2; ++q) { const int row = row0 + q * NGW; const float* mb = mod + (row / SEQ) * 6144;
            const float rh = rsqrtf(wave_sum(s2[q]) * (1.f / D) + RMS_EPS);
#pragma unroll
            for (int j = 0; j < 4; ++j) { const int col = 4 * lane + 256 * j;
                const f32x4 gg = *(const f32x4*)(gp2 + col), sh = *(const f32x4*)(mb + 3072 + col), sc = *(const f32x4*)(mb + 4096 + col);
                const f32x4 o = h[q][j] * rh * gg * (sc + 1.0f) + sh;
                u32x2 w; w.x = cvtpk(o.x, o.y); w.y = cvtpk(o.z, o.w); *(u32x2*)(xn + (size_t)row * D + col) = w; } }
    }
}

constexpr int ATT_KP = 208, ATT_VP = 272, ATT_KB = 128 * ATT_KP, ATT_VB = 64 * ATT_VP;
constexpr float ATT_THR = 8.0f;
__device__ __forceinline__ void attn_unit(int b, int h, int qb, const bf16* Qb, const bf16* Kb, const bf16* Vt, bf16* O, LAS unsigned char* lds) {
    int tid_ = threadIdx.x; asm volatile("" : "+v"(tid_));
    const int tid = tid_, lane = tid & 63, r32 = lane & 31, hi = lane >> 5; const int wid = __builtin_amdgcn_readfirstlane(tid >> 6);
    const int q0 = qb * 256, tok0 = b * SEQ, NT = (q0 + 256) / 128;
    const bf16* kg[3]; int kl[3];
#pragma unroll
    for (int i = 0; i < 3; ++i) { const int c = tid + 512 * i, kr = c / 12, kc = c % 12; kg[i] = Kb + (size_t)(tok0 + kr) * 768 + h * QKD + kc * 8; kl[i] = kr * ATT_KP + kc * 16; }
    const bf16* vg[2]; int vl[2];
#pragma unroll
    for (int i = 0; i < 2; ++i) { const int c = tid + 512 * i, vd = c >> 4, vc = c & 15; vg[i] = Vt + (size_t)(h * VD + vd) * T + tok0 + vc * 8; vl[i] = 2 * ATT_KB + vd * ATT_VP + vc * 16; }
    const int qrow = tok0 + q0 + wid * 32 + r32; const int qpos = q0 + wid * 32 + r32;
    bf16x8 qf[6];
#pragma unroll
    for (int s = 0; s < 6; ++s) qf[s] = *(const bf16x8*)(Qb + (size_t)qrow * 768 + h * QKD + 16 * s + 8 * hi);
    const int krow = (r32 & ~12) | ((r32 & 4) << 1) | ((r32 & 8) >> 1);
    const int ka = krow * ATT_KP + hi * 16, va = 2 * ATT_KB + r32 * ATT_VP + hi * 16;
    f32x16 o0 = {}, o1 = {}, negm = {}; float mhat = 0.f, lrun = 0.f; bool first = true;
    u32x4 kx[3], vx[2];
#pragma unroll
    for (int i = 0; i < 3; ++i) kx[i] = *(const u32x4*)kg[i];
#pragma unroll
    for (int i = 0; i < 2; ++i) vx[i] = *(const u32x4*)vg[i];
#pragma unroll
    for (int i = 0; i < 3; ++i) *(LAS u32x4*)(lds + kl[i]) = kx[i];
#pragma unroll
    for (int i = 0; i < 2; ++i) *(LAS u32x4*)(lds + vl[i]) = vx[i];
    __syncthreads();
    for (int t = 0; t < NT; ++t) {
        const int cb = t & 1, nb = cb ^ 1;
        const bool more = t + 1 < NT;
        if (more) {
#pragma unroll
            for (int i = 0; i < 3; ++i) kx[i] = *(const u32x4*)(kg[i] + (size_t)(t + 1) * 128 * 768);
#pragma unroll
            for (int i = 0; i < 2; ++i) vx[i] = *(const u32x4*)(vg[i] + (t + 1) * 128); }
#pragma unroll
        for (int h2 = 0; h2 < 2; ++h2) {
            const int kv0 = t * 128 + h2 * 64;
            if (kv0 <= q0 + wid * 32 + 31) {
                f32x16 p0 = negm, p1 = negm;
                const LAS unsigned char* kb = lds + cb * ATT_KB + h2 * 64 * ATT_KP + ka;
#pragma unroll
                for (int s = 0; s < 6; ++s) {
                    const bf16x8 a0 = *(const LAS bf16x8*)(kb + s * 32), a1 = *(const LAS bf16x8*)(kb + 32 * ATT_KP + s * 32);
                    p0 = __builtin_amdgcn_mfma_f32_32x32x16_bf16(a0, qf[s], p0, 0, 0, 0);
                    p1 = __builtin_amdgcn_mfma_f32_32x32x16_bf16(a1, qf[s], p1, 0, 0, 0);
                }
                if (kv0 + 63 > q0 + wid * 32) {
#pragma unroll
                    for (int r = 0; r < 16; ++r) { const int kv = kv0 + (r & 7) + 8 * hi + 16 * (r >> 3); if (kv > qpos) p0[r] = -INFINITY; if (kv + 32 > qpos) p1[r] = -INFINITY; }
                }
                float mx = fmaxf(fmaxf(p0[0], p1[0]), fmaxf(p0[1], p1[1]));
#pragma unroll
                for (int r = 2; r < 16; r += 2) mx = fmaxf(mx, fmaxf(fmaxf(p0[r], p1[r]), fmaxf(p0[r + 1], p1[r + 1])));
                mx = fmaxf(mx, __shfl_xor(mx, 32));
                if (first || __any(mx > ATT_THR)) {
                    const float dl = first ? mx : fmaxf(mx, 0.f); mhat += dl;
                    const float f = first ? 1.0f : __builtin_amdgcn_exp2f(-dl); first = false;
#pragma unroll
                    for (int r = 0; r < 16; ++r) { p0[r] -= dl; p1[r] -= dl; negm[r] = -mhat; o0[r] *= f; o1[r] *= f; }
                    lrun *= f;
                }
                float ls = 0.f;
#pragma unroll
                for (int r = 0; r < 16; ++r) { p0[r] = __builtin_amdgcn_exp2f(p0[r]); p1[r] = __builtin_amdgcn_exp2f(p1[r]); ls += p0[r] + p1[r]; }
                lrun += ls;
                u32x4 pb[4];
                pb[0] = (u32x4){cvtpk(p0[0], p0[1]), cvtpk(p0[2], p0[3]), cvtpk(p0[4], p0[5]), cvtpk(p0[6], p0[7])};
                pb[1] = (u32x4){cvtpk(p0[8], p0[9]), cvtpk(p0[10], p0[11]), cvtpk(p0[12], p0[13]), cvtpk(p0[14], p0[15])};
                pb[2] = (u32x4){cvtpk(p1[0], p1[1]), cvtpk(p1[2], p1[3]), cvtpk(p1[4], p1[5]), cvtpk(p1[6], p1[7])};
                pb[3] = (u32x4){cvtpk(p1[8], p1[9]), cvtpk(p1[10], p1[11]), cvtpk(p1[12], p1[13]), cvtpk(p1[14], p1[15])};
                const LAS unsigned char* vb = lds + cb * ATT_VB + h2 * 128 + va;
#pragma unroll
                for (int ks = 0; ks < 4; ++ks) {
                    const bf16x8 a0 = *(const LAS bf16x8*)(vb + ks * 32), a1 = *(const LAS bf16x8*)(vb + 32 * ATT_VP + ks * 32);
                    const bf16x8 pbv = __builtin_bit_cast(bf16x8, pb[ks]);
                    o0 = __builtin_amdgcn_mfma_f32_32x32x16_bf16(a0, pbv, o0, 0, 0, 0);
                    o1 = __builtin_amdgcn_mfma_f32_32x32x16_bf16(a1, pbv, o1, 0, 0, 0);
                }
            }
        }
        if (more) {
#pragma unroll
            for (int i = 0; i < 3; ++i) *(LAS u32x4*)(lds + nb * ATT_KB + kl[i]) = kx[i];
#pragma unroll
            for (int i = 0; i < 2; ++i) *(LAS u32x4*)(lds + nb * ATT_VB + vl[i]) = vx[i]; }
        __syncthreads();
    }
    const float lt = lrun + __shfl_xor(lrun, 32); const float il = 1.0f / lt;
    bf16* op = O + (size_t)qrow * 512 + h * VD;
#pragma unroll
    for (int rg = 0; rg < 4; ++rg) {
        u32x2 w0, w1; w0.x = cvtpk(o0[4 * rg] * il, o0[4 * rg + 1] * il); w0.y = cvtpk(o0[4 * rg + 2] * il, o0[4 * rg + 3] * il);
        w1.x = cvtpk(o1[4 * rg] * il, o1[4 * rg + 1] * il); w1.y = cvtpk(o1[4 * rg + 2] * il, o1[4 * rg + 3] * il);
        *(u32x2*)(op + 8 * rg + 4 * hi) = w0; *(u32x2*)(op + 32 + 8 * rg + 4 * hi) = w1;
    }
}
__device__ __forceinline__ void p4_attention(Frame& F) {
    const bf16* Qb = (const bf16*)(F.ws + WS_R1); const bf16* Kb = (const bf16*)(F.ws + WS_KB); const bf16* Vt = (const bf16*)(F.ws + WS_VT); bf16* O = (bf16*)(F.ws + WS_AO);
    for (int p = F.vcu; p < 256; p += F.G) {
        const int bh = p >> 3, s = p & 7;
        attn_unit(bh >> 3, bh & 7, 15 - s, Qb, Kb, Vt, O, F.lds);
        attn_unit(bh >> 3, bh & 7, s, Qb, Kb, Vt, O, F.lds);
    }
}

__device__ __forceinline__ int mono(float x) { const int b = __float_as_int(x); return b ^ ((b >> 31) & 0x7fffffff); }
__device__ __forceinline__ float unmono(int k) { return __int_as_float(k ^ ((k >> 31) & 0x7fffffff)); }
#define TK_INS(L, xx) do { int _x = (xx); _Pragma("unroll") for (int _i = 0; _i < 16; ++_i) { const int _t = max(L[_i], _x); _x = min(L[_i], _x); L[_i] = _t; } } while (0)
__device__ __forceinline__ void sort16_desc(int (&v)[16]) {
#pragma unroll
    for (int k = 2; k <= 16; k <<= 1)
#pragma unroll
        for (int j = k >> 1; j > 0; j >>= 1)
#pragma unroll
            for (int i = 0; i < 16; ++i) { const int l = i ^ j; if (l > i) { const int hi_ = max(v[i], v[l]), lo_ = min(v[i], v[l]); const bool desc = (i & k) == 0; v[i] = desc ? hi_ : lo_; v[l] = desc ? lo_ : hi_; } }
}
__device__ __forceinline__ void merge16_desc(int (&top)[16], const int (&b)[16]) {
#pragma unroll
    for (int i = 0; i < 16; ++i) top[i] = max(top[i], b[15 - i]);
#pragma unroll
    for (int j = 8; j > 0; j >>= 1)
#pragma unroll
        for (int i = 0; i < 16; ++i) { const int l = i ^ j; if (l > i) { const int hi_ = max(top[i], top[l]), lo_ = min(top[i], top[l]); top[i] = hi_; top[l] = lo_; } }
}
__device__ __forceinline__ void peer_side(const bf16* qp, const bf16* sk, int r32, int hi, int (&L)[16]) {
    bf16x8 qf[8];
#pragma unroll
    for (int s = 0; s < 8; ++s) qf[s] = *(const bf16x8*)(qp + 16 * s + 8 * hi);
#pragma unroll
    for (int kt = 0; kt < 4; ++kt) {
        f32x16 acc = {};
#pragma unroll
        for (int s = 0; s < 8; ++s) { const bf16x8 a = *(const bf16x8*)(sk + (size_t)(32 * kt + r32) * 128 + 16 * s + 8 * hi); acc = __builtin_amdgcn_mfma_f32_32x32x16_bf16(a, qf[s], acc, 0, 0, 0); }
        int tv[16];
#pragma unroll
        for (int r = 0; r < 16; ++r) { const int key = 32 * kt + (r & 3) + 8 * (r >> 2); tv[r] = (mono(acc[r]) & ~127) | (127 - key); }
        sort16_desc(tv);
        if (kt == 0) {
#pragma unroll
            for (int i = 0; i < 16; ++i) L[i] = tv[i];
        } else merge16_desc(L, tv);
        asm volatile("" ::: "memory");
    }
    int Oth[16];
#pragma unroll
    for (int i = 0; i < 16; ++i) { L[i] ^= (hi << 2); Oth[i] = __shfl_xor(L[i], 32); }
    merge16_desc(L, Oth);
}
__device__ __forceinline__ void p9_peer_topk(Frame& F) {
    const bf16* QP = (const bf16*)(F.ws + WS_R2); const bf16* SK = (const bf16*)(F.ws + WS_SK);
    int* eidx = (int*)(F.ws + WS_EIDX); float* gate = (float*)(F.ws + WS_GATE);
    int lane_ = F.lane; asm volatile("" : "+v"(lane_));
    const int gw = F.vcu * NWAVES + F.wave, NGW = F.G * NWAVES, lane = lane_, r32 = lane & 31, hi = lane >> 5;
    LAS int* tab = (LAS int*)(F.lds + F.wave * 8192);
    for (int it = gw; it < (T / 32) * PEER_H; it += NGW) {
        const int h = it & 7, tb = it >> 3; const int tok = tb * 32 + r32;
        int L1[16], L2[16], L3[16];
        peer_side(QP + (size_t)tok * 2048 + h * 256, SK + (size_t)h * 16384, r32, hi, L1);
        peer_side(QP + (size_t)tok * 2048 + h * 256 + 128, SK + 131072 + (size_t)h * 16384, r32, hi, L2);
        float v1[16], v2[16];
#pragma unroll
        for (int i = 0; i < 16; ++i) { v1[i] = unmono(L1[i] & ~127); v2[i] = unmono(L2[i] & ~127); tab[i * 64 + lane] = 127 - (L1[i] & 127); tab[(16 + i) * 64 + lane] = 127 - (L2[i] & 127); L3[i] = (int)0x80000000; }
#define CAND(a, b) ((mono(v1[a] + v2[b]) & ~255) | (255 - ((a) * 16 + (b))))
        {
#pragma unroll
            for (int b = 0; b < 16; ++b) L3[b] = CAND(0, b);
            int gB[16] = {CAND(1, 0), CAND(1, 1), CAND(1, 2), CAND(1, 3), CAND(1, 4), CAND(1, 5), CAND(1, 6), CAND(1, 7), CAND(2, 0), CAND(2, 1), CAND(2, 2), CAND(2, 3), CAND(2, 4), CAND(4, 0), CAND(4, 1), CAND(4, 2)};
            sort16_desc(gB); merge16_desc(L3, gB);
            int gC[16] = {CAND(3, 0), CAND(3, 1), CAND(3, 2), CAND(3, 3), CAND(5, 0), CAND(5, 1), CAND(6, 0), CAND(6, 1), CAND(7, 0), CAND(7, 1), CAND(8, 0), CAND(9, 0), CAND(10, 0), CAND(11, 0), CAND(12, 0), CAND(13, 0)};
            sort16_desc(gC); merge16_desc(L3, gC);
            TK_INS(L3, CAND(14, 0)); TK_INS(L3, CAND(15, 0));
        }
#undef CAND
        float sc[16], ssum = 0.f; int ei[16];
#pragma unroll
        for (int k = 0; k < 16; ++k) { const int ci = 255 - (L3[k] & 255); sc[k] = unmono(L3[k] & ~255);
            ei[k] = tab[(ci >> 4) * 64 + lane] * 128 + tab[(16 + (ci & 15)) * 64 + lane]; }
        const float smax = sc[0];
#pragma unroll
        for (int k = 0; k < 16; ++k) { sc[k] = __builtin_amdgcn_exp2f((sc[k] - smax) * 1.4426950408889634f); ssum += sc[k]; }
        const float inv = 1.0f / ssum;
        const size_t ob = ((size_t)tok * PEER_H + h) * PEER_K;
        if (hi == 0) {
#pragma unroll
            for (int k = 0; k < 16; k += 4) *(u32x4*)(eidx + ob + k) = (u32x4){(unsigned)ei[k], (unsigned)ei[k + 1], (unsigned)ei[k + 2], (unsigned)ei[k + 3]};
        } else {
#pragma unroll
            for (int k = 0; k < 16; k += 4) *(f32x4*)(gate + ob + k) = (f32x4){sc[k] * inv, sc[k + 1] * inv, sc[k + 2] * inv, sc[k + 3] * inv};
        }
        LDS_WAIT();
    }
}
__device__ __forceinline__ void cvt_experts(Frame& F) {
    int lane_ = F.lane; asm volatile("" : "+v"(lane_));
    const int gw = F.vcu * NWAVES + F.wave, NGW = F.G * NWAVES, lane = lane_;
    float* esc = (float*)(F.ws + WS_ESC);
    for (int r0 = gw * 4; r0 < 2 * 16384; r0 += NGW * 4) {
        f32x4 v[4][4]; float am[4];
#pragma unroll
        for (int q = 0; q < 4; ++q) { const int row = r0 + q; const float* src = F.in[row < 16384 ? I_EU : I_EV] + (size_t)(row & 16383) * D + 16 * lane;
#pragma unroll
            for (int c = 0; c < 4; ++c) v[q][c] = *(const f32x4*)(src + 4 * c); }
#pragma unroll
        for (int q = 0; q < 4; ++q) { float m = 0.f;
#pragma unroll
            for (int c = 0; c < 4; ++c) m = fmaxf(m, fmaxf(fmaxf(fabsf(v[q][c][0]), fabsf(v[q][c][1])), fmaxf(fabsf(v[q][c][2]), fabsf(v[q][c][3]))));
            am[q] = m; }
#pragma unroll
        for (int o = 1; o < 64; o <<= 1)
#pragma unroll
            for (int q = 0; q < 4; ++q) am[q] = fmaxf(am[q], __shfl_xor(am[q], o));
#pragma unroll
        for (int q = 0; q < 4; ++q) { const int row = r0 + q; const float sc = am[q] > 0.f ? 6.5f / am[q] : 1.0f;
            unsigned w0 = 0u, w1 = 0u;
            w0 = __builtin_amdgcn_cvt_scalef32_pk_fp4_f32(w0, v[q][0][0] * sc, v[q][0][1] * sc, 1.0f, 0); w0 = __builtin_amdgcn_cvt_scalef32_pk_fp4_f32(w0, v[q][0][2] * sc, v[q][0][3] * sc, 1.0f, 1);
            w0 = __builtin_amdgcn_cvt_scalef32_pk_fp4_f32(w0, v[q][1][0] * sc, v[q][1][1] * sc, 1.0f, 2); w0 = __builtin_amdgcn_cvt_scalef32_pk_fp4_f32(w0, v[q][1][2] * sc, v[q][1][3] * sc, 1.0f, 3);
            w1 = __builtin_amdgcn_cvt_scalef32_pk_fp4_f32(w1, v[q][2][0] * sc, v[q][2][1] * sc, 1.0f, 0); w1 = __builtin_amdgcn_cvt_scalef32_pk_fp4_f32(w1, v[q][2][2] * sc, v[q][2][3] * sc, 1.0f, 1);
            w1 = __builtin_amdgcn_cvt_scalef32_pk_fp4_f32(w1, v[q][3][0] * sc, v[q][3][1] * sc, 1.0f, 2); w1 = __builtin_amdgcn_cvt_scalef32_pk_fp4_f32(w1, v[q][3][2] * sc, v[q][3][3] * sc, 1.0f, 3);
            unsigned char* dst = F.ws + (row < 16384 ? WS_EU : WS_EV) + (size_t)(row & 16383) * 512 + 8 * lane;
            *(u32x2*)dst = (u32x2){w0, w1};
            if (lane == 0) esc[row] = am[q] > 0.f ? am[q] * (1.0f / 6.5f) : 1.0f; }
    }
}

#define FMAC_V(acc, a, b) asm("v_fmac_f32_e32 %0, %1, %2" : "+v"(acc) : "v"(a), "v"(b))
#define FMAC_S(acc, ws, b) asm("v_fmac_f32_e32 %0, %1, %2" : "+v"(acc) : "s"(ws), "v"(b))
#define CVT4(w, sel) __builtin_amdgcn_cvt_scalef32_pk_f32_fp4((w), 1.0f, (sel))
__device__ __forceinline__ float dot16_fp4(u32x2 r, const float (&x)[16]) {
    float a = 0.f, b = 0.f; f32x2 t;
    t = CVT4(r.x, 0); FMAC_V(a, t.x, x[0]);  FMAC_V(b, t.y, x[1]);
    t = CVT4(r.x, 1); FMAC_V(a, t.x, x[2]);  FMAC_V(b, t.y, x[3]);
    t = CVT4(r.x, 2); FMAC_V(a, t.x, x[4]);  FMAC_V(b, t.y, x[5]);
    t = CVT4(r.x, 3); FMAC_V(a, t.x, x[6]);  FMAC_V(b, t.y, x[7]);
    t = CVT4(r.y, 0); FMAC_V(a, t.x, x[8]);  FMAC_V(b, t.y, x[9]);
    t = CVT4(r.y, 1); FMAC_V(a, t.x, x[10]); FMAC_V(b, t.y, x[11]);
    t = CVT4(r.y, 2); FMAC_V(a, t.x, x[12]); FMAC_V(b, t.y, x[13]);
    t = CVT4(r.y, 3); FMAC_V(a, t.x, x[14]); FMAC_V(b, t.y, x[15]);
    return a + b;
}
__device__ __forceinline__ void axpy16_fp4(float (&y)[16], float w, u32x2 r) {
    f32x2 t;
    t = CVT4(r.x, 0); FMAC_S(y[0], w, t.x);  FMAC_S(y[1], w, t.y);
    t = CVT4(r.x, 1); FMAC_S(y[2], w, t.x);  FMAC_S(y[3], w, t.y);
    t = CVT4(r.x, 2); FMAC_S(y[4], w, t.x);  FMAC_S(y[5], w, t.y);
    t = CVT4(r.x, 3); FMAC_S(y[6], w, t.x);  FMAC_S(y[7], w, t.y);
    t = CVT4(r.y, 0); FMAC_S(y[8], w, t.x);  FMAC_S(y[9], w, t.y);
    t = CVT4(r.y, 1); FMAC_S(y[10], w, t.x); FMAC_S(y[11], w, t.y);
    t = CVT4(r.y, 2); FMAC_S(y[12], w, t.x); FMAC_S(y[13], w, t.y);
    t = CVT4(r.y, 3); FMAC_S(y[14], w, t.x); FMAC_S(y[15], w, t.y);
}
__device__ __forceinline__ void sort128(int& k0, int& k1, int lane) {
#pragma unroll
    for (int k = 2; k <= 128; k <<= 1) {
#pragma unroll
        for (int j = k >> 1; j > 0; j >>= 1) {
            if (j == 64) { const int lo = min(k0, k1), hi = max(k0, k1); k0 = lo; k1 = hi; }
            else {
                const bool lower = (lane & j) == 0;
                const int p0 = __shfl_xor(k0, j), p1 = __shfl_xor(k1, j);
                const bool up0 = (k == 128) ? true : (k == 64) ? true : ((lane & k) == 0);
                const bool up1 = (k == 128) ? true : (k == 64) ? false : ((lane & k) == 0);
                k0 = (lower == up0) ? min(k0, p0) : max(k0, p0);
                k1 = (lower == up1) ? min(k1, p1) : max(k1, p1);
            }
        }
    }
}
typedef int i32x4 __attribute__((ext_vector_type(4)));
__device__ __forceinline__ u32x2 row_load(__amdgpu_buffer_rsrc_t rsrc, int lane8, int e) { return __builtin_bit_cast(u32x2, __builtin_amdgcn_raw_buffer_load_b64(rsrc, lane8, e << 9, 0)); }
template <bool DRY> __device__ __forceinline__ void p10_peer_experts(Frame& F) {
    int lane_ = F.lane; asm volatile("" : "+v"(lane_));
    const int gw = F.vcu * NWAVES + F.wave, NGW = F.G * NWAVES, lane = lane_, lane16 = lane * 8;
    const bf16* XN = (const bf16*)(F.ws + WS_R1);
    const __amdgpu_buffer_rsrc_t ru = __builtin_amdgcn_make_buffer_rsrc((void*)(F.ws + WS_EU), 0, 16384 * 512, 0x00020000), rv = __builtin_amdgcn_make_buffer_rsrc((void*)(F.ws + WS_EV), 0, 16384 * 512, 0x00020000);
    const float* esc = (const float*)(F.ws + WS_ESC);
    const int* eidx = (const int*)(F.ws + WS_EIDX); const float* gate = (const float*)(F.ws + WS_GATE);
    const float* mod = (const float*)(F.ws + WS_CTL) + CW_MODF; const float* gp = F.in[I_GPOST2];
    const int b5 = (lane >> 5) & 1, b4 = (lane >> 4) & 1, b3 = (lane >> 3) & 1, b2 = (lane >> 2) & 1;
    const int eloc = b5 * 8 + b4 * 4 + b3 * 2 + b2;
    for (int tok = gw; tok < T; tok += NGW) {
        float x[16];
        { const u32x4 xa = *(const u32x4*)(XN + (size_t)tok * D + 16 * lane), xb = *(const u32x4*)(XN + (size_t)tok * D + 16 * lane + 8);
          x[0] = bflo(xa.x); x[1] = bfhi(xa.x); x[2] = bflo(xa.y); x[3] = bfhi(xa.y); x[4] = bflo(xa.z); x[5] = bfhi(xa.z); x[6] = bflo(xa.w); x[7] = bfhi(xa.w);
          x[8] = bflo(xb.x); x[9] = bfhi(xb.x); x[10] = bflo(xb.y); x[11] = bfhi(xb.y); x[12] = bflo(xb.z); x[13] = bfhi(xb.z); x[14] = bflo(xb.w); x[15] = bfhi(xb.w); }
        int k0 = (eidx[(size_t)tok * 128 + lane] << 7) | lane, k1 = (eidx[(size_t)tok * 128 + 64 + lane] << 7) | (64 + lane);
        sort128(k0, k1, lane);
        float y[16];
#pragma unroll
        for (int i = 0; i < 16; ++i) y[i] = 0.f;
        u32x2 U[16], V[16];
#pragma unroll
        for (int j = 0; j < 16; ++j) U[j] = row_load(ru, lane16, __builtin_amdgcn_readlane(k0, j) >> 7);
        for (int kb = 0; kb < 8; ++kb) {
            const int kv = kb < 4 ? k0 : k1; const int lb = (kb & 3) * 16;
#pragma unroll
            for (int j = 0; j < 16; ++j) V[j] = row_load(rv, lane16, __builtin_amdgcn_readlane(kv, lb + j) >> 7);
            __builtin_amdgcn_sched_barrier(0);
            float p[16];
#pragma unroll
            for (int j = 0; j < 16; ++j) p[j] = dot16_fp4(U[j], x);
            float q[8], r4[4], s2[2], tt;
#pragma unroll
            for (int j = 0; j < 8; ++j) { const float keep = b5 ? p[j + 8] : p[j], send = b5 ? p[j] : p[j + 8]; q[j] = keep + __shfl_xor(send, 32); }
#pragma unroll
            for (int j = 0; j < 4; ++j) { const float keep = b4 ? q[j + 4] : q[j], send = b4 ? q[j] : q[j + 4]; r4[j] = keep + __shfl_xor(send, 16); }
#pragma unroll
            for (int j = 0; j < 2; ++j) { const float keep = b3 ? r4[j + 2] : r4[j], send = b3 ? r4[j] : r4[j + 2]; s2[j] = keep + __shfl_xor(send, 8); }
            { const float keep = b2 ? s2[1] : s2[0], send = b2 ? s2[0] : s2[1]; tt = keep + __shfl_xor(send, 4); }
            tt += __shfl_xor(tt, 2); tt += __shfl_xor(tt, 1);
            const int mykey = __shfl(kv, lb + eloc); const int pidx = mykey & 127, myexp = mykey >> 7;
            tt *= esc[myexp];
            const float g = gate[(size_t)tok * 128 + pidx] * esc[16384 + myexp];
            const float u3 = 0.7978845608028654f * (tt + 0.044715f * tt * tt * tt);
            const float w = g * tt * sigmoidf_(2.0f * u3);
            if (kb < 7) { const int kn = (kb + 1) < 4 ? k0 : k1; const int ln = ((kb + 1) & 3) * 16;
#pragma unroll
                for (int j = 0; j < 16; ++j) U[j] = row_load(ru, lane16, __builtin_amdgcn_readlane(kn, ln + j) >> 7); }
            __builtin_amdgcn_sched_barrier(0);
#pragma unroll
            for (int j = 0; j < 16; ++j) {
                const int sl = ((j >> 3) & 1) * 32 + ((j >> 2) & 1) * 16 + ((j >> 1) & 1) * 8 + (j & 1) * 4;
                const float wj = __int_as_float(__builtin_amdgcn_readlane(__float_as_int(w), sl));
                axpy16_fp4(y, wj, V[j]); }
        }
        float ss = 0.f;
#pragma unroll
        for (int i = 0; i < 16; ++i) ss += y[i] * y[i];
        const float rstd = rsqrtf(wave_sum(ss) * (1.f / D) + RMS_EPS);
        const float* mb = mod + (tok / SEQ) * 6144 + 5 * 1024; float* orow = DRY ? (float*)(F.ws + WS_AO) + (size_t)(tok & 1023) * D : F.out + (size_t)tok * D;
#pragma unroll
        for (int c = 0; c < 4; ++c) { const int col = 16 * lane + 4 * c;
            const f32x4 yy = {y[4 * c], y[4 * c + 1], y[4 * c + 2], y[4 * c + 3]};
            const f32x4 h0 = *(const f32x4*)(orow + col), g0 = *(const f32x4*)(mb + col), p0 = *(const f32x4*)(gp + col);
            *(f32x4*)(orow + col) = h0 + g0 * (yy * rstd * p0); }
    }
}

__device__ __forceinline__ void p9_bruteforce(Frame& F) {
    const bf16* QP = (const bf16*)(F.ws + WS_R2);
    int* eidx = (int*)(F.ws + WS_EIDX); float* gate = (float*)(F.ws + WS_GATE);
    LAS float* sc = (LAS float*)(F.lds);
    (void)sc;
    float* scr = (float*)(F.ws + WS_PIN);
    (void)scr;
    const int gt = (F.vcu * NWAVES * 64) + F.tid, NGT = F.G * NWAVES * 64;
    for (int it = gt; it < T * 8; it += NGT) {
        const int tok = it >> 3, h = it & 7;
        float v[2][16]; int ix[2][16];
        for (int side = 0; side < 2; ++side) {
            const float* K = F.in[side ? I_SK2 : I_SK1] + (size_t)h * 16384;
            const bf16* q = QP + (size_t)tok * 2048 + h * 256 + side * 128;
            float prev = INFINITY; int previ = -1;
            for (int k = 0; k < 16; ++k) {
                float best = -INFINITY; int bi = -1;
                for (int key = 0; key < 128; ++key) {
                    float s = 0.f;
                    for (int d = 0; d < 128; ++d) s += __uint_as_float((unsigned)q[d] << 16) * K[key * 128 + d];
                    const bool after = (s < prev) || (s == prev && key > previ);
                    if (after && (s > best)) { best = s; bi = key; }
                }
                v[side][k] = best; ix[side][k] = bi; prev = best; previ = bi;
            }
        }
        float prev = INFINITY; int previ = -1; float scs[16]; int es[16];
        for (int k = 0; k < 16; ++k) {
            float best = -INFINITY; int bi = -1;
            for (int c = 0; c < 256; ++c) { const float s = v[0][c >> 4] + v[1][c & 15]; const bool after = (s < prev) || (s == prev && c > previ); if (after && s > best) { best = s; bi = c; } }
            scs[k] = best; es[k] = ix[0][bi >> 4] * 128 + ix[1][bi & 15]; prev = best; previ = bi;
        }
        float ssum = 0.f; for (int k = 0; k < 16; ++k) { scs[k] = __expf(scs[k] - scs[0]); ssum += scs[k]; }
        scs[0] = 1.0f;
        for (int k = 0; k < 16; ++k) { eidx[(size_t)it * 16 + k] = es[k]; gate[(size_t)it * 16 + k] = scs[k] / ssum; }
    }
}
__device__ __forceinline__ void p10_bruteforce(Frame& F) {
    const int gw = F.vcu * NWAVES + F.wave, NGW = F.G * NWAVES, lane = F.lane;
    const bf16* XN = (const bf16*)(F.ws + WS_R1); const float* EU = F.in[I_EU]; const float* EV = F.in[I_EV];
    const int* eidx = (const int*)(F.ws + WS_EIDX); const float* gate = (const float*)(F.ws + WS_GATE);
    const float* mod = (const float*)(F.ws + WS_CTL) + CW_MODF; const float* gp = F.in[I_GPOST2];
    for (int tok = gw; tok < T; tok += NGW) {
        float x[16], y[16];
        for (int i = 0; i < 16; ++i) { x[i] = __uint_as_float((unsigned)XN[(size_t)tok * D + lane + 64 * i] << 16); y[i] = 0.f; }
        for (int k = 0; k < 128; ++k) {
            const int e = eidx[(size_t)tok * 128 + k]; const float g = gate[(size_t)tok * 128 + k];
            float p = 0.f;
            for (int i = 0; i < 16; ++i) p += x[i] * EU[(size_t)e * D + lane + 64 * i];
            p = wave_sum(p);
            const float u3 = 0.7978845608028654f * (p + 0.044715f * p * p * p);
            const float w = g * 0.5f * p * (1.0f + tanhf(u3));
            for (int i = 0; i < 16; ++i) y[i] += w * EV[(size_t)e * D + lane + 64 * i];
        }
        float ss = 0.f; for (int i = 0; i < 16; ++i) ss += y[i] * y[i];
        const float rstd = rsqrtf(wave_sum(ss) * (1.f / D) + RMS_EPS);
        const float* mb = mod + (tok / SEQ) * 6144 + 5 * 1024; float* orow = F.out + (size_t)tok * D;
        for (int i = 0; i < 16; ++i) { const int col = lane + 64 * i; orow[col] = orow[col] + mb[col] * (y[i] * rstd * gp[col]); }
    }
}
#ifndef PH_MASK
#define PH_MASK 0xFFFFFFFFu
#endif
#define PH(k) ((PH_MASK >> (k)) & 1u)
__global__ void __launch_bounds__(NWAVES * 64, 2) fwd_megakernel(Args args) {
    extern __shared__ __attribute__((aligned(16))) unsigned char lds_raw[];
    Frame F;
    F.lds = (LAS unsigned char*)lds_raw;
    F.tid = threadIdx.x; F.lane = F.tid & 63; F.wave = __builtin_amdgcn_readfirstlane(F.tid >> 6);
    F.G = gridDim.x; { const int bx = blockIdx.x; F.vcu = (F.G % 8 == 0) ? (bx % 8) * (F.G / 8) + bx / 8 : bx; }
    F.in = args.in; F.out = args.out; F.ws = args.ws;
    unsigned char* ws = args.ws;
    volatile LAS unsigned* MISC = (volatile LAS unsigned*)(F.lds + LDSCTL_OFF);
    for (int u = F.tid; u < 64; u += NWAVES * 64) MISC[u] = 0u;
    __syncthreads();
    XcdBarrier bar = xcd_barrier_post((unsigned*)(ws + WS_CTL) + CW_BAR, MISC + 8);
#define GRID_BAR() xcd_barrier(bar)
    using namespace pg8;
    long long* rsq = (long long*)((unsigned*)(ws + WS_CTL) + CW_RSQ); long long* rsk = (long long*)((unsigned*)(ws + WS_CTL) + CW_RSK); const float* rope = (const float*)(ws + WS_ROPE);
    bf16* PROJ = (bf16*)(ws + WS_R2);
    if (PH(0)) p0_prologue(F); GRID_BAR();
    if (PH(1)) p1_xn(F); GRID_BAR();
    if (PH(2)) { Gemm g{(const bf16*)(ws + WS_R1), (const bf16*)(ws + WS_WIN), T, PROJ_N, 1024, 1024, 1024}; StaticOrder S; S.init(T, PROJ_N, F.G, (int)blockIdx.x);
      EpiProj E{PROJ, (bf16*)(ws + WS_KB), rsq, rsk, rope}; gemm_phase<EpiProj, true>(F.lds, g, S, E); }
    GRID_BAR();
    if (PH(3)) p3_pool(F);
    if (PH(4)) { Gemm g{PROJ + 512, (const bf16*)(ws + WS_WQ), T, 768, 256, PROJ_N, 256}; StaticOrder S; S.init(T, 768, F.G, (int)blockIdx.x);
      EpiQ E{(bf16*)(ws + WS_R1), rsq, rope}; gemm_phase<EpiQ, true>(F.lds, g, S, E); }
    if (PH(5)) { Gemm g{PROJ + 768, (const bf16*)(ws + WS_WK), T, 512, 256, PROJ_N, 256}; StaticOrder S; S.init(T, 512, F.G, (int)blockIdx.x);
      EpiKn E{(bf16*)(ws + WS_KB), rsk}; gemm_phase<EpiKn, true>(F.lds, g, S, E); }
    if (PH(6)) { Gemm g{(const bf16*)(ws + WS_WV), PROJ + 768, 512, T, 256, 256, PROJ_N}; StaticOrder S; S.init(512, T, F.G, (int)blockIdx.x);
      EpiVt E{(bf16*)(ws + WS_VT), rsk}; gemm_phase<EpiVt, true>(F.lds, g, S, E); }
    GRID_BAR();
    if (PH(7)) { Gemm g{(const bf16*)(ws + WS_PIN), (const bf16*)(ws + WS_WG), T, 512, 512, 512, 512}; StaticOrder S; S.init(T, 512, F.G, (int)blockIdx.x);
      EpiPlain E{(bf16*)(ws + WS_PF), 512}; gemm_phase<EpiPlain, true>(F.lds, g, S, E); }
    if (PH(8)) p4_attention(F);
#if defined(DUP_ATT)
    p4_attention(F);
#endif
    GRID_BAR();
    if (PH(9)) { Gemm g{(const bf16*)(ws + WS_PF), (const bf16*)(ws + WS_WPO), T, 1024, 512, 512, 512}; StaticOrder S; S.init(T, 1024, F.G, (int)blockIdx.x);
      EpiGate<0> E{(bf16*)(ws + WS_MRG), PROJ, 1024}; gemm_phase<EpiGate<0>, true>(F.lds, g, S, E); }
    asm volatile("s_waitcnt vmcnt(0)" ::: "memory"); __syncthreads();
    if (PH(10)) { Gemm g{(const bf16*)(ws + WS_AO), (const bf16*)(ws + WS_WMO), T, 1024, 512, 512, 512}; StaticOrder S; S.init(T, 1024, F.G, (int)blockIdx.x);
      EpiGate<1> E{(bf16*)(ws + WS_MRG), PROJ, 2048}; gemm_phase<EpiGate<1>, true>(F.lds, g, S, E); }
    GRID_BAR();
    if (PH(11)) { Gemm g{(const bf16*)(ws + WS_MRG), (const bf16*)(ws + WS_WOUT), T, 1024, 1024, 1024, 1024}; StaticOrder S; S.init(T, 1024, F.G, (int)blockIdx.x);
      EpiPlain E{(bf16*)(ws + WS_R2), 1024}; gemm_phase<EpiPlain, true>(F.lds, g, S, E); }
    GRID_BAR();
    if (PH(12)) p7_rows(F); GRID_BAR();
    if (PH(13)) { Gemm g{(const bf16*)(ws + WS_R1), (const bf16*)(ws + WS_WQY), T, 2048, 1024, 1024, 1024}; StaticOrder S; S.init(T, 2048, F.G, (int)blockIdx.x);
      EpiPlain E{(bf16*)(ws + WS_R2), 2048}; gemm_phase<EpiPlain, true>(F.lds, g, S, E); }
    GRID_BAR();
    if (PH(14)) cvt_experts(F);
#if defined(BF_P9)
    if (PH(15)) p9_bruteforce(F);
#else
    if (PH(15)) p9_peer_topk(F);
#if defined(DUP_TOPK)
    p9_peer_topk(F);
#endif
#endif
    GRID_BAR();
#if defined(BF_P10)
    if (PH(16)) p10_bruteforce(F);
#else
#if defined(DUP_P10)
    p10_peer_experts<true>(F);
#endif
    if (PH(16)) p10_peer_experts<false>(F);
#endif
}

extern "C" void kernel_launch(void* const* d_in, const int* in_sizes, int n_in, void* d_out, int out_size, void* d_ws, size_t ws_size, hipStream_t stream) {
    static int grid = 0;
    if (grid == 0) {
        if (n_in != 23 || out_size != T * D || ws_size < WS_END) { fprintf(stderr, "kernel_launch: unexpected shapes (n_in %d out %d ws %zu)\n", n_in, out_size, ws_size); grid = -1; return; }
        int dev = 0, cus = 0, per_cu = 0;
        if (hipGetDevice(&dev) != hipSuccess || hipDeviceGetAttribute(&cus, hipDeviceAttributeMultiprocessorCount, dev) != hipSuccess) { grid = -1; return; }
        if (hipFuncSetAttribute((const void*)fwd_megakernel, hipFuncAttributeMaxDynamicSharedMemorySize, LDS_BYTES) != hipSuccess) { fprintf(stderr, "kernel_launch: hipFuncSetAttribute failed\n"); grid = -1; return; }
        if (hipOccupancyMaxActiveBlocksPerMultiprocessor(&per_cu, (const void*)fwd_megakernel, NWAVES * 64, LDS_BYTES) != hipSuccess || per_cu < 1) { fprintf(stderr, "kernel_launch: note: occupancy query says %d workgroups per CU\n", per_cu); (void)hipGetLastError(); }
        grid = cus;
    }
    if (grid < 0) return;
    (void)hipMemsetAsync((char*)d_ws + WS_CTL, 0, CTL_ZERO_BYTES, stream);
    Args a{};
    for (int i = 0; i < 23; ++i) a.in[i] = (const float*)d_in[i];
    a.out = (float*)d_out; a.ws = (unsigned char*)d_ws;
    hipLaunchKernelGGL(fwd_megakernel, dim3(grid), dim3(NWAVES * 64), LDS_BYTES, stream, a);
}
```

```cpp
#include <hip/hip_runtime.h>
#include <cstdio>
#include <cstdint>

#ifndef DIAG
#define DIAG 0
#endif
#define LAS __attribute__((address_space(3)))
#define GAS __attribute__((address_space(1)))
typedef unsigned short bf16;
typedef short bf16x8 __attribute__((ext_vector_type(8)));
typedef float f32x4 __attribute__((ext_vector_type(4)));
typedef float f32x2 __attribute__((ext_vector_type(2)));
typedef float f32x16 __attribute__((ext_vector_type(16)));
typedef unsigned u32x4 __attribute__((ext_vector_type(4)));
typedef unsigned u32x2 __attribute__((ext_vector_type(2)));
typedef __bf16 bf16x2_t __attribute__((ext_vector_type(2)));

constexpr int NBATCH = 4, SEQ = 4096, T = NBATCH * SEQ, D = 1024;
constexpr int PROJ_N = 3072;
constexpr int NHEAD = 8, QKD = 96, VD = 64;
constexpr float RMS_EPS = 1e-6f;
constexpr float ATT_C2 = 0.10206207261596577f * 1.4426950408889634f;
constexpr int PEER_H = 8, PEER_K = 16;

constexpr size_t MiB = 1u << 20;
constexpr size_t WS_CTL = 0, CTL_ZERO_BYTES = 1 * MiB;
constexpr size_t WS_WIN = 1 * MiB;
constexpr size_t WS_WQ = 7 * MiB;
constexpr size_t WS_WK = WS_WQ + 512 * 1024;
constexpr size_t WS_WV = WS_WK + 256 * 1024;
constexpr size_t WS_WG = 8 * MiB;
constexpr size_t WS_WPO = WS_WG + 512 * 1024;
constexpr size_t WS_WMO = WS_WPO + 1 * MiB;
constexpr size_t WS_WOUT = WS_WMO + 1 * MiB;
constexpr size_t WS_WQY = 13 * MiB;
constexpr size_t WS_SK = 17 * MiB;
constexpr size_t WS_ROPE = WS_SK + 512 * 1024;
constexpr size_t WS_R1 = 18 * MiB;
constexpr size_t WS_R2 = 50 * MiB;
constexpr size_t WS_EIDX = WS_R2 + 64 * MiB;
constexpr size_t WS_GATE = WS_EIDX + 8 * MiB;
constexpr size_t WS_KB = 146 * MiB;
constexpr size_t WS_VT = 170 * MiB;
constexpr size_t WS_MRG = 146 * MiB;
constexpr size_t WS_PIN = 186 * MiB;
constexpr size_t WS_PF = 202 * MiB;
constexpr size_t WS_AO = 218 * MiB;
constexpr size_t WS_EU = 146 * MiB;
constexpr size_t WS_EV = 154 * MiB;
constexpr size_t WS_ESC = 162 * MiB;
constexpr size_t WS_END = 234 * MiB;
constexpr int CW_BAR = 4096;
constexpr int CW_MOD = 16384;
constexpr int CW_RSQ = CW_MOD + 2 * 4 * 6144;
constexpr int CW_RSK = CW_RSQ + 2 * T;
constexpr int CW_MODF = CW_RSK + 2 * T;
static_assert((CW_MODF + 4 * 6144) * 4 <= (int)CTL_ZERO_BYTES, "ctl");
constexpr double MOD_FX = 1099511627776.0, RS_FX = 16777216.0;
__device__ __forceinline__ void fx_add(long long* p, float v, double scale) { atomicAdd((unsigned long long*)p, (unsigned long long)__double2ll_rn((double)v * scale)); }
__device__ __forceinline__ float fx_get(const long long* p, double inv_scale) { return (float)((double)(*p) * inv_scale); }

__device__ __forceinline__ unsigned cvtpk(float lo, float hi) { f32x2 v = {lo, hi}; bf16x2_t b = __builtin_convertvector(v, bf16x2_t); return __builtin_bit_cast(unsigned, b); }
__device__ __forceinline__ float bflo(unsigned w) { return __uint_as_float(w << 16); }
__device__ __forceinline__ float bfhi(unsigned w) { return __uint_as_float(w & 0xffff0000u); }
__device__ __forceinline__ u32x4 pack8(f32x4 a, f32x4 b) { u32x4 w; w.x = cvtpk(a[0], a[1]); w.y = cvtpk(a[2], a[3]); w.z = cvtpk(b[0], b[1]); w.w = cvtpk(b[2], b[3]); return w; }
__device__ __forceinline__ void unpack8(u32x4 w, f32x4& a, f32x4& b) { a = (f32x4){bflo(w.x), bfhi(w.x), bflo(w.y), bfhi(w.y)}; b = (f32x4){bflo(w.z), bfhi(w.z), bflo(w.w), bfhi(w.w)}; }
__device__ __forceinline__ float sigmoidf_(float x) { return __builtin_amdgcn_rcpf(1.0f + __builtin_amdgcn_exp2f(-1.4426950408889634f * x)); }
__device__ __forceinline__ float wave_sum(float v) {
#pragma unroll
    for (int o = 1; o < 64; o <<= 1) v += __shfl_xor(v, o);
    return v;
}
#define LDS_WAIT() asm volatile("s_waitcnt lgkmcnt(0)" ::: "memory")

namespace pg8 {
typedef unsigned short bf16_t;
constexpr int BM = 256, BK = 64, HALF = 128, HTB = HALF * BK * 2, STAGE_BYTES = 8 * HTB, NXCD = 8, WGM = 8;
__host__ __device__ __forceinline__ int lds_byte(int r, int c) { const int st = (r >> 4) * 2 + (c >> 5), rr = r & 15, cc = c & 31, ob = rr * 64 + cc * 2; return st * 1024 + (ob ^ (((ob >> 9) & 1) << 5)); }
__host__ __device__ __forceinline__ void stage_rc(int b, int& R, int& C) { const int st = b / 1024, sb = b % 1024, swz = sb ^ (((sb >> 9) & 1) << 5); R = (st >> 1) * 16 + swz / 64; C = (st & 1) * 32 + (swz % 64) / 2; }
__host__ __device__ __forceinline__ int perm32(int rho) { const int n = rho >> 4, i = rho & 15; return 8 * (i >> 2) + 4 * n + (i & 3); }
struct Unit { int pm, pn; };
struct Gemm { const bf16_t* A; const bf16_t* Bt; int M, N, K, lda, ldb; };
struct StaticOrder {
    int nM, nN, nwg, G, c;
    __host__ __device__ void init(int M, int N, int G_, int c_) { nM = M / BM; nN = N / BM; nwg = nM * nN; G = G_; c = c_; }
    __host__ __device__ bool next(int i, Unit& u) const {
        const long L = (long)i * G + c; if (L >= nwg) return false;
        int wgid = (int)L; { const int q = nwg / NXCD, r = nwg % NXCD, xcd = wgid % NXCD, off = wgid / NXCD; wgid = (xcd < r ? xcd * (q + 1) : r * (q + 1) + (xcd - r) * q) + off; }
        const int nig = WGM * nN, gid = wgid / nig, fm = gid * WGM, gsz = (nM - fm) < WGM ? (nM - fm) : WGM;
        u.pm = fm + ((wgid % nig) % gsz); u.pn = (wgid % nig) / gsz; return true;
    }
};
template <class Epi, bool ALIGN_EPI>
__device__ __forceinline__ void gemm_phase(LAS unsigned char* lds, const Gemm g, const StaticOrder& S, const Epi& E) {
    int tid_ = threadIdx.x; asm volatile("" : "+v"(tid_));
    const int tid = tid_, wid = __builtin_amdgcn_readfirstlane(tid >> 6), lane = tid & 63, wr = wid >> 2, wc = wid & 3, fr = lane & 15, fq = lane >> 4;
    int K_ = g.K; asm volatile("" : "+s"(K_));
    const int K = K_, nt = K / BK;
    unsigned voffA[2], voffB[2];
#pragma unroll
    for (int i = 0; i < 2; ++i) { int R, C; stage_rc(tid * 16 + i * 8192, R, C); const int Rb = (R & ~31) + perm32(R & 31);
        voffA[i] = (unsigned)(R * g.lda + C) * 2u; voffB[i] = (unsigned)(Rb * g.ldb + C) * 2u; }
    const size_t kstep = (size_t)(BK * 2);
    const size_t hstepA = (size_t)HALF * g.lda * 2, hstepB = (size_t)HALF * g.ldb * 2;
    const size_t tstepA = 2 * hstepA, tstepB = 2 * hstepB;
    const unsigned ldsw = (unsigned)wid * 1024u;
    const int aoff = lds_byte(wr * 64 + fr, fq * 8), boff = lds_byte(wc * 32 + fr, fq * 8);
#define PG8_SA(b, h) (((b) * 2 + (h)) * HTB)
#define PG8_SB(b, h) ((4 + (b) * 2 + (h)) * HTB)
#define PG8_STAGE(bufoff, gbase, voff) do { _Pragma("unroll") for (int _i = 0; _i < 2; ++_i) \
        __builtin_amdgcn_global_load_lds((const unsigned*)((const char*)(gbase) + (voff)[_i]), (LAS unsigned*)(lds + (bufoff) + ldsw + _i * 8192), 16, 0, 0); } while (0)
#define PG8_LDA(dst, b, h) do { _Pragma("unroll") for (int m = 0; m < 4; ++m) _Pragma("unroll") for (int k = 0; k < 2; ++k) dst[m][k] = *(const LAS bf16x8*)(lds + PG8_SA(b, h) + aoff + m * 2048 + k * 1024); } while (0)
#define PG8_LDB(dst, b, h) do { _Pragma("unroll") for (int n = 0; n < 2; ++n) _Pragma("unroll") for (int k = 0; k < 2; ++k) dst[n][k] = *(const LAS bf16x8*)(lds + PG8_SB(b, h) + boff + n * 2048 + k * 1024); } while (0)
#define PG8_MMA(ai, bj, At, Bt) do { __builtin_amdgcn_s_setprio(1); _Pragma("unroll") for (int m = 0; m < 4; ++m) _Pragma("unroll") for (int n = 0; n < 2; ++n) _Pragma("unroll") for (int k = 0; k < 2; ++k) \
        acc[ai][bj][m][n] = __builtin_amdgcn_mfma_f32_16x16x32_bf16(Bt[n][k], At[m][k], acc[ai][bj][m][n], 0, 0, 0); __builtin_amdgcn_s_setprio(0); } while (0)
#define PG8_WAIT_V(n) asm volatile("s_waitcnt vmcnt(" #n ")" ::: "memory")
#define PG8_WAIT_L(n) asm volatile("s_waitcnt lgkmcnt(" #n ")" ::: "memory")
#define PG8_BAR __builtin_amdgcn_s_barrier()
#define PG8_SCHED __builtin_amdgcn_sched_barrier(0)
    Unit cur, nxt; int ui = 0;
    if (!S.next(0, cur)) return;
    f32x4 acc[2][2][4][2];
#pragma unroll
    for (int a = 0; a < 2; ++a)
#pragma unroll
        for (int b = 0; b < 2; ++b)
#pragma unroll
            for (int m = 0; m < 4; ++m)
#pragma unroll
                for (int n = 0; n < 2; ++n) acc[a][b][m][n] = (f32x4){0.f, 0.f, 0.f, 0.f};
    bf16x8 At[4][2], B0[2][2], B1[2][2];
    const char* cA = (const char*)g.A + (size_t)cur.pm * tstepA; const char* cB = (const char*)g.Bt + (size_t)cur.pn * tstepB;
    PG8_STAGE(PG8_SB(0, 0), cB, voffB); PG8_STAGE(PG8_SB(0, 1), cB + hstepB, voffB); PG8_STAGE(PG8_SA(0, 0), cA, voffA); PG8_STAGE(PG8_SA(0, 1), cA + hstepA, voffA);
    if (wr == 1) PG8_BAR;
    PG8_WAIT_V(2); PG8_BAR;
    PG8_STAGE(PG8_SB(1, 0), cB + kstep, voffB); PG8_STAGE(PG8_SA(1, 0), cA + kstep, voffA); PG8_STAGE(PG8_SB(1, 1), cB + hstepB + kstep, voffB);
    PG8_WAIT_V(6); PG8_BAR;
    for (;;) {
        const bool has_next = S.next(ui + 1, nxt);
        const char* nA = has_next ? (const char*)g.A + (size_t)nxt.pm * tstepA : cA; const char* nB = has_next ? (const char*)g.Bt + (size_t)nxt.pn * tstepB : cB;
        for (int t = 0; t < nt; t += 2) {
            const bool last = (t == nt - 2);
            const char* a1 = cA + (size_t)(t + 1) * kstep;
            const char* a2 = last ? nA : cA + (size_t)(t + 2) * kstep; const char* b2 = last ? nB : cB + (size_t)(t + 2) * kstep;
            const char* a3 = a2 + kstep; const char* b3 = b2 + kstep;
            PG8_LDB(B0, 0, 0); PG8_LDB(B1, 0, 1); PG8_SCHED; PG8_LDA(At, 0, 0); PG8_STAGE(PG8_SA(1, 1), a1 + hstepA, voffA);
            PG8_WAIT_V(8); PG8_WAIT_L(0); PG8_BAR; PG8_MMA(0, 0, At, B0); PG8_MMA(0, 1, At, B1); PG8_BAR; PG8_SCHED;
            PG8_LDA(At, 0, 1); PG8_STAGE(PG8_SB(0, 0), b2, voffB); PG8_STAGE(PG8_SB(0, 1), b2 + hstepB, voffB); PG8_STAGE(PG8_SA(0, 0), a2, voffA);
            PG8_WAIT_V(8); PG8_WAIT_L(0); PG8_BAR; PG8_MMA(1, 0, At, B0); PG8_MMA(1, 1, At, B1); PG8_BAR; PG8_SCHED;
            PG8_LDB(B0, 1, 0); PG8_LDB(B1, 1, 1); PG8_SCHED; PG8_LDA(At, 1, 0); PG8_STAGE(PG8_SA(0, 1), a2 + hstepA, voffA);
            PG8_WAIT_V(8); PG8_WAIT_L(0); PG8_BAR; PG8_MMA(0, 0, At, B0); PG8_MMA(0, 1, At, B1); PG8_BAR; PG8_SCHED;
            PG8_LDA(At, 1, 1); PG8_STAGE(PG8_SB(1, 0), b3, voffB); PG8_STAGE(PG8_SB(1, 1), b3 + hstepB, voffB); PG8_STAGE(PG8_SA(1, 0), a3, voffA);
            PG8_WAIT_V(8); PG8_WAIT_L(0); PG8_BAR; PG8_MMA(1, 0, At, B0); PG8_MMA(1, 1, At, B1); PG8_BAR; PG8_SCHED;
        }
        if constexpr (ALIGN_EPI) { if (wr == 0) PG8_BAR; }
        E(acc, cur, wr, wc, fr, fq);
        if (!has_next) break;
#pragma unroll
        for (int a = 0; a < 2; ++a)
#pragma unroll
            for (int b = 0; b < 2; ++b)
#pragma unroll
                for (int m = 0; m < 4; ++m)
#pragma unroll
                    for (int n = 0; n < 2; ++n) acc[a][b][m][n] = (f32x4){0.f, 0.f, 0.f, 0.f};
        cur = nxt; cA = nA; cB = nB; ++ui;
        if constexpr (ALIGN_EPI) { if (wr == 1) PG8_BAR; }
    }
    PG8_WAIT_V(0);
    if constexpr (!ALIGN_EPI) { if (wr == 0) PG8_BAR; }
    PG8_BAR;
#undef PG8_SA
#undef PG8_SB
#undef PG8_STAGE
#undef PG8_LDA
#undef PG8_LDB
#undef PG8_MMA
#undef PG8_WAIT_V
#undef PG8_WAIT_L
#undef PG8_BAR
#undef PG8_SCHED
}

#define EPI_ARGS const f32x4 (&acc)[2][2][4][2], const Unit& u, int wr, int wc, int fr, int fq
__device__ __forceinline__ void rope8(f32x4& v0, f32x4& v1, const float* tab, int e0) {
    const f32x4 c = *(const f32x4*)(tab + e0), s = *(const f32x4*)(tab + 16 + e0);
    const float a0 = v0[0] * c[0] - v0[1] * s[0], b0 = v0[1] * c[0] + v0[0] * s[0];
    const float a1 = v0[2] * c[1] - v0[3] * s[1], b1 = v0[3] * c[1] + v0[2] * s[1];
    const float a2 = v1[0] * c[2] - v1[1] * s[2], b2 = v1[1] * c[2] + v1[0] * s[2];
    const float a3 = v1[2] * c[3] - v1[3] * s[3], b3 = v1[3] * c[3] + v1[2] * s[3];
    v0 = (f32x4){a0, b0, a1, b1}; v1 = (f32x4){a2, b2, a3, b3};
}
struct EpiPlain { bf16* O; int ldc;
    __device__ __forceinline__ void operator()(EPI_ARGS) const {
#pragma unroll
        for (int ai = 0; ai < 2; ++ai)
#pragma unroll
            for (int m = 0; m < 4; ++m) { const int row = u.pm * BM + ai * HALF + wr * 64 + m * 16 + fr;
#pragma unroll
                for (int bj = 0; bj < 2; ++bj) { const int col0 = u.pn * BM + bj * HALF + wc * 32 + 8 * fq;
                    *(u32x4*)(O + (size_t)row * ldc + col0) = pack8(acc[ai][bj][m][0], acc[ai][bj][m][1]); } }
    }
};
struct EpiProj { bf16* P; bf16* Kb; long long* rsq; long long* rsk; const float* rope;
    __device__ __forceinline__ void operator()(EPI_ARGS) const {
        const int pn = u.pn;
#pragma unroll
        for (int ai = 0; ai < 2; ++ai)
#pragma unroll
            for (int m = 0; m < 4; ++m) { const int row = u.pm * BM + ai * HALF + wr * 64 + m * 16 + fr; float ss = 0.f;
#pragma unroll
                for (int bj = 0; bj < 2; ++bj) { const int col0 = pn * BM + bj * HALF + wc * 32 + 8 * fq;
                    f32x4 v0 = acc[ai][bj][m][0], v1 = acc[ai][bj][m][1];
                    if (pn >= 4) {
#pragma unroll
                        for (int i = 0; i < 4; ++i) { v0[i] = sigmoidf_(v0[i]); v1[i] = sigmoidf_(v1[i]); }
                    }
                    *(u32x4*)(P + (size_t)row * PROJ_N + col0) = pack8(v0, v1);
                    if (pn == 2 || (pn == 3 && bj == 0)) ss += (v0[0] * v0[0] + v0[1] * v0[1]) + (v0[2] * v0[2] + v0[3] * v0[3]) + (v1[0] * v1[0] + v1[1] * v1[1]) + (v1[2] * v1[2] + v1[3] * v1[3]);
                    if (pn == 3 && bj == 1 && wc == 0) {
                        rope8(v0, v1, rope + (size_t)(row & (SEQ - 1)) * 32, 4 * fq);
                        const u32x4 w = pack8(v0, v1);
#pragma unroll
                        for (int h = 0; h < NHEAD; ++h) *(u32x4*)(Kb + (size_t)row * (NHEAD * QKD) + h * QKD + 64 + 8 * fq) = w;
                    }
                }
                if (pn == 2 || pn == 3) { ss += __shfl_xor(ss, 16); ss += __shfl_xor(ss, 32);
                    if (fq == 0) fx_add((pn == 2 ? rsq : rsk) + row, ss, RS_FX); }
            }
    }
};
struct EpiQ { bf16* Q; const long long* rsq; const float* rope;
    __device__ __forceinline__ void operator()(EPI_ARGS) const {
#pragma unroll
        for (int ai = 0; ai < 2; ++ai)
#pragma unroll
            for (int m = 0; m < 4; ++m) { const int row = u.pm * BM + ai * HALF + wr * 64 + m * 16 + fr;
                const float sc = rsqrtf(fx_get(rsq + row, 1.0 / RS_FX) * (1.0f / 256.0f) + RMS_EPS) * ATT_C2;
#pragma unroll
                for (int bj = 0; bj < 2; ++bj) { const int col0 = u.pn * BM + bj * HALF + wc * 32 + 8 * fq;
                    f32x4 v0 = acc[ai][bj][m][0] * sc, v1 = acc[ai][bj][m][1] * sc;
                    if (((u.pn * 8 + bj * 4 + wc) % 3) == 2) rope8(v0, v1, rope + (size_t)(row & (SEQ - 1)) * 32, 4 * fq);
                    *(u32x4*)(Q + (size_t)row * (NHEAD * QKD) + col0) = pack8(v0, v1); }
                asm volatile("" ::: "memory"); }
    }
};
struct EpiKn { bf16* Kb; const long long* rsk;
    __device__ __forceinline__ void operator()(EPI_ARGS) const {
#pragma unroll
        for (int ai = 0; ai < 2; ++ai)
#pragma unroll
            for (int m = 0; m < 4; ++m) { const int row = u.pm * BM + ai * HALF + wr * 64 + m * 16 + fr;
                const float sc = rsqrtf(fx_get(rsk + row, 1.0 / RS_FX) * (1.0f / 128.0f) + RMS_EPS);
#pragma unroll
                for (int bj = 0; bj < 2; ++bj) { const int col0 = u.pn * BM + bj * HALF + wc * 32 + 8 * fq; const int h = col0 >> 6, j = col0 & 63;
                    *(u32x4*)(Kb + (size_t)row * (NHEAD * QKD) + h * QKD + j) = pack8(acc[ai][bj][m][0] * sc, acc[ai][bj][m][1] * sc); }
                if (m & 1) asm volatile("" ::: "memory"); }
    }
};
struct EpiVt { bf16* Vt; const long long* rsk;
    __device__ __forceinline__ void operator()(EPI_ARGS) const {
#pragma unroll
        for (int bj = 0; bj < 2; ++bj) { const int col0 = u.pn * BM + bj * HALF + wc * 32 + 8 * fq;
            f32x4 s0, s1;
#pragma unroll
            for (int i = 0; i < 4; ++i) { s0[i] = rsqrtf(fx_get(rsk + col0 + i, 1.0 / RS_FX) * (1.0f / 128.0f) + RMS_EPS); s1[i] = rsqrtf(fx_get(rsk + col0 + 4 + i, 1.0 / RS_FX) * (1.0f / 128.0f) + RMS_EPS); }
#pragma unroll
            for (int ai = 0; ai < 2; ++ai)
#pragma unroll
                for (int m = 0; m < 4; ++m) { const int row = u.pm * BM + ai * HALF + wr * 64 + m * 16 + fr;
                    *(u32x4*)(Vt + (size_t)row * T + col0) = pack8(acc[ai][bj][m][0] * s0, acc[ai][bj][m][1] * s1); }
            asm volatile("" ::: "memory"); }
    }
};
template <int MODE> struct EpiGate { bf16* Y; const bf16* P; int goff;
    __device__ __forceinline__ void operator()(EPI_ARGS) const {
#pragma unroll
        for (int ai = 0; ai < 2; ++ai)
#pragma unroll
            for (int m = 0; m < 4; ++m) { const int row = u.pm * BM + ai * HALF + wr * 64 + m * 16 + fr;
#pragma unroll
                for (int bj = 0; bj < 2; ++bj) { const int col0 = u.pn * BM + bj * HALF + wc * 32 + 8 * fq;
                    f32x4 g0, g1; unpack8(*(const u32x4*)(P + (size_t)row * PROJ_N + goff + col0), g0, g1);
                    f32x4 v0 = acc[ai][bj][m][0] * g0, v1 = acc[ai][bj][m][1] * g1;
                    bf16* yp = Y + (size_t)row * D + col0;
                    if (MODE == 1) { f32x4 y0, y1; unpack8(*(const u32x4*)yp, y0, y1); v0 += y0; v1 += y1; }
                    *(u32x4*)yp = pack8(v0, v1); } }
    }
};
}

#define XB_TMO      128
#define XB_XCNT(j)  (256  + 64 * (j))
#define XB_XSUB(j)  (1280 + 64 * (j))
#define XB_XGEN(j)  (2304 + 64 * (j))
#define XB_TOP      3328
#define XB_TOPGEN   3392
#define XCD_BAR_WORDS 3456
#define XB_SPIN_CAP (1u << 18)
__device__ __forceinline__ unsigned xb_ld(unsigned* p)              { return __hip_atomic_load(p, __ATOMIC_RELAXED, __HIP_MEMORY_SCOPE_AGENT); }
__device__ __forceinline__ unsigned xb_add(unsigned* p, unsigned v) { return __hip_atomic_fetch_add(p, v, __ATOMIC_RELAXED, __HIP_MEMORY_SCOPE_AGENT); }
__device__ __forceinline__ unsigned xb_xcc_id() { return (unsigned)__builtin_amdgcn_s_getreg((3 << 11) | 20) & 0xFu; }
#define XB_SPIN(cond, bar) do { unsigned _sp = 0; while (cond) { __builtin_amdgcn_s_sleep(1); \
    if ((++_sp & 255u) == 0u) { if (xb_ld(&(bar)[XB_TMO])) break; if (_sp > XB_SPIN_CAP) { atomicAdd(&(bar)[XB_TMO], 1u); break; } } } } while (0)
struct XcdBarrier { unsigned* bar; unsigned x; volatile LAS unsigned* st; };
__device__ __forceinline__ XcdBarrier xcd_barrier_post(unsigned* bar, volatile LAS unsigned* st) {
    XcdBarrier b; b.bar = bar; b.x = xb_xcc_id(); b.st = st;
    if (threadIdx.x == 0) (void)xb_add(&bar[XB_XCNT(b.x)], 1u);
    return b;
}
__device__ __forceinline__ void xcd_barrier_complete(unsigned* bar, unsigned x, unsigned& nloc, unsigned& nx) {
    const unsigned G = gridDim.x * gridDim.y * gridDim.z;
    unsigned sum, cnt, mine, sp = 0u;
    for (;;) {
        sum = 0u; cnt = 0u; mine = 0u;
#pragma unroll
        for (unsigned j = 0; j < 16; ++j) { const unsigned c = xb_ld(&bar[XB_XCNT(j)]); sum += c; cnt += (c > 0u) ? 1u : 0u; mine = (j == x) ? c : mine; }
        if (sum == G) break;
        __builtin_amdgcn_s_sleep(1);
        if ((++sp & 255u) == 0u) { if (xb_ld(&bar[XB_TMO])) break; if (sp > XB_SPIN_CAP) { atomicAdd(&bar[XB_TMO], 1u); break; } }
    }
    nloc = mine > 0u ? mine : 1u; nx = cnt > 0u ? cnt : 1u;
}
__device__ __forceinline__ void xcd_barrier(const XcdBarrier& b) {
    asm volatile("s_waitcnt vmcnt(0)" ::: "memory");
    __syncthreads();
    if (threadIdx.x == 0) {
        unsigned* bar = b.bar;
        __builtin_amdgcn_s_waitcnt(0);
        unsigned nloc = b.st[0], nx = b.st[1];
        if (nloc == 0u) { xcd_barrier_complete(bar, b.x, nloc, nx); b.st[0] = nloc; b.st[1] = nx; }
        const unsigned old = xb_add(&bar[XB_XSUB(b.x)], 1u);
        const unsigned gen = old / nloc;
        if (old + 1u == (gen + 1u) * nloc) {
            __builtin_amdgcn_fence(__ATOMIC_RELEASE, "agent");
            asm volatile("s_waitcnt vmcnt(0)" ::: "memory");
            const unsigned og = xb_add(&bar[XB_TOP], 1u);
            const unsigned tg = og / nx;
            if (og + 1u == (tg + 1u) * nx) xb_add(&bar[XB_TOPGEN], 1u);
            else XB_SPIN(xb_ld(&bar[XB_TOPGEN]) == tg, bar);
            __builtin_amdgcn_fence(__ATOMIC_ACQUIRE, "agent");
            xb_add(&bar[XB_XGEN(b.x)], 1u);
            asm volatile("s_waitcnt vmcnt(0)" ::: "memory");
        } else {
            XB_SPIN(xb_ld(&bar[XB_XGEN(b.x)]) == gen, bar);
            __builtin_amdgcn_fence(__ATOMIC_ACQUIRE, "agent");
            asm volatile("s_waitcnt vmcnt(0)" ::: "memory");
        }
    }
    __syncthreads();
}

constexpr int NWAVES = 8;
constexpr int RING_BYTES = 131072, LDSCTL_OFF = RING_BYTES, LDS_BYTES = 147456;
struct Args { const float* in[23]; float* out; unsigned char* ws; };
struct Frame {
    LAS unsigned char* lds; int tid, lane, wave, vcu, G;
    const float* const* in; float* out; unsigned char* ws;
};
enum { I_X = 0, I_C, I_WADA, I_BADA, I_GPRE1, I_GPOST1, I_WIN, I_WPG, I_PSCALE, I_WPO, I_GQ, I_WQUP, I_GKV, I_WKVUP, I_WMO, I_WOUT, I_GPRE2, I_GPOST2, I_WQY, I_SK1, I_SK2, I_EU, I_EV };

__device__ __forceinline__ void tr_block(const float* src, int spitch, int ks, int ns, int perm, const float* gk, const float* gn, bf16* dst, int dpitch, int nd, int kd, LAS float* scr, int lane) {
    if (src) {
        const float gnv = gn ? gn[lane & 31] : 1.0f;
        float tv[32];
#pragma unroll
        for (int i = 0; i < 32; ++i) tv[i] = src[(size_t)(ks + 2 * i + (lane >> 5)) * spitch + ns + (lane & 31)];
#pragma unroll
        for (int i = 0; i < 32; ++i) { const int kk = 2 * i + (lane >> 5); float v = tv[i] * gnv; if (gk) v *= gk[ks + kk]; scr[kk * 33 + (lane & 31)] = v; }
    } else {
#pragma unroll 8
        for (int i = 0; i < 32; ++i) { const int kk = 2 * i + (lane >> 5); scr[kk * 33 + (lane & 31)] = 0.f; }
    }
    LDS_WAIT(); asm volatile("" ::: "memory");
    const int c = lane & 7;
#pragma unroll
    for (int j = 0; j < 4; ++j) { const int n = (lane >> 3) + 8 * j; const int pc = perm ? ((n >> 1) + 16 * (n & 1)) : n; const LAS float* s = scr + (8 * c) * 33 + pc;
        u32x4 o; o.x = cvtpk(s[0 * 33], s[1 * 33]); o.y = cvtpk(s[2 * 33], s[3 * 33]); o.z = cvtpk(s[4 * 33], s[5 * 33]); o.w = cvtpk(s[6 * 33], s[7 * 33]);
        *(u32x4*)(dst + (size_t)(nd + n) * dpitch + kd + 8 * c) = o; }
    LDS_WAIT(); asm volatile("" ::: "memory");
}

__device__ __forceinline__ void p0_prologue(Frame& F) {
    LAS float* scr = (LAS float*)(F.lds + F.wave * 16384);
    int lane_ = F.lane; asm volatile("" : "+v"(lane_));
    const int gw = F.vcu * NWAVES + F.wave, NGW = F.G * NWAVES, lane = lane_;
    unsigned char* ws = F.ws;
    {
        long long* mod = (long long*)((unsigned*)(ws + WS_CTL) + CW_MOD);
        const float* cc = F.in[I_C]; const float* wa = F.in[I_WADA]; const float* ba = F.in[I_BADA];
        for (int it = gw; it < 24 * 64; it += NGW) {
            const int cg = it % 24, kc = it / 24; const int col = cg * 256 + 4 * lane;
            f32x4 a0 = {0, 0, 0, 0}, a1 = a0, a2 = a0, a3 = a0;
            if (kc == 0) { a0 = *(const f32x4*)(ba + col); a1 = a0; a2 = a0; a3 = a0; }
#pragma unroll 4
            for (int k = kc * 16; k < kc * 16 + 16; ++k) {
                const f32x4 w = *(const f32x4*)(wa + (size_t)k * 6144 + col);
                const float c0 = cc[k], c1 = cc[1024 + k], c2 = cc[2048 + k], c3 = cc[3072 + k];
                a0 += w * (c0 * sigmoidf_(c0)); a1 += w * (c1 * sigmoidf_(c1)); a2 += w * (c2 * sigmoidf_(c2)); a3 += w * (c3 * sigmoidf_(c3));
            }
#pragma unroll
            for (int i = 0; i < 4; ++i) { fx_add(mod + col + i, a0[i], MOD_FX); fx_add(mod + 6144 + col + i, a1[i], MOD_FX); fx_add(mod + 2 * 6144 + col + i, a2[i], MOD_FX); fx_add(mod + 3 * 6144 + col + i, a3[i], MOD_FX); }
        }
    }
    {
        bf16* Win = (bf16*)(ws + WS_WIN); bf16* Wq = (bf16*)(ws + WS_WQ); bf16* Wk = (bf16*)(ws + WS_WK); bf16* Wv = (bf16*)(ws + WS_WV); bf16* Wg = (bf16*)(ws + WS_WG);
        bf16* Wpo = (bf16*)(ws + WS_WPO); bf16* Wmo = (bf16*)(ws + WS_WMO); bf16* Wout = (bf16*)(ws + WS_WOUT); bf16* Wqy = (bf16*)(ws + WS_WQY);
        constexpr int N1 = 96 * 16, N2 = 24 * 4, N3 = 16 * 4, N4 = 16 * 4, N5 = 16 * 8, N6 = 32 * 8, N7 = 32 * 8, N8 = 32 * 16, N9 = 64 * 16;
        constexpr int NITEMS = N1 + N2 + N3 + N4 + N5 + N6 + N7 + N8 + N9;
        for (int it = gw; it < NITEMS; it += NGW) {
            int r = it;
            if (r < N1) { const int nb = r % 96, kb = r / 96; const float* s = F.in[I_WIN]; int ns = 32 * nb, pm = 0;
                if (nb == 28) pm = 1; else if (nb >= 29 && nb < 32) s = nullptr; else if (nb >= 32) ns = 928 + 32 * (nb - 32);
                tr_block(s, 2976, 64 * kb, ns, pm, nullptr, nullptr, Win, 1024, 32 * nb, 64 * kb, scr, lane); continue; } r -= N1;
            if (r < N2) { const int nb = r % 24, kb = r / 24; const int h = nb / 3, q = nb % 3;
                tr_block(F.in[I_WQUP], 768, 64 * kb, 96 * h + 32 * q, q == 2, F.in[I_GQ], nullptr, Wq, 256, 32 * nb, 64 * kb, scr, lane); continue; } r -= N2;
            if (r < N3) { const int nb = r % 16, kb = r / 16; const int h = nb / 2, q = nb % 2;
                tr_block(kb < 2 ? F.in[I_WKVUP] : nullptr, 1024, 64 * kb, 128 * h + 32 * q, 0, F.in[I_GKV], nullptr, Wk, 256, 32 * nb, 64 * kb, scr, lane); continue; } r -= N3;
            if (r < N4) { const int nb = r % 16, kb = r / 16; const int h = nb / 2, q = nb % 2;
                tr_block(kb < 2 ? F.in[I_WKVUP] : nullptr, 1024, 64 * kb, 128 * h + 64 + 32 * q, 0, F.in[I_GKV], nullptr, Wv, 256, 32 * nb, 64 * kb, scr, lane); continue; } r -= N4;
            if (r < N5) { const int nb = r % 16, kb = r / 16; const int g = nb / 4; const bool dg = (kb / 2) == g;
                tr_block(dg ? F.in[I_WPG] + (size_t)g * 128 * 128 : nullptr, 128, 64 * (kb % 2), 32 * (nb % 4), 0, nullptr, F.in[I_PSCALE] + g * 128 + 32 * (nb % 4), Wg, 512, 32 * nb, 64 * kb, scr, lane); continue; } r -= N5;
            if (r < N6) { const int nb = r % 32, kb = r / 32; tr_block(F.in[I_WPO], 1024, 64 * kb, 32 * nb, 0, nullptr, nullptr, Wpo, 512, 32 * nb, 64 * kb, scr, lane); continue; } r -= N6;
            if (r < N7) { const int nb = r % 32, kb = r / 32; tr_block(F.in[I_WMO], 1024, 64 * kb, 32 * nb, 0, nullptr, nullptr, Wmo, 512, 32 * nb, 64 * kb, scr, lane); continue; } r -= N7;
            if (r < N8) { const int nb = r % 32, kb = r / 32; tr_block(F.in[I_WOUT], 1024, 64 * kb, 32 * nb, 0, nullptr, nullptr, Wout, 1024, 32 * nb, 64 * kb, scr, lane); continue; } r -= N8;
            { const int nb = r % 64, kb = r / 64; tr_block(F.in[I_WQY], 2048, 64 * kb, 32 * nb, 0, nullptr, nullptr, Wqy, 1024, 32 * nb, 64 * kb, scr, lane); }
        }
    }
    {
        bf16* sk = (bf16*)(ws + WS_SK);
        const int gt = (F.vcu * NWAVES * 64) + F.wave * 64 + lane, NGT = F.G * NWAVES * 64;
        for (int i = gt; i < 2 * 131072 / 8; i += NGT) { const int side = i / 16384, o = (i % 16384) * 8; const float* s = F.in[side ? I_SK2 : I_SK1] + o;
            *(u32x4*)(sk + (size_t)side * 131072 + o) = pack8(*(const f32x4*)s, *(const f32x4*)(s + 4)); }
        float* rope = (float*)(ws + WS_ROPE);
        for (int i = gt; i < SEQ * 16; i += NGT) { const int pos = i >> 4, e = i & 15;
            const float frac[4] = {1.0f, 0.5623413251903491f, 0.31622776601683794f, 0.17782794100389228f};
            const float dec[4] = {1.0f, 0.1f, 0.01f, 0.001f};
            const float inv = (float)((double)dec[e >> 2] * (double)frac[e & 3]);
            const float ang = (float)pos * inv;
            const double rev = (double)ang * 0.15915494309189535;
            const float fr = (float)(rev - floor(rev));
            rope[pos * 32 + e] = __builtin_amdgcn_cosf(fr); rope[pos * 32 + 16 + e] = __builtin_amdgcn_sinf(fr); }
    }
}

__device__ __forceinline__ void p1_xn(Frame& F) {
    int lane_ = F.lane; asm volatile("" : "+v"(lane_));
    const int gw = F.vcu * NWAVES + F.wave, NGW = F.G * NWAVES, lane = lane_;
    const long long* mod = (const long long*)((const unsigned*)(F.ws + WS_CTL) + CW_MOD); const float* g = F.in[I_GPRE1]; bf16* xn = (bf16*)(F.ws + WS_R1);
    { float* modf = (float*)(F.ws + WS_CTL) + CW_MODF; for (int i = gw * 64 + lane; i < 4 * 6144; i += NGW * 64) modf[i] = fx_get(mod + i, 1.0 / MOD_FX); }
    for (int row0 = gw; row0 < T; row0 += 2 * NGW) {
        f32x4 v[2][4]; float s[2] = {0.f, 0.f};
#pragma unroll
        for (int q = 0; q < 2; ++q) { const f32x4* xr = (const f32x4*)(F.in[I_X] + (size_t)(row0 + q * NGW) * D) + lane;
#pragma unroll
            for (int j = 0; j < 4; ++j) v[q][j] = xr[64 * j]; }
#pragma unroll
        for (int q = 0; q < 2; ++q)
#pragma unroll
            for (int j = 0; j < 4; ++j) s[q] += (v[q][j].x * v[q][j].x + v[q][j].y * v[q][j].y) + (v[q][j].z * v[q][j].z + v[q][j].w * v[q][j].w);
#pragma unroll
        for (int q = 0; q < 2; ++q) { const int row = row0 + q * NGW; const long long* mb = mod + (row / SEQ) * 6144;
            const float rstd = rsqrtf(wave_sum(s[q]) * (1.f / D) + RMS_EPS);
#pragma unroll
            for (int j = 0; j < 4; ++j) { const int col = 4 * lane + 256 * j;
                const f32x4 gg = *(const f32x4*)(g + col); f32x4 sh, sc;
#pragma unroll
                for (int i = 0; i < 4; ++i) { sh[i] = fx_get(mb + col + i, 1.0 / MOD_FX); sc[i] = fx_get(mb + 1024 + col + i, 1.0 / MOD_FX); }
                const f32x4 o = v[q][j] * rstd * gg * (sc + 1.0f) + sh;
                u32x2 w; w.x = cvtpk(o.x, o.y); w.y = cvtpk(o.z, o.w); *(u32x2*)(xn + (size_t)row * D + col) = w; } }
    }
}
template <int W> __device__ __forceinline__ void pool_item(const bf16* P, bf16* PI, int t0, int ch) {
    const int s0 = t0 & (SEQ - 1);
    u32x4 raw[W + 7];
#pragma unroll
    for (int i = 0; i < W + 7; ++i) { const int dt = i - (W - 1); raw[i] = (s0 + dt >= 0) ? *(const u32x4*)(P + (size_t)(t0 + dt) * PROJ_N + ch) : (u32x4){0u, 0u, 0u, 0u}; }
    f32x4 a0 = {0, 0, 0, 0}, a1 = a0;
#pragma unroll
    for (int i = 0; i < W - 1; ++i) { f32x4 y0, y1; unpack8(raw[i], y0, y1); a0 += y0; a1 += y1; }
#pragma unroll
    for (int k = 0; k < 8; ++k) {
        f32x4 x0, x1; unpack8(raw[W - 1 + k], x0, x1); a0 += x0; a1 += x1;
        const int s = s0 + k; const float ic = 1.0f / (float)((s + 1 < W) ? s + 1 : W);
        *(u32x4*)(PI + (size_t)(t0 + k) * 512 + ch) = pack8(a0 * ic - x0, a1 * ic - x1);
        f32x4 o0, o1; unpack8(raw[k], o0, o1); a0 -= o0; a1 -= o1;
    }
}
__device__ __forceinline__ void p3_pool(Frame& F) {
    const bf16* P = (const bf16*)(F.ws + WS_R2); bf16* PI = (bf16*)(F.ws + WS_PIN);
    int tid_ = F.tid; asm volatile("" : "+v"(tid_));
    const int gt = (F.vcu * NWAVES * 64) + tid_, NGT = F.G * NWAVES * 64;
    for (int i = gt; i < (T / 8) * 64; i += NGT) {
        const int cg = i & 63, t0 = (i >> 6) * 8, ch = cg * 8, g = cg >> 4;
        if (g == 0) pool_item<2>(P, PI, t0, ch); else if (g == 1) pool_item<4>(P, PI, t0, ch); else if (g == 2) pool_item<8>(P, PI, t0, ch); else pool_item<16>(P, PI, t0, ch);
    }
}
__device__ __forceinline__ void p7_rows(Frame& F) {
    int lane_ = F.lane; asm volatile("" : "+v"(lane_));
    const int gw = F.vcu * NWAVES + F.wave, NGW = F.G * NWAVES, lane = lane_;
    const float* mod = (const float*)(F.ws + WS_CTL) + CW_MODF; const bf16* Z = (const bf16*)(F.ws + WS_R2); bf16* xn = (bf16*)(F.ws + WS_R1);
    const float* gp1 = F.in[I_GPOST1]; const float* gp2 = F.in[I_GPRE2];
    for (int row0 = gw; row0 < T; row0 += 2 * NGW) {
        f32x4 z[2][4], h[2][4], xv[2][4]; float s[2] = {0.f, 0.f}, s2[2] = {0.f, 0.f};
#pragma unroll
        for (int q = 0; q < 2; ++q) { const int row = row0 + q * NGW;
#pragma unroll
            for (int j = 0; j < 4; ++j) { const u32x2 w = *(const u32x2*)(Z + (size_t)row * D + 4 * lane + 256 * j); z[q][j] = (f32x4){bflo(w.x), bfhi(w.x), bflo(w.y), bfhi(w.y)};
                xv[q][j] = *(const f32x4*)(F.in[I_X] + (size_t)row * D + 4 * lane + 256 * j); } }
#pragma unroll
        for (int q = 0; q < 2; ++q)
#pragma unroll
            for (int j = 0; j < 4; ++j) s[q] += (z[q][j].x * z[q][j].x + z[q][j].y * z[q][j].y) + (z[q][j].z * z[q][j].z + z[q][j].w * z[q][j].w);
#pragma unroll
        for (int q = 0; q < 2; ++q) { const int row = row0 + q * NGW; const float* mb = mod + (row / SEQ) * 6144;
            const float rz = rsqrtf(wave_sum(s[q]) * (1.f / D) + RMS_EPS);
#pragma unroll
            for (int j = 0; j < 4; ++j) { const int col = 4 * lane + 256 * j;
                const f32x4 g1 = *(const f32x4*)(mb + 2048 + col), gg = *(const f32x4*)(gp1 + col);
                h[q][j] = xv[q][j] + g1 * (z[q][j] * rz * gg); *(f32x4*)(F.out + (size_t)row * D + col) = h[q][j];
                s2[q] += (h[q][j].x * h[q][j].x + h[q][j].y * h[q][j].y) + (h[q][j].z * h[q][j].z + h[q][j].w * h[q][j].w); } }
#pragma unroll
        for (int q = 0; q < 2; ++q) { const int row = row0 + q * NGW; const float* mb = mod + (row / SEQ) * 6144;
            const float rh = rsqrtf(wave_sum(s2[q]) * (1.f / D) + RMS_EPS);
#pragma unroll
            for (int j = 0; j < 4; ++j) { const int col = 4 * lane + 256 * j;
                const f32x4 gg = *(const f32x4*)(gp2 + col), sh = *(const f32x4*)(mb + 3072 + col), sc = *(const f32x4*)(mb + 4096 + col);
                const f32x4 o = h[q][j] * rh * gg * (sc + 1.0f) + sh;
                u32x2 w; w.x = cvtpk(o.x, o.y); w.y = cvtpk(o.z, o.w); *(u32x2*)(xn + (size_t)row * D + col) = w; } }
    }
}

constexpr int ATT_KP = 208, ATT_VP = 272, ATT_KB = 128 * ATT_KP, ATT_VB = 64 * ATT_VP;
constexpr float ATT_THR = 8.0f;
__device__ __forceinline__ void attn_unit(int b, int h, int qb, const bf16* Qb, const bf16* Kb, const bf16* Vt, bf16* O, LAS unsigned char* lds) {
    int tid_ = threadIdx.x; asm volatile("" : "+v"(tid_));
    const int tid = tid_, lane = tid & 63, r32 = lane & 31, hi = lane >> 5; const int wid = __builtin_amdgcn_readfirstlane(tid >> 6);
    const int q0 = qb * 256, tok0 = b * SEQ, NT = (q0 + 256) / 128;
    const bf16* kg[3]; int kl[3];
#pragma unroll
    for (int i = 0; i < 3; ++i) { const int c = tid + 512 * i, kr = c / 12, kc = c % 12; kg[i] = Kb + (size_t)(tok0 + kr) * 768 + h * QKD + kc * 8; kl[i] = kr * ATT_KP + kc * 16; }
    const bf16* vg[2]; int vl[2];
#pragma unroll
    for (int i = 0; i < 2; ++i) { const int c = tid + 512 * i, vd = c >> 4, vc = c & 15; vg[i] = Vt + (size_t)(h * VD + vd) * T + tok0 + vc * 8; vl[i] = 2 * ATT_KB + vd * ATT_VP + vc * 16; }
    const int qrow = tok0 + q0 + wid * 32 + r32; const int qpos = q0 + wid * 32 + r32;
    bf16x8 qf[6];
#pragma unroll
    for (int s = 0; s < 6; ++s) qf[s] = *(const bf16x8*)(Qb + (size_t)qrow * 768 + h * QKD + 16 * s + 8 * hi);
    const int krow = (r32 & ~12) | ((r32 & 4) << 1) | ((r32 & 8) >> 1);
    const int ka = krow * ATT_KP + hi * 16, va = 2 * ATT_KB + r32 * ATT_VP + hi * 16;
    f32x16 o0 = {}, o1 = {}, negm = {}; float mhat = 0.f, lrun = 0.f; bool first = true;
    u32x4 kx[3], vx[2];
#pragma unroll
    for (int i = 0; i < 3; ++i) kx[i] = *(const u32x4*)kg[i];
#pragma unroll
    for (int i = 0; i < 2; ++i) vx[i] = *(const u32x4*)vg[i];
#pragma unroll
    for (int i = 0; i < 3; ++i) *(LAS u32x4*)(lds + kl[i]) = kx[i];
#pragma unroll
    for (int i = 0; i < 2; ++i) *(LAS u32x4*)(lds + vl[i]) = vx[i];
    __syncthreads();
    for (int t = 0; t < NT; ++t) {
        const int cb = t & 1, nb = cb ^ 1;
        const bool more = t + 1 < NT;
        if (more) {
#pragma unroll
            for (int i = 0; i < 3; ++i) kx[i] = *(const u32x4*)(kg[i] + (size_t)(t + 1) * 128 * 768);
#pragma unroll
            for (int i = 0; i < 2; ++i) vx[i] = *(const u32x4*)(vg[i] + (t + 1) * 128); }
#pragma unroll
        for (int h2 = 0; h2 < 2; ++h2) {
            const int kv0 = t * 128 + h2 * 64;
            if (kv0 <= q0 + wid * 32 + 31) {
                f32x16 p0 = negm, p1 = negm;
                const LAS unsigned char* kb = lds + cb * ATT_KB + h2 * 64 * ATT_KP + ka;
#pragma unroll
                for (int s = 0; s < 6; ++s) {
                    const bf16x8 a0 = *(const LAS bf16x8*)(kb + s * 32), a1 = *(const LAS bf16x8*)(kb + 32 * ATT_KP + s * 32);
                    p0 = __builtin_amdgcn_mfma_f32_32x32x16_bf16(a0, qf[s], p0, 0, 0, 0);
                    p1 = __builtin_amdgcn_mfma_f32_32x32x16_bf16(a1, qf[s], p1, 0, 0, 0);
                }
                if (kv0 + 63 > q0 + wid * 32) {
#pragma unroll
                    for (int r = 0; r < 16; ++r) { const int kv = kv0 + (r & 7) + 8 * hi + 16 * (r >> 3); if (kv > qpos) p0[r] = -INFINITY; if (kv + 32 > qpos) p1[r] = -INFINITY; }
                }
                float mx = fmaxf(fmaxf(p0[0], p1[0]), fmaxf(p0[1], p1[1]));
#pragma unroll
                for (int r = 2; r < 16; r += 2) mx = fmaxf(mx, fmaxf(fmaxf(p0[r], p1[r]), fmaxf(p0[r + 1], p1[r + 1])));
                mx = fmaxf(mx, __shfl_xor(mx, 32));
                if (first || __any(mx > ATT_THR)) {
                    const float dl = first ? mx : fmaxf(mx, 0.f); mhat += dl;
                    const float f = first ? 1.0f : __builtin_amdgcn_exp2f(-dl); first = false;
#pragma unroll
                    for (int r = 0; r < 16; ++r) { p0[r] -= dl; p1[r] -= dl; negm[r] = -mhat; o0[r] *= f; o1[r] *= f; }
                    lrun *= f;
                }
                float ls = 0.f;
#pragma unroll
                for (int r = 0; r < 16; ++r) { p0[r] = __builtin_amdgcn_exp2f(p0[r]); p1[r] = __builtin_amdgcn_exp2f(p1[r]); ls += p0[r] + p1[r]; }
                lrun += ls;
                u32x4 pb[4];
                pb[0] = (u32x4){cvtpk(p0[0], p0[1]), cvtpk(p0[2], p0[3]), cvtpk(p0[4], p0[5]), cvtpk(p0[6], p0[7])};
                pb[1] = (u32x4){cvtpk(p0[8], p0[9]), cvtpk(p0[10], p0[11]), cvtpk(p0[12], p0[13]), cvtpk(p0[14], p0[15])};
                pb[2] = (u32x4){cvtpk(p1[0], p1[1]), cvtpk(p1[2], p1[3]), cvtpk(p1[4], p1[5]), cvtpk(p1[6], p1[7])};
                pb[3] = (u32x4){cvtpk(p1[8], p1[9]), cvtpk(p1[10], p1[11]), cvtpk(p1[12], p1[13]), cvtpk(p1[14], p1[15])};
                const LAS unsigned char* vb = lds + cb * ATT_VB + h2 * 128 + va;
#pragma unroll
                for (int ks = 0; ks < 4; ++ks) {
                    const bf16x8 a0 = *(const LAS bf16x8*)(vb + ks * 32), a1 = *(const LAS bf16x8*)(vb + 32 * ATT_VP + ks * 32);
                    const bf16x8 pbv = __builtin_bit_cast(bf16x8, pb[ks]);
                    o0 = __builtin_amdgcn_mfma_f32_32x32x16_bf16(a0, pbv, o0, 0, 0, 0);
                    o1 = __builtin_amdgcn_mfma_f32_32x32x16_bf16(a1, pbv, o1, 0, 0, 0);
                }
            }
        }
        if (more) {
#pragma unroll
            for (int i = 0; i < 3; ++i) *(LAS u32x4*)(lds + nb * ATT_KB + kl[i]) = kx[i];
#pragma unroll
            for (int i = 0; i < 2; ++i) *(LAS u32x4*)(lds + nb * ATT_VB + vl[i]) = vx[i]; }
        __syncthreads();
    }
    const float lt = lrun + __shfl_xor(lrun, 32); const float il = 1.0f / lt;
    bf16* op = O + (size_t)qrow * 512 + h * VD;
#pragma unroll
    for (int rg = 0; rg < 4; ++rg) {
        u32x2 w0, w1; w0.x = cvtpk(o0[4 * rg] * il, o0[4 * rg + 1] * il); w0.y = cvtpk(o0[4 * rg + 2] * il, o0[4 * rg + 3] * il);
        w1.x = cvtpk(o1[4 * rg] * il, o1[4 * rg + 1] * il); w1.y = cvtpk(o1[4 * rg + 2] * il, o1[4 * rg + 3] * il);
        *(u32x2*)(op + 8 * rg + 4 * hi) = w0; *(u32x2*)(op + 32 + 8 * rg + 4 * hi) = w1;
    }
}
__device__ __forceinline__ void p4_attention(Frame& F) {
    const bf16* Qb = (const bf16*)(F.ws + WS_R1); const bf16* Kb = (const bf16*)(F.ws + WS_KB); const bf16* Vt = (const bf16*)(F.ws + WS_VT); bf16* O = (bf16*)(F.ws + WS_AO);
    for (int p = F.vcu; p < 256; p += F.G) {
        const int bh = p >> 3, s = p & 7;
        attn_unit(bh >> 3, bh & 7, 15 - s, Qb, Kb, Vt, O, F.lds);
        attn_unit(bh >> 3, bh & 7, s, Qb, Kb, Vt, O, F.lds);
    }
}

__device__ __forceinline__ int mono(float x) { const int b = __float_as_int(x); return b ^ ((b >> 31) & 0x7fffffff); }
__device__ __forceinline__ float unmono(int k) { return __int_as_float(k ^ ((k >> 31) & 0x7fffffff)); }
#define TK_INS(L, xx) do { int _x = (xx); _Pragma("unroll") for (int _i = 0; _i < 16; ++_i) { const int _t = max(L[_i], _x); _x = min(L[_i], _x); L[_i] = _t; } } while (0)
__device__ __forceinline__ void sort16_desc(int (&v)[16]) {
#pragma unroll
    for (int k = 2; k <= 16; k <<= 1)
#pragma unroll
        for (int j = k >> 1; j > 0; j >>= 1)
#pragma unroll
            for (int i = 0; i < 16; ++i) { const int l = i ^ j; if (l > i) { const int hi_ = max(v[i], v[l]), lo_ = min(v[i], v[l]); const bool desc = (i & k) == 0; v[i] = desc ? hi_ : lo_; v[l] = desc ? lo_ : hi_; } }
}
__device__ __forceinline__ void merge16_desc(int (&top)[16], const int (&b)[16]) {
#pragma unroll
    for (int i = 0; i < 16; ++i) top[i] = max(top[i], b[15 - i]);
#pragma unroll
    for (int j = 8; j > 0; j >>= 1)
#pragma unroll
        for (int i = 0; i < 16; ++i) { const int l = i ^ j; if (l > i) { const int hi_ = max(top[i], top[l]), lo_ = min(top[i], top[l]); top[i] = hi_; top[l] = lo_; } }
}
__device__ __forceinline__ void peer_side(const bf16* qp, const bf16* sk, int r32, int hi, int (&L)[16]) {
    bf16x8 qf[8];
#pragma unroll
    for (int s = 0; s < 8; ++s) qf[s] = *(const bf16x8*)(qp + 16 * s + 8 * hi);
#pragma unroll
    for (int kt = 0; kt < 4; ++kt) {
        f32x16 acc = {};
#pragma unroll
        for (int s = 0; s < 8; ++s) { const bf16x8 a = *(const bf16x8*)(sk + (size_t)(32 * kt + r32) * 128 + 16 * s + 8 * hi); acc = __builtin_amdgcn_mfma_f32_32x32x16_bf16(a, qf[s], acc, 0, 0, 0); }
        int tv[16];
#pragma unroll
        for (int r = 0; r < 16; ++r) { const int key = 32 * kt + (r & 3) + 8 * (r >> 2); tv[r] = (mono(acc[r]) & ~127) | (127 - key); }
        sort16_desc(tv);
        if (kt == 0) {
#pragma unroll
            for (int i = 0; i < 16; ++i) L[i] = tv[i];
        } else merge16_desc(L, tv);
        asm volatile("" ::: "memory");
    }
    int Oth[16];
#pragma unroll
    for (int i = 0; i < 16; ++i) { L[i] ^= (hi << 2); Oth[i] = __shfl_xor(L[i], 32); }
    merge16_desc(L, Oth);
}
__device__ __forceinline__ void p9_peer_topk(Frame& F) {
    const bf16* QP = (const bf16*)(F.ws + WS_R2); const bf16* SK = (const bf16*)(F.ws + WS_SK);
    int* eidx = (int*)(F.ws + WS_EIDX); float* gate = (float*)(F.ws + WS_GATE);
    int lane_ = F.lane; asm volatile("" : "+v"(lane_));
    const int gw = F.vcu * NWAVES + F.wave, NGW = F.G * NWAVES, lane = lane_, r32 = lane & 31, hi = lane >> 5;
    LAS int* tab = (LAS int*)(F.lds + F.wave * 8192);
    pg8::StaticOrder SO; SO.init(T, 2048, F.G, (int)blockIdx.x); pg8::Unit un; (void)gw; (void)NGW;
    for (int ui = 0; SO.next(ui, un); ++ui) {
        const int h = un.pn, tb = un.pm * 8 + F.wave; const int tok = tb * 32 + r32;
        int L1[16], L2[16], L3[16];
        peer_side(QP + (size_t)tok * 2048 + h * 256, SK + (size_t)h * 16384, r32, hi, L1);
        peer_side(QP + (size_t)tok * 2048 + h * 256 + 128, SK + 131072 + (size_t)h * 16384, r32, hi, L2);
        float v1[16], v2[16];
#pragma unroll
        for (int i = 0; i < 16; ++i) { v1[i] = unmono(L1[i] & ~127); v2[i] = unmono(L2[i] & ~127); tab[i * 64 + lane] = 127 - (L1[i] & 127); tab[(16 + i) * 64 + lane] = 127 - (L2[i] & 127); L3[i] = (int)0x80000000; }
#define CAND(a, b) ((mono(v1[a] + v2[b]) & ~255) | (255 - ((a) * 16 + (b))))
        {
#pragma unroll
            for (int b = 0; b < 16; ++b) L3[b] = CAND(0, b);
            int gB[16] = {CAND(1, 0), CAND(1, 1), CAND(1, 2), CAND(1, 3), CAND(1, 4), CAND(1, 5), CAND(1, 6), CAND(1, 7), CAND(2, 0), CAND(2, 1), CAND(2, 2), CAND(2, 3), CAND(2, 4), CAND(4, 0), CAND(4, 1), CAND(4, 2)};
            sort16_desc(gB); merge16_desc(L3, gB);
            int gC[16] = {CAND(3, 0), CAND(3, 1), CAND(3, 2), CAND(3, 3), CAND(5, 0), CAND(5, 1), CAND(6, 0), CAND(6, 1), CAND(7, 0), CAND(7, 1), CAND(8, 0), CAND(9, 0), CAND(10, 0), CAND(11, 0), CAND(12, 0), CAND(13, 0)};
            sort16_desc(gC); merge16_desc(L3, gC);
            TK_INS(L3, CAND(14, 0)); TK_INS(L3, CAND(15, 0));
        }
#undef CAND
        float sc[16], ssum = 0.f; int ei[16];
#pragma unroll
        for (int k = 0; k < 16; ++k) { const int ci = 255 - (L3[k] & 255); sc[k] = unmono(L3[k] & ~255);
            ei[k] = tab[(ci >> 4) * 64 + lane] * 128 + tab[(16 + (ci & 15)) * 64 + lane]; }
        const float smax = sc[0];
#pragma unroll
        for (int k = 0; k < 16; ++k) { sc[k] = __builtin_amdgcn_exp2f((sc[k] - smax) * 1.4426950408889634f); ssum += sc[k]; }
        const float inv = 1.0f / ssum;
        const size_t ob = ((size_t)tok * PEER_H + h) * PEER_K;
        if (hi == 0) {
#pragma unroll
            for (int k = 0; k < 16; k += 4) *(u32x4*)(eidx + ob + k) = (u32x4){(unsigned)ei[k], (unsigned)ei[k + 1], (unsigned)ei[k + 2], (unsigned)ei[k + 3]};
        } else {
#pragma unroll
            for (int k = 0; k < 16; k += 4) *(f32x4*)(gate + ob + k) = (f32x4){sc[k] * inv, sc[k + 1] * inv, sc[k + 2] * inv, sc[k + 3] * inv};
        }
        LDS_WAIT();
    }
}
__device__ __forceinline__ void cvt_experts(Frame& F) {
    int lane_ = F.lane; asm volatile("" : "+v"(lane_));
    const int gw = F.vcu * NWAVES + F.wave, NGW = F.G * NWAVES, lane = lane_;
    float* esc = (float*)(F.ws + WS_ESC);
    for (int r0 = gw * 4; r0 < 2 * 16384; r0 += NGW * 4) {
        f32x4 v[4][4]; float am[4];
#pragma unroll
        for (int q = 0; q < 4; ++q) { const int row = r0 + q; const float* src = F.in[row < 16384 ? I_EU : I_EV] + (size_t)(row & 16383) * D + 16 * lane;
#pragma unroll
            for (int c = 0; c < 4; ++c) v[q][c] = *(const f32x4*)(src + 4 * c); }
#pragma unroll
        for (int q = 0; q < 4; ++q) { float m = 0.f;
#pragma unroll
            for (int c = 0; c < 4; ++c) m = fmaxf(m, fmaxf(fmaxf(fabsf(v[q][c][0]), fabsf(v[q][c][1])), fmaxf(fabsf(v[q][c][2]), fabsf(v[q][c][3]))));
            am[q] = m; }
#pragma unroll
        for (int o = 1; o < 64; o <<= 1)
#pragma unroll
            for (int q = 0; q < 4; ++q) am[q] = fmaxf(am[q], __shfl_xor(am[q], o));
#pragma unroll
        for (int q = 0; q < 4; ++q) { const int row = r0 + q; const float sc = am[q] > 0.f ? 6.5f / am[q] : 1.0f;
            unsigned w0 = 0u, w1 = 0u;
            w0 = __builtin_amdgcn_cvt_scalef32_pk_fp4_f32(w0, v[q][0][0] * sc, v[q][0][1] * sc, 1.0f, 0); w0 = __builtin_amdgcn_cvt_scalef32_pk_fp4_f32(w0, v[q][0][2] * sc, v[q][0][3] * sc, 1.0f, 1);
            w0 = __builtin_amdgcn_cvt_scalef32_pk_fp4_f32(w0, v[q][1][0] * sc, v[q][1][1] * sc, 1.0f, 2); w0 = __builtin_amdgcn_cvt_scalef32_pk_fp4_f32(w0, v[q][1][2] * sc, v[q][1][3] * sc, 1.0f, 3);
            w1 = __builtin_amdgcn_cvt_scalef32_pk_fp4_f32(w1, v[q][2][0] * sc, v[q][2][1] * sc, 1.0f, 0); w1 = __builtin_amdgcn_cvt_scalef32_pk_fp4_f32(w1, v[q][2][2] * sc, v[q][2][3] * sc, 1.0f, 1);
            w1 = __builtin_amdgcn_cvt_scalef32_pk_fp4_f32(w1, v[q][3][0] * sc, v[q][3][1] * sc, 1.0f, 2); w1 = __builtin_amdgcn_cvt_scalef32_pk_fp4_f32(w1, v[q][3][2] * sc, v[q][3][3] * sc, 1.0f, 3);
            unsigned char* dst = F.ws + (row < 16384 ? WS_EU : WS_EV) + (size_t)(row & 16383) * 512 + 8 * lane;
            *(u32x2*)dst = (u32x2){w0, w1};
            if (lane == 0) esc[row] = am[q] > 0.f ? am[q] * (1.0f / 6.5f) : 1.0f; }
    }
}

#define FMAC_V(acc, a, b) asm("v_fmac_f32_e32 %0, %1, %2" : "+v"(acc) : "v"(a), "v"(b))
#define FMAC_S(acc, ws, b) asm("v_fmac_f32_e32 %0, %1, %2" : "+v"(acc) : "s"(ws), "v"(b))
#define CVT4(w, sel) __builtin_amdgcn_cvt_scalef32_pk_f32_fp4((w), 1.0f, (sel))
__device__ __forceinline__ float dot16_fp4(u32x2 r, const float (&x)[16]) {
    float a = 0.f, b = 0.f; f32x2 t;
    t = CVT4(r.x, 0); FMAC_V(a, t.x, x[0]);  FMAC_V(b, t.y, x[1]);
    t = CVT4(r.x, 1); FMAC_V(a, t.x, x[2]);  FMAC_V(b, t.y, x[3]);
    t = CVT4(r.x, 2); FMAC_V(a, t.x, x[4]);  FMAC_V(b, t.y, x[5]);
    t = CVT4(r.x, 3); FMAC_V(a, t.x, x[6]);  FMAC_V(b, t.y, x[7]);
    t = CVT4(r.y, 0); FMAC_V(a, t.x, x[8]);  FMAC_V(b, t.y, x[9]);
    t = CVT4(r.y, 1); FMAC_V(a, t.x, x[10]); FMAC_V(b, t.y, x[11]);
    t = CVT4(r.y, 2); FMAC_V(a, t.x, x[12]); FMAC_V(b, t.y, x[13]);
    t = CVT4(r.y, 3); FMAC_V(a, t.x, x[14]); FMAC_V(b, t.y, x[15]);
    return a + b;
}
__device__ __forceinline__ void axpy16_fp4(float (&y)[16], float w, u32x2 r) {
    f32x2 t;
    t = CVT4(r.x, 0); FMAC_S(y[0], w, t.x);  FMAC_S(y[1], w, t.y);
    t = CVT4(r.x, 1); FMAC_S(y[2], w, t.x);  FMAC_S(y[3], w, t.y);
    t = CVT4(r.x, 2); FMAC_S(y[4], w, t.x);  FMAC_S(y[5], w, t.y);
    t = CVT4(r.x, 3); FMAC_S(y[6], w, t.x);  FMAC_S(y[7], w, t.y);
    t = CVT4(r.y, 0); FMAC_S(y[8], w, t.x);  FMAC_S(y[9], w, t.y);
    t = CVT4(r.y, 1); FMAC_S(y[10], w, t.x); FMAC_S(y[11], w, t.y);
    t = CVT4(r.y, 2); FMAC_S(y[12], w, t.x); FMAC_S(y[13], w, t.y);
    t = CVT4(r.y, 3); FMAC_S(y[14], w, t.x); FMAC_S(y[15], w, t.y);
}
__device__ __forceinline__ void sort128(int& k0, int& k1, int lane) {
#pragma unroll
    for (int k = 2; k <= 128; k <<= 1) {
#pragma unroll
        for (int j = k >> 1; j > 0; j >>= 1) {
            if (j == 64) { const int lo = min(k0, k1), hi = max(k0, k1); k0 = lo; k1 = hi; }
            else {
                const bool lower = (lane & j) == 0;
                const int p0 = __shfl_xor(k0, j), p1 = __shfl_xor(k1, j);
                const bool up0 = (k == 128) ? true : (k == 64) ? true : ((lane & k) == 0);
                const bool up1 = (k == 128) ? true : (k == 64) ? false : ((lane & k) == 0);
                k0 = (lower == up0) ? min(k0, p0) : max(k0, p0);
                k1 = (lower == up1) ? min(k1, p1) : max(k1, p1);
            }
        }
    }
}
typedef int i32x4 __attribute__((ext_vector_type(4)));
__device__ __forceinline__ u32x2 row_load(__amdgpu_buffer_rsrc_t rsrc, int lane8, int rowoff) { return __builtin_bit_cast(u32x2, __builtin_amdgcn_raw_buffer_load_b64(rsrc, lane8, rowoff, 0)); }
template <bool DRY> __device__ __forceinline__ void p10_peer_experts(Frame& F) {
    int lane_ = F.lane; asm volatile("" : "+v"(lane_));
    const int gw = F.vcu * NWAVES + F.wave, NGW = F.G * NWAVES, lane = lane_, lane16 = lane * 8;
    const bf16* XN = (const bf16*)(F.ws + WS_R1);
    const __amdgpu_buffer_rsrc_t ru = __builtin_amdgcn_make_buffer_rsrc((void*)(F.ws + WS_EU), 0, 16384 * 512, 0x00020000), rv = __builtin_amdgcn_make_buffer_rsrc((void*)(F.ws + WS_EV), 0, 16384 * 512, 0x00020000);
    const float* esc = (const float*)(F.ws + WS_ESC);
    const int* eidx = (const int*)(F.ws + WS_EIDX); const float* gate = (const float*)(F.ws + WS_GATE);
    const float* mod = (const float*)(F.ws + WS_CTL) + CW_MODF; const float* gp = F.in[I_GPOST2];
    const int b5 = (lane >> 5) & 1, b4 = (lane >> 4) & 1, b3 = (lane >> 3) & 1, b2 = (lane >> 2) & 1;
    const int eloc = b5 * 8 + b4 * 4 + b3 * 2 + b2;
    for (int tok = gw; tok < T; tok += NGW) {
        float x[16];
        { const u32x4 xa = *(const u32x4*)(XN + (size_t)tok * D + 16 * lane), xb = *(const u32x4*)(XN + (size_t)tok * D + 16 * lane + 8);
          x[0] = bflo(xa.x); x[1] = bfhi(xa.x); x[2] = bflo(xa.y); x[3] = bfhi(xa.y); x[4] = bflo(xa.z); x[5] = bfhi(xa.z); x[6] = bflo(xa.w); x[7] = bfhi(xa.w);
          x[8] = bflo(xb.x); x[9] = bfhi(xb.x); x[10] = bflo(xb.y); x[11] = bfhi(xb.y); x[12] = bflo(xb.z); x[13] = bfhi(xb.z); x[14] = bflo(xb.w); x[15] = bfhi(xb.w); }
        int k0 = (eidx[(size_t)tok * 128 + lane] << 7) | lane, k1 = (eidx[(size_t)tok * 128 + 64 + lane] << 7) | (64 + lane);
        sort128(k0, k1, lane);
        const int o0 = (k0 >> 7) << 9, o1 = (k1 >> 7) << 9;
        float y[16];
#pragma unroll
        for (int i = 0; i < 16; ++i) y[i] = 0.f;
        u32x2 U[16], V[16];
#pragma unroll
        for (int j = 0; j < 16; ++j) U[j] = row_load(ru, lane16, __builtin_amdgcn_readlane(o0, j));
        for (int kb = 0; kb < 8; ++kb) {
            const int kv = kb < 4 ? k0 : k1, ov = kb < 4 ? o0 : o1; const int lb = (kb & 3) * 16;
#pragma unroll
            for (int j = 0; j < 16; ++j) V[j] = row_load(rv, lane16, __builtin_amdgcn_readlane(ov, lb + j));
            __builtin_amdgcn_sched_barrier(0);
            float p[16];
#pragma unroll
            for (int j = 0; j < 16; ++j) p[j] = dot16_fp4(U[j], x);
            float q[8], r4[4], s2[2], tt;
#pragma unroll
            for (int j = 0; j < 8; ++j) { const float keep = b5 ? p[j + 8] : p[j], send = b5 ? p[j] : p[j + 8]; q[j] = keep + __shfl_xor(send, 32); }
#pragma unroll
            for (int j = 0; j < 4; ++j) { const float keep = b4 ? q[j + 4] : q[j], send = b4 ? q[j] : q[j + 4]; r4[j] = keep + __shfl_xor(send, 16); }
#pragma unroll
            for (int j = 0; j < 2; ++j) { const float keep = b3 ? r4[j + 2] : r4[j], send = b3 ? r4[j] : r4[j + 2]; s2[j] = keep + __shfl_xor(send, 8); }
            { const float keep = b2 ? s2[1] : s2[0], send = b2 ? s2[0] : s2[1]; tt = keep + __shfl_xor(send, 4); }
            tt += __shfl_xor(tt, 2); tt += __shfl_xor(tt, 1);
            const int mykey = __shfl(kv, lb + eloc); const int pidx = mykey & 127, myexp = mykey >> 7;
            tt *= esc[myexp];
            const float g = gate[(size_t)tok * 128 + pidx] * esc[16384 + myexp];
            const float u3 = 0.7978845608028654f * (tt + 0.044715f * tt * tt * tt);
            const float w = g * tt * sigmoidf_(2.0f * u3);
            if (kb < 7) { const int on = (kb + 1) < 4 ? o0 : o1; const int ln = ((kb + 1) & 3) * 16;
#pragma unroll
                for (int j = 0; j < 16; ++j) U[j] = row_load(ru, lane16, __builtin_amdgcn_readlane(on, ln + j)); }
            __builtin_amdgcn_sched_barrier(0);
#pragma unroll
            for (int j = 0; j < 16; ++j) {
                const int sl = ((j >> 3) & 1) * 32 + ((j >> 2) & 1) * 16 + ((j >> 1) & 1) * 8 + (j & 1) * 4;
                const float wj = __int_as_float(__builtin_amdgcn_readlane(__float_as_int(w), sl));
                axpy16_fp4(y, wj, V[j]); }
        }
        float ss = 0.f;
#pragma unroll
        for (int i = 0; i < 16; ++i) ss += y[i] * y[i];
        const float rstd = rsqrtf(wave_sum(ss) * (1.f / D) + RMS_EPS);
        const float* mb = mod + (tok / SEQ) * 6144 + 5 * 1024; float* orow = DRY ? (float*)(F.ws + WS_AO) + (size_t)(tok & 1023) * D : F.out + (size_t)tok * D;
#pragma unroll
        for (int c = 0; c < 4; ++c) { const int col = 16 * lane + 4 * c;
            const f32x4 yy = {y[4 * c], y[4 * c + 1], y[4 * c + 2], y[4 * c + 3]};
            const f32x4 h0 = *(const f32x4*)(orow + col), g0 = *(const f32x4*)(mb + col), p0 = *(const f32x4*)(gp + col);
            *(f32x4*)(orow + col) = h0 + g0 * (yy * rstd * p0); }
    }
}

__device__ __forceinline__ void p9_bruteforce(Frame& F) {
    const bf16* QP = (const bf16*)(F.ws + WS_R2);
    int* eidx = (int*)(F.ws + WS_EIDX); float* gate = (float*)(F.ws + WS_GATE);
    LAS float* sc = (LAS float*)(F.lds);
    (void)sc;
    float* scr = (float*)(F.ws + WS_PIN);
    (void)scr;
    const int gt = (F.vcu * NWAVES * 64) + F.tid, NGT = F.G * NWAVES * 64;
    for (int it = gt; it < T * 8; it += NGT) {
        const int tok = it >> 3, h = it & 7;
        float v[2][16]; int ix[2][16];
        for (int side = 0; side < 2; ++side) {
            const float* K = F.in[side ? I_SK2 : I_SK1] + (size_t)h * 16384;
            const bf16* q = QP + (size_t)tok * 2048 + h * 256 + side * 128;
            float prev = INFINITY; int previ = -1;
            for (int k = 0; k < 16; ++k) {
                float best = -INFINITY; int bi = -1;
                for (int key = 0; key < 128; ++key) {
                    float s = 0.f;
                    for (int d = 0; d < 128; ++d) s += __uint_as_float((unsigned)q[d] << 16) * K[key * 128 + d];
                    const bool after = (s < prev) || (s == prev && key > previ);
                    if (after && (s > best)) { best = s; bi = key; }
                }
                v[side][k] = best; ix[side][k] = bi; prev = best; previ = bi;
            }
        }
        float prev = INFINITY; int previ = -1; float scs[16]; int es[16];
        for (int k = 0; k < 16; ++k) {
            float best = -INFINITY; int bi = -1;
            for (int c = 0; c < 256; ++c) { const float s = v[0][c >> 4] + v[1][c & 15]; const bool after = (s < prev) || (s == prev && c > previ); if (after && s > best) { best = s; bi = c; } }
            scs[k] = best; es[k] = ix[0][bi >> 4] * 128 + ix[1][bi & 15]; prev = best; previ = bi;
        }
        float ssum = 0.f; for (int k = 0; k < 16; ++k) { scs[k] = __expf(scs[k] - scs[0]); ssum += scs[k]; }
        scs[0] = 1.0f;
        for (int k = 0; k < 16; ++k) { eidx[(size_t)it * 16 + k] = es[k]; gate[(size_t)it * 16 + k] = scs[k] / ssum; }
    }
}
__device__ __forceinline__ void p10_bruteforce(Frame& F) {
    const int gw = F.vcu * NWAVES + F.wave, NGW = F.G * NWAVES, lane = F.lane;
    const bf16* XN = (const bf16*)(F.ws + WS_R1); const float* EU = F.in[I_EU]; const float* EV = F.in[I_EV];
    const int* eidx = (const int*)(F.ws + WS_EIDX); const float* gate = (const float*)(F.ws + WS_GATE);
    const float* mod = (const float*)(F.ws + WS_CTL) + CW_MODF; const float* gp = F.in[I_GPOST2];
    for (int tok = gw; tok < T; tok += NGW) {
        float x[16], y[16];
        for (int i = 0; i < 16; ++i) { x[i] = __uint_as_float((unsigned)XN[(size_t)tok * D + lane + 64 * i] << 16); y[i] = 0.f; }
        for (int k = 0; k < 128; ++k) {
            const int e = eidx[(size_t)tok * 128 + k]; const float g = gate[(size_t)tok * 128 + k];
            float p = 0.f;
            for (int i = 0; i < 16; ++i) p += x[i] * EU[(size_t)e * D + lane + 64 * i];
            p = wave_sum(p);
            const float u3 = 0.7978845608028654f * (p + 0.044715f * p * p * p);
            const float w = g * 0.5f * p * (1.0f + tanhf(u3));
            for (int i = 0; i < 16; ++i) y[i] += w * EV[(size_t)e * D + lane + 64 * i];
        }
        float ss = 0.f; for (int i = 0; i < 16; ++i) ss += y[i] * y[i];
        const float rstd = rsqrtf(wave_sum(ss) * (1.f / D) + RMS_EPS);
        const float* mb = mod + (tok / SEQ) * 6144 + 5 * 1024; float* orow = F.out + (size_t)tok * D;
        for (int i = 0; i < 16; ++i) { const int col = lane + 64 * i; orow[col] = orow[col] + mb[col] * (y[i] * rstd * gp[col]); }
    }
}
#ifndef PH_MASK
#define PH_MASK 0xFFFFFFFFu
#endif
#define PH(k) ((PH_MASK >> (k)) & 1u)
__global__ void __launch_bounds__(NWAVES * 64, 2) fwd_megakernel(Args args) {
    extern __shared__ __attribute__((aligned(16))) unsigned char lds_raw[];
    Frame F;
    F.lds = (LAS unsigned char*)lds_raw;
    F.tid = threadIdx.x; F.lane = F.tid & 63; F.wave = __builtin_amdgcn_readfirstlane(F.tid >> 6);
    F.G = gridDim.x; { const int bx = blockIdx.x; F.vcu = (F.G % 8 == 0) ? (bx % 8) * (F.G / 8) + bx / 8 : bx; }
    F.in = args.in; F.out = args.out; F.ws = args.ws;
    unsigned char* ws = args.ws;
    volatile LAS unsigned* MISC = (volatile LAS unsigned*)(F.lds + LDSCTL_OFF);
    for (int u = F.tid; u < 64; u += NWAVES * 64) MISC[u] = 0u;
    __syncthreads();
    XcdBarrier bar = xcd_barrier_post((unsigned*)(ws + WS_CTL) + CW_BAR, MISC + 8);
#define GRID_BAR() xcd_barrier(bar)
    using namespace pg8;
    long long* rsq = (long long*)((unsigned*)(ws + WS_CTL) + CW_RSQ); long long* rsk = (long long*)((unsigned*)(ws + WS_CTL) + CW_RSK); const float* rope = (const float*)(ws + WS_ROPE);
    bf16* PROJ = (bf16*)(ws + WS_R2);
    if (PH(0)) p0_prologue(F); GRID_BAR();
    if (PH(1)) p1_xn(F); GRID_BAR();
    if (PH(2)) { Gemm g{(const bf16*)(ws + WS_R1), (const bf16*)(ws + WS_WIN), T, PROJ_N, 1024, 1024, 1024}; StaticOrder S; S.init(T, PROJ_N, F.G, (int)blockIdx.x);
      EpiProj E{PROJ, (bf16*)(ws + WS_KB), rsq, rsk, rope}; gemm_phase<EpiProj, true>(F.lds, g, S, E); }
    GRID_BAR();
    if (PH(3)) p3_pool(F);
    if (PH(4)) { Gemm g{PROJ + 512, (const bf16*)(ws + WS_WQ), T, 768, 256, PROJ_N, 256}; StaticOrder S; S.init(T, 768, F.G, (int)blockIdx.x);
      EpiQ E{(bf16*)(ws + WS_R1), rsq, rope}; gemm_phase<EpiQ, true>(F.lds, g, S, E); }
    if (PH(5)) { Gemm g{PROJ + 768, (const bf16*)(ws + WS_WK), T, 512, 256, PROJ_N, 256}; StaticOrder S; S.init(T, 512, F.G, (int)blockIdx.x);
      EpiKn E{(bf16*)(ws + WS_KB), rsk}; gemm_phase<EpiKn, true>(F.lds, g, S, E); }
    if (PH(6)) { Gemm g{(const bf16*)(ws + WS_WV), PROJ + 768, 512, T, 256, 256, PROJ_N}; StaticOrder S; S.init(512, T, F.G, (int)blockIdx.x);
      EpiVt E{(bf16*)(ws + WS_VT), rsk}; gemm_phase<EpiVt, true>(F.lds, g, S, E); }
    GRID_BAR();
    if (PH(7)) { Gemm g{(const bf16*)(ws + WS_PIN), (const bf16*)(ws + WS_WG), T, 512, 512, 512, 512}; StaticOrder S; S.init(T, 512, F.G, (int)blockIdx.x);
      EpiPlain E{(bf16*)(ws + WS_PF), 512}; gemm_phase<EpiPlain, true>(F.lds, g, S, E); }
    if (PH(8)) p4_attention(F);
#if defined(DUP_ATT)
    p4_attention(F);
#endif
    GRID_BAR();
    if (PH(9)) { Gemm g{(const bf16*)(ws + WS_PF), (const bf16*)(ws + WS_WPO), T, 1024, 512, 512, 512}; StaticOrder S; S.init(T, 1024, F.G, (int)blockIdx.x);
      EpiGate<0> E{(bf16*)(ws + WS_MRG), PROJ, 1024}; gemm_phase<EpiGate<0>, true>(F.lds, g, S, E); }
    asm volatile("s_waitcnt vmcnt(0)" ::: "memory"); __syncthreads();
    if (PH(10)) { Gemm g{(const bf16*)(ws + WS_AO), (const bf16*)(ws + WS_WMO), T, 1024, 512, 512, 512}; StaticOrder S; S.init(T, 1024, F.G, (int)blockIdx.x);
      EpiGate<1> E{(bf16*)(ws + WS_MRG), PROJ, 2048}; gemm_phase<EpiGate<1>, true>(F.lds, g, S, E); }
    GRID_BAR();
    if (PH(11)) { Gemm g{(const bf16*)(ws + WS_MRG), (const bf16*)(ws + WS_WOUT), T, 1024, 1024, 1024, 1024}; StaticOrder S; S.init(T, 1024, F.G, (int)blockIdx.x);
      EpiPlain E{(bf16*)(ws + WS_R2), 1024}; gemm_phase<EpiPlain, true>(F.lds, g, S, E); }
    GRID_BAR();
    if (PH(12)) p7_rows(F); GRID_BAR();
    if (PH(13)) { Gemm g{(const bf16*)(ws + WS_R1), (const bf16*)(ws + WS_WQY), T, 2048, 1024, 1024, 1024}; StaticOrder S; S.init(T, 2048, F.G, (int)blockIdx.x);
      EpiPlain E{(bf16*)(ws + WS_R2), 2048}; gemm_phase<EpiPlain, true>(F.lds, g, S, E); }
    asm volatile("s_waitcnt vmcnt(0)" ::: "memory"); __syncthreads();
    if (F.tid == 0) { __builtin_amdgcn_fence(__ATOMIC_ACQUIRE, "agent"); asm volatile("s_waitcnt vmcnt(0)" ::: "memory"); }
    __syncthreads();
    if (PH(14)) cvt_experts(F);
#if defined(BF_P9)
    if (PH(15)) p9_bruteforce(F);
#else
    if (PH(15)) p9_peer_topk(F);
#if defined(DUP_TOPK)
    p9_peer_topk(F);
#endif
#endif
    GRID_BAR();
#if defined(BF_P10)
    if (PH(16)) p10_bruteforce(F);
#else
#if defined(DUP_P10)
    p10_peer_experts<true>(F);
#endif
    if (PH(16)) p10_peer_experts<false>(F);
#endif
}

extern "C" void kernel_launch(void* const* d_in, const int* in_sizes, int n_in, void* d_out, int out_size, void* d_ws, size_t ws_size, hipStream_t stream) {
    static int grid = 0;
    if (grid == 0) {
        if (n_in != 23 || out_size != T * D || ws_size < WS_END) { fprintf(stderr, "kernel_launch: unexpected shapes (n_in %d out %d ws %zu)\n", n_in, out_size, ws_size); grid = -1; return; }
        int dev = 0, cus = 0, per_cu = 0;
        if (hipGetDevice(&dev) != hipSuccess || hipDeviceGetAttribute(&cus, hipDeviceAttributeMultiprocessorCount, dev) != hipSuccess) { grid = -1; return; }
        if (hipFuncSetAttribute((const void*)fwd_megakernel, hipFuncAttributeMaxDynamicSharedMemorySize, LDS_BYTES) != hipSuccess) { fprintf(stderr, "kernel_launch: hipFuncSetAttribute failed\n"); grid = -1; return; }
        if (hipOccupancyMaxActiveBlocksPerMultiprocessor(&per_cu, (const void*)fwd_megakernel, NWAVES * 64, LDS_BYTES) != hipSuccess || per_cu < 1) { fprintf(stderr, "kernel_launch: note: occupancy query says %d workgroups per CU\n", per_cu); (void)hipGetLastError(); }
        grid = cus;
    }
    if (grid < 0) return;
    (void)hipMemsetAsync((char*)d_ws + WS_CTL, 0, CTL_ZERO_BYTES, stream);
    Args a{};
    for (int i = 0; i < 23; ++i) a.in[i] = (const float*)d_in[i];
    a.out = (float*)d_out; a.ws = (unsigned char*)d_ws;
    hipLaunchKernelGGL(fwd_megakernel, dim3(grid), dim3(NWAVES * 64), LDS_BYTES, stream, a);
}
```
